# Optimizing an MI355X kernel written in HIP

```python
import math
import jax
import jax.numpy as jnp
from jax import lax
import numpy as np

D_MODEL = 1024
BATCH = 32
SEQ = 256
DEPTH = 4
DEC_BATCH = 8
DEC_SEQ = 4096
PAST_LEN = 256

GRID_W = 64
W_A = D_MODEL // 2
W_B = D_MODEL // 2
W_C = D_MODEL // 2
W_D = D_MODEL // 2
W_MIX = W_A + W_B
SC_WIDTH = 3
LRU_CONV = 4
LRU_HEADS = 8
LRU_BLK = W_B // LRU_HEADS
RG_C = 8.0
HY_CONV = 3
HY_ORDER = 2
HY_BANDS = 16
HY_POS_DIM = 1 + 2 * HY_BANDS
HY_FFN = 64
HY_TARGET = 1e-2
HY_SHORT_PCT = 0.3
HY_LONG_PCT = 1.5
RW_HEAD = 64
RW_HEADS = W_D // RW_HEAD
RW_LORA_W = 64
RW_LORA_A = 64
D_FF = 4 * D_MODEL
N_AB = (DEPTH + 1) // 2
N_CD = DEPTH // 2
DN_ALPHA = (2 * DEPTH) ** 0.25
DN_BETA = (8 * DEPTH) ** -0.25
LN_EPS = 1e-5
GN_EPS = 64e-5

kernel_name = 'hybrid_diffusion_conv_lru_hyena_rwkv7_step'


def _layer_norm(x, g, b):
    xf = x.astype(jnp.float32)
    xc = xf - jnp.mean(xf, -1, keepdims=True)
    var = jnp.mean(xc * xc, -1, keepdims=True)
    return (xc * lax.rsqrt(var + LN_EPS) * g.astype(jnp.float32) + b.astype(jnp.float32)).astype(x.dtype)


def _dwconv(x, w, pad_left, line):
    K, L = w.shape[0], x.shape[1]
    xp = jnp.pad(x, ((0, 0), (pad_left, K - 1 - pad_left), (0, 0)))
    pos = None if line is None else jnp.arange(L) % line
    out = 0.0
    for k in range(K):
        off = k - pad_left
        term = xp[:, k:k + L] * w[k]
        if pos is not None and off != 0:
            valid = ((pos + off >= 0) & (pos + off < line))[None, :, None]
            term = jnp.where(valid, term, jnp.zeros_like(term))
        out = out + term
    return out


def _tshift(x, line):
    w = jnp.array([0.5, 0.0, 0.5], x.dtype)[:, None]
    return _dwconv(x, w, 1, line)


def _to_colmajor(t, rows):
    b, L, ch = t.shape
    return t.reshape(b, rows, GRID_W, ch).transpose(0, 2, 1, 3).reshape(b, L, ch)


def _from_colmajor(t, rows):
    b, L, ch = t.shape
    return t.reshape(b, GRID_W, rows, ch).transpose(0, 2, 1, 3).reshape(b, L, ch)


def _lin_combine(e1, e2):
    a1, b1 = e1
    a2, b2 = e2
    return a1 * a2, a2 * b1 + b2


def _rglru_dir(xc, wa, ba, wi, bi, lam, h0):
    b, L, ch = xc.shape
    xf = xc.astype(jnp.float32)
    xb = xf.reshape(b, L, LRU_HEADS, LRU_BLK)
    r = jax.nn.sigmoid(jnp.einsum('blhi,hij->blhj', xb, wa).reshape(b, L, ch) + ba)
    i = jax.nn.sigmoid(jnp.einsum('blhi,hij->blhj', xb, wi).reshape(b, L, ch) + bi)
    log_a = -RG_C * r * jax.nn.softplus(-lam.astype(jnp.float32))
    a = jnp.exp(log_a)
    u = jnp.sqrt(-jnp.expm1(2.0 * log_a)) * (i * xf)
    u = u.at[:, 0].add(a[:, 0] * h0.astype(jnp.float32))
    _, h = lax.associative_scan(_lin_combine, (a, u), axis=1)
    return h, h[:, -1]


def _rwkv_dir(r, w, k, v, kk, a, s0):
    xs = tuple(jnp.moveaxis(t, 1, 0) for t in (r, w, k, v, kk, a))

    def step(S, inp):
        r_t, w_t, k_t, v_t, kk_t, a_t = inp
        sa = jnp.einsum('bhvk,bhk->bhv', S, kk_t)
        S = (S * w_t[:, :, None, :] - sa[..., None] * (kk_t * a_t)[:, :, None, :]
             + v_t[..., None] * k_t[:, :, None, :])
        return S, jnp.einsum('bhvk,bhk->bhv', S, r_t)

    s_fin, o = lax.scan(step, s0, xs)
    return jnp.moveaxis(o, 0, 1), s_fin


def _hyena_filters(L, w1, b1, w2, b2, w3, freq):
    f32 = jnp.float32
    tn = jnp.linspace(0.0, 1.0, L, dtype=f32)
    tr = jnp.arange(L, dtype=f32)
    bands = jnp.linspace(1e-4, HY_BANDS - 1, HY_BANDS, dtype=f32)
    ang = (2.0 * math.pi / L) * tr[:, None] * bands[None, :]
    feats = jnp.concatenate([tn[:, None], jnp.cos(ang), -jnp.sin(ang)], -1)
    fr = freq.astype(f32)
    hid = jnp.sin(fr * (jnp.dot(feats, w1.astype(f32)) + b1))
    hid = jnp.sin(fr * (jnp.dot(hid, w2.astype(f32)) + b2))
    raw = jnp.dot(hid, w3.astype(f32)).reshape(L, HY_ORDER, 2, W_C)
    deltas = jnp.abs(jnp.linspace(math.log(HY_TARGET) / HY_LONG_PCT, math.log(HY_TARGET) / HY_SHORT_PCT, W_C, dtype=f32))
    decay = jnp.exp(-tn[:, None] * deltas[None, :])
    filt = raw * decay[:, None, None, :]
    circ = jnp.concatenate([filt[:, :, 0], jnp.zeros((1, HY_ORDER, W_C), f32), filt[:0:-1, :, 1]], 0)
    return circ * lax.rsqrt(jnp.sum(circ * circ, 0, keepdims=True) + 1e-6)


def _fft_conv(z, f):
    L = z.shape[1]
    n = 2 * L
    zf = jnp.fft.rfft(z.astype(jnp.float32), n=n, axis=1)
    ff = jnp.fft.rfft(f, n=n, axis=0)
    return jnp.fft.irfft(zf * ff[None], n=n, axis=1)[:, :L]


def _mixer_ab(h, j, h0, line, p):
    proj = jnp.dot(h, p['ab_w_in'][j])
    s_b, s_c, s_v, g_lru, x_lru = jnp.split(proj, [W_A, 2 * W_A, 3 * W_A, 3 * W_A + W_B], axis=-1)
    y_a = s_b * _dwconv(s_c * s_v, p['sc_conv'][j], 1, line)
    xc = _dwconv(x_lru, p['lru_conv'][j], 2, line) + p['lru_conv_b'][j]
    hf, sf = _rglru_dir(xc, p['lru_wa'][j, 0], p['lru_ba'][j, 0], p['lru_wi'][j, 0], p['lru_bi'][j, 0], p['lru_lambda'][j, 0], h0[:, 0])
    hb, sb = _rglru_dir(jnp.flip(xc, 1), p['lru_wa'][j, 1], p['lru_ba'][j, 1], p['lru_wi'][j, 1], p['lru_bi'][j, 1], p['lru_lambda'][j, 1], h0[:, 1])
    y_b = jax.nn.gelu(g_lru) * (hf + jnp.flip(hb, 1)).astype(h.dtype)
    return jnp.concatenate([y_a, y_b], -1), jnp.stack([sf, sb], 1)


def _mixer_cd(h, j, s0, line, p):
    f32 = jnp.float32
    bsz, L, _ = h.shape
    proj = jnp.dot(h, p['cd_w_in'][j])
    u = _dwconv(proj[..., :3 * W_C], p['hy_conv'][j], 1, line)
    hv, hx1, hx2 = jnp.split(u.astype(f32), 3, axis=-1)
    filt = _hyena_filters(L, p['hy_w1'][j], p['hy_b1'][j], p['hy_w2'][j], p['hy_b2'][j], p['hy_w3'][j], p['hy_freq'][j])
    bias = p['hy_bias'][j].astype(f32)
    z = hx1 * (_fft_conv(hv, filt[:, 0]) + bias[0] * hv)
    y_c = hx2 * (_fft_conv(z, filt[:, 1]) + bias[1] * z)

    mu = p['rw_mu'][j]
    r, k, v, g = [t + (_tshift(t, line) - t) * mu[n] for n, t in enumerate(jnp.split(proj[..., 3 * W_C:], 4, axis=-1))]
    dh = _tshift(h, line) - h
    xw = h + dh * p['rw_mu_x'][j, 0]
    xa = h + dh * p['rw_mu_x'][j, 1]

    def heads(t):
        return t.astype(f32).reshape(bsz, L, RW_HEADS, RW_HEAD)

    rh, vh = heads(r), heads(v)
    kk = heads(k * p['rw_kk'][j])
    kk = kk * lax.rsqrt(jnp.sum(kk * kk, -1, keepdims=True) + 1e-12)
    rk = p['rw_rk'][j].astype(f32)
    o_sum = 0.0
    bonus = 0.0
    finals = []
    for d in range(2):
        w_raw = -jax.nn.softplus(-(p['rw_w0'][j, d] + jnp.dot(jnp.tanh(jnp.dot(xw, p['rw_w1'][j, d])), p['rw_w2'][j, d]))) - 0.5
        decay = heads(jnp.exp(-jnp.exp(w_raw.astype(f32))))
        a = jax.nn.sigmoid(p['rw_a0'][j, d] + jnp.dot(jnp.dot(xa, p['rw_a1'][j, d]), p['rw_a2'][j, d]))
        kd = k * (1.0 + (a - 1.0) * p['rw_ka'][j])
        ah, kdh = heads(a), heads(kd)
        seq = (rh, decay, kdh, vh, kk, ah)
        if d == 1:
            seq = tuple(jnp.flip(t, 1) for t in seq)
        o, s_fin = _rwkv_dir(seq[0], seq[1], seq[2], seq[3], seq[4], seq[5], s0[:, d].astype(f32))
        if d == 1:
            o = jnp.flip(o, 1)
        o_sum = o_sum + o
        bonus = bonus + jnp.sum(rh * kdh * rk, -1, keepdims=True) * vh
        finals.append(s_fin)
    oc = o_sum - jnp.mean(o_sum, -1, keepdims=True)
    on = oc * lax.rsqrt(jnp.mean(oc * oc, -1, keepdims=True) + GN_EPS)
    on = on.reshape(bsz, L, W_D) * p['rw_gn_g'][j].astype(f32) + p['rw_gn_b'][j].astype(f32)
    y_d = (on + bonus.reshape(bsz, L, W_D)) * jax.nn.sigmoid(g.astype(f32))
    return jnp.concatenate([y_c, y_d], -1).astype(h.dtype), jnp.stack(finals, 1)


def _trunk(x, cvec, init_lru, init_rwkv, rows, p):
    bsz = x.shape[0]
    if init_lru is None:
        init_lru = jnp.zeros((bsz, N_AB, 2, W_B), jnp.float32)
        init_rwkv = jnp.zeros((bsz, N_CD, 2, RW_HEADS, RW_HEAD, RW_HEAD), jnp.float32)
    new_lru = []
    new_rwkv = []
    for l in range(DEPTH):
        j = l // 2
        mods = jnp.dot(jax.nn.silu(cvec), p['w_mod'][l]) + p['b_mod'][l]
        sh1, sc1, g1, sh2, sc2, g2 = [m[:, None, :] for m in jnp.split(mods, 6, axis=-1)]
        h = x * (1.0 + sc1) + sh1
        if l % 2 == 0:
            line = None if rows is None else GRID_W
            mix, st = _mixer_ab(h, j, init_lru[:, j], line, p)
            y = jnp.dot(mix, p['w_out'][l])
            new_lru.append(st)
        else:
            if rows is None:
                mix, st = _mixer_cd(h, j, init_rwkv[:, j], None, p)
                y = jnp.dot(mix, p['w_out'][l])
            else:
                mix, st = _mixer_cd(_to_colmajor(h, rows), j, init_rwkv[:, j], rows, p)
                y = _from_colmajor(jnp.dot(mix, p['w_out'][l]), rows)
            new_rwkv.append(st)
        x = _layer_norm(DN_ALPHA * x + g1 * y, p['ln1_g'][l], p['ln1_b'][l])
        h = x * (1.0 + sc2) + sh2
        y = jnp.dot(jnp.square(jax.nn.relu(jnp.dot(h, p['mlp_w1'][l]))), p['mlp_w2'][l])
        x = _layer_norm(DN_ALPHA * x + g2 * y, p['ln2_g'][l], p['ln2_b'][l])
    return x, jnp.stack(new_lru, 1), jnp.stack(new_rwkv, 1)


def setup_inputs(seed: int = 0) -> dict:
    key = jax.random.key(seed)
    ks = iter(jax.random.split(key, 64))
    f32 = jnp.float32

    def nrm(shape, s):
        return jax.random.normal(next(ks), shape, f32) * s

    def uni(shape, lo, hi):
        return jax.random.uniform(next(ks), shape, f32, lo, hi)

    lam_a = uni((N_AB, 2, W_B), 0.9, 0.999) ** (1.0 / RG_C)
    return {
        'x_prompt': nrm((BATCH, SEQ, D_MODEL), 1.0),
        'x_sample': nrm((DEC_BATCH, DEC_SEQ, D_MODEL), 1.0),
        'state_lru': nrm((DEC_BATCH, N_AB, 2, W_B), 0.5),
        'state_rwkv': nrm((DEC_BATCH, N_CD, 2, RW_HEADS, RW_HEAD, RW_HEAD), 0.5),
        'c': nrm((DEC_BATCH, D_MODEL), 1.0),
        'c_ctx': nrm((D_MODEL,), 1.0),
        'w_mod': nrm((DEPTH, D_MODEL, 6 * D_MODEL), 0.5 * D_MODEL ** -0.5),
        'b_mod': nrm((DEPTH, 6 * D_MODEL), 0.02),
        'ln1_g': 1.0 + nrm((DEPTH, D_MODEL), 0.02),
        'ln1_b': nrm((DEPTH, D_MODEL), 0.01),
        'ln2_g': 1.0 + nrm((DEPTH, D_MODEL), 0.02),
        'ln2_b': nrm((DEPTH, D_MODEL), 0.01),
        'mlp_w1': nrm((DEPTH, D_MODEL, D_FF), D_MODEL ** -0.5),
        'mlp_w2': nrm((DEPTH, D_FF, D_MODEL), DN_BETA * D_FF ** -0.5),
        'w_out': nrm((DEPTH, W_MIX, D_MODEL), DN_BETA * W_MIX ** -0.5),
        'ab_w_in': nrm((N_AB, D_MODEL, 3 * W_A + 2 * W_B), D_MODEL ** -0.5),
        'sc_conv': nrm((N_AB, SC_WIDTH, W_A), SC_WIDTH ** -0.5),
        'lru_conv': nrm((N_AB, LRU_CONV, W_B), LRU_CONV ** -0.5),
        'lru_conv_b': nrm((N_AB, W_B), 0.01),
        'lru_wa': nrm((N_AB, 2, LRU_HEADS, LRU_BLK, LRU_BLK), LRU_BLK ** -0.5),
        'lru_ba': nrm((N_AB, 2, W_B), 0.01),
        'lru_wi': nrm((N_AB, 2, LRU_HEADS, LRU_BLK, LRU_BLK), LRU_BLK ** -0.5),
        'lru_bi': nrm((N_AB, 2, W_B), 0.01),
        'lru_lambda': jnp.log(lam_a) - jnp.log1p(-lam_a),
        'cd_w_in': nrm((N_CD, D_MODEL, 3 * W_C + 4 * W_D), D_MODEL ** -0.5),
        'hy_conv': nrm((N_CD, HY_CONV, 3 * W_C), HY_CONV ** -0.5),
        'hy_w1': nrm((N_CD, HY_POS_DIM, HY_FFN), HY_POS_DIM ** -0.5),
        'hy_b1': nrm((N_CD, HY_FFN), 0.01),
        'hy_w2': nrm((N_CD, HY_FFN, HY_FFN), HY_FFN ** -0.5),
        'hy_b2': nrm((N_CD, HY_FFN), 0.01),
        'hy_w3': nrm((N_CD, HY_FFN, HY_ORDER * 2 * W_C), HY_FFN ** -0.5),
        'hy_freq': 1.0 + nrm((N_CD, HY_FFN), 0.1),
        'hy_bias': nrm((N_CD, HY_ORDER, W_C), 0.1),
        'rw_mu': uni((N_CD, 4, W_D), 0.0, 1.0),
        'rw_mu_x': uni((N_CD, 2, D_MODEL), 0.0, 1.0),
        'rw_w0': uni((N_CD, 2, W_D), -6.0, -1.0),
        'rw_w1': nrm((N_CD, 2, D_MODEL, RW_LORA_W), D_MODEL ** -0.5),
        'rw_w2': nrm((N_CD, 2, RW_LORA_W, W_D), 0.1 * RW_LORA_W ** -0.5),
        'rw_a0': nrm((N_CD, 2, W_D), 0.1),
        'rw_a1': nrm((N_CD, 2, D_MODEL, RW_LORA_A), D_MODEL ** -0.5),
        'rw_a2': nrm((N_CD, 2, RW_LORA_A, W_D), 0.1 * RW_LORA_A ** -0.5),
        'rw_kk': 0.85 + nrm((N_CD, W_D), 0.05),
        'rw_ka': 1.0 + nrm((N_CD, W_D), 0.05),
        'rw_rk': nrm((N_CD, RW_HEADS, RW_HEAD), 0.1),
        'rw_gn_g': 1.0 + nrm((N_CD, W_D), 0.02),
        'rw_gn_b': nrm((N_CD, W_D), 0.01),
    }


def reference(x_prompt, x_sample, state_lru, state_rwkv, c, c_ctx, w_mod, b_mod, ln1_g, ln1_b, ln2_g, ln2_b,
              mlp_w1, mlp_w2, w_out, ab_w_in, sc_conv, lru_conv, lru_conv_b, lru_wa, lru_ba, lru_wi, lru_bi,
              lru_lambda, cd_w_in, hy_conv, hy_w1, hy_b1, hy_w2, hy_b2, hy_w3, hy_freq, hy_bias, rw_mu, rw_mu_x,
              rw_w0, rw_w1, rw_w2, rw_a0, rw_a1, rw_a2, rw_kk, rw_ka, rw_rk, rw_gn_g, rw_gn_b):
    p = dict(w_mod=w_mod, b_mod=b_mod, ln1_g=ln1_g, ln1_b=ln1_b, ln2_g=ln2_g, ln2_b=ln2_b,
             mlp_w1=mlp_w1, mlp_w2=mlp_w2, w_out=w_out, ab_w_in=ab_w_in, sc_conv=sc_conv,
             lru_conv=lru_conv, lru_conv_b=lru_conv_b, lru_wa=lru_wa, lru_ba=lru_ba, lru_wi=lru_wi,
             lru_bi=lru_bi, lru_lambda=lru_lambda, cd_w_in=cd_w_in, hy_conv=hy_conv, hy_w1=hy_w1,
             hy_b1=hy_b1, hy_w2=hy_w2, hy_b2=hy_b2, hy_w3=hy_w3, hy_freq=hy_freq, hy_bias=hy_bias,
             rw_mu=rw_mu, rw_mu_x=rw_mu_x, rw_w0=rw_w0, rw_w1=rw_w1, rw_w2=rw_w2, rw_a0=rw_a0,
             rw_a1=rw_a1, rw_a2=rw_a2, rw_kk=rw_kk, rw_ka=rw_ka, rw_rk=rw_rk, rw_gn_g=rw_gn_g,
             rw_gn_b=rw_gn_b)
    y_prompt, new_state_lru, new_state_rwkv = _trunk(x_prompt, c_ctx[None, :], None, None, None, p)
    rows = x_sample.shape[1] // GRID_W
    y_sample, _, _ = _trunk(x_sample, c, state_lru, state_rwkv, rows, p)
    return (y_prompt, y_sample, new_state_lru, new_state_rwkv)
```

```cpp
#include <hip/hip_runtime.h>
#include <hip/hip_bf16.h>
#include <hip/hip_cooperative_groups.h>
#include <cstdio>
namespace cg = cooperative_groups;

typedef unsigned short u16;
typedef unsigned int u32;
using bf16x8 = __attribute__((ext_vector_type(8))) short;
using f32x4 = __attribute__((ext_vector_type(4))) float;

#define NTHR 512
#define MTOK 40960
#define MCTX 8192
#define ALPHA 1.6817928305074292f
#define SMEM_BYTES 122880

struct P {
  const float *x_prompt, *x_sample, *state_lru, *state_rwkv, *c, *c_ctx, *w_mod, *b_mod, *ln1_g, *ln1_b, *ln2_g, *ln2_b,
      *mlp_w1, *mlp_w2, *w_out, *ab_w_in, *sc_conv, *lru_conv, *lru_conv_b, *lru_wa, *lru_ba, *lru_wi, *lru_bi, *lru_lambda,
      *cd_w_in, *hy_conv, *hy_w1, *hy_b1, *hy_w2, *hy_b2, *hy_w3, *hy_freq, *hy_bias, *rw_mu, *rw_mu_x, *rw_w0, *rw_w1, *rw_w2,
      *rw_a0, *rw_a1, *rw_a2, *rw_kk, *rw_ka, *rw_rk, *rw_gn_g, *rw_gn_b;
  float* out;
  char* ws;
};

#define MiB (1024ull * 1024ull)
#define OFF_MODS (0ull)
#define OFF_BONUS (1ull * MiB)
#define OFF_HID2 (4ull * MiB)
#define OFF_SUMSQ (7ull * MiB)
#define OFF_CTR (7ull * MiB + 65536ull)
#define OFF_WIN (8ull * MiB)
#define OFF_WOUT (16ull * MiB)
#define OFF_W1T (18ull * MiB)
#define OFF_W2T (26ull * MiB)
#define OFF_FILT (34ull * MiB)
#define OFF_H (52ull * MiB)
#define OFF_ARENA (132ull * MiB)
#define ARENA_B (200ull * MiB)
#define WS_NEED (492ull * MiB)

__device__ __forceinline__ int otid() {
  int t = threadIdx.x;
  asm volatile("" : "+v"(t));
  return t;
}
__device__ __forceinline__ u16 f2bf(float f) {
  u32 u = __float_as_uint(f);
  u += 0x7fffu + ((u >> 16) & 1u);
  return (u16)(u >> 16);
}
__device__ __forceinline__ float bf2f(u16 h) { return __uint_as_float(((u32)h) << 16); }
__device__ __forceinline__ float bflo(u32 u) { return __uint_as_float(u << 16); }
__device__ __forceinline__ float bfhi(u32 u) { return __uint_as_float(u & 0xffff0000u); }
__device__ __forceinline__ u32 pack2(float a, float b) { return (u32)f2bf(a) | ((u32)f2bf(b) << 16); }
__device__ __forceinline__ float sigmoidf_(float x) { return 1.f / (1.f + __expf(-x)); }
__device__ __forceinline__ float softplusf_(float x) { return fmaxf(x, 0.f) + log1pf(__expf(-fabsf(x))); }
__device__ __forceinline__ float wsum(float v) {
#pragma unroll
  for (int o = 32; o > 0; o >>= 1) v += __shfl_xor(v, o);
  return v;
}
__device__ __forceinline__ int mods_row(int m) { return m < MCTX ? 0 : 1 + ((m - MCTX) >> 12); }
__device__ __forceinline__ int perm_row(int m) {
  if (m < MCTX) return m;
  int t = m - MCTX;
  int b = t >> 12, s = t & 4095;
  return MCTX + (b << 12) + ((s & 63) << 6) + (s >> 6);
}

__device__ __forceinline__ void phase_mods(const P& p, float* mods, float* sm) {
  float* sc = sm;
  float* red = sm + 9 * 1024;
  const int tid = otid();
  for (int i = tid; i < 9 * 1024; i += NTHR) {
    int r = i >> 10, k = i & 1023;
    float v = (r == 0) ? p.c_ctx[k] : p.c[(r - 1) * 1024 + k];
    sc[i] = v / (1.f + __expf(-v));
  }
  __syncthreads();
  const int nl = tid & 63, ks = tid >> 6;
  for (int it = blockIdx.x; it < 4 * 96; it += gridDim.x) {
    int l = it / 96, ng = it % 96;
    int n = ng * 64 + nl;
    const float* w = p.w_mod + (size_t)l * 1024 * 6144 + n;
    float a0 = 0, a1 = 0, a2 = 0, a3 = 0, a4 = 0, a5 = 0, a6 = 0, a7 = 0, a8 = 0;
#pragma unroll 4
    for (int k = ks * 128; k < ks * 128 + 128; ++k) {
      float wv = w[(size_t)k * 6144];
      a0 += sc[k] * wv; a1 += sc[1024 + k] * wv; a2 += sc[2048 + k] * wv; a3 += sc[3072 + k] * wv;
      a4 += sc[4096 + k] * wv; a5 += sc[5120 + k] * wv; a6 += sc[6144 + k] * wv; a7 += sc[7168 + k] * wv;
      a8 += sc[8192 + k] * wv;
    }
    red[(ks * 9 + 0) * 64 + nl] = a0; red[(ks * 9 + 1) * 64 + nl] = a1; red[(ks * 9 + 2) * 64 + nl] = a2;
    red[(ks * 9 + 3) * 64 + nl] = a3; red[(ks * 9 + 4) * 64 + nl] = a4; red[(ks * 9 + 5) * 64 + nl] = a5;
    red[(ks * 9 + 6) * 64 + nl] = a6; red[(ks * 9 + 7) * 64 + nl] = a7; red[(ks * 9 + 8) * 64 + nl] = a8;
    __syncthreads();
    for (int o = tid; o < 9 * 64; o += NTHR) {
      int r = o >> 6, cc = o & 63;
      float s = 0;
#pragma unroll
      for (int q = 0; q < 8; ++q) s += red[(q * 9 + r) * 64 + cc];
      int nn = ng * 64 + cc;
      mods[(size_t)(l * 9 + r) * 6144 + nn] = s + p.b_mod[l * 6144 + nn];
    }
    __syncthreads();
  }
}

__device__ __forceinline__ void phase_hid2(const P& p, float* HID2, float* sm) {
  float* ft = sm;
  float* h1s = sm + 8 * 36;
  const int tid = otid();
  for (int it = blockIdx.x; it < 2 * 544; it += gridDim.x) {
    int j = it / 544, rg = it % 544;
    int row0 = rg * 8;
    if (tid < 8 * 33) {
      int r = tid / 33, f = tid % 33;
      int row = row0 + r;
      int L = row < 4096 ? 4096 : 256;
      int lag = row < 4096 ? row : row - 4096;
      float val;
      if (f == 0) val = (float)lag / (float)(L - 1);
      else {
        int bi = (f - 1) & 15;
        float band = 1e-4f + (float)bi * ((15.f - 1e-4f) / 15.f);
        float ang = (6.283185307179586f / (float)L) * (float)lag * band;
        val = (f <= 16) ? cosf(ang) : -sinf(ang);
      }
      ft[r * 36 + f] = val;
    }
    __syncthreads();
    int rl = tid >> 6, u = tid & 63;
    float fr = p.hy_freq[j * 64 + u];
    float h1 = p.hy_b1[j * 64 + u];
    for (int f = 0; f < 33; ++f) h1 += ft[rl * 36 + f] * p.hy_w1[(j * 33 + f) * 64 + u];
    h1 = sinf(fr * h1);
    h1s[rl * 64 + u] = h1;
    __syncthreads();
    float h2 = p.hy_b2[j * 64 + u];
    for (int v = 0; v < 64; ++v) h2 += h1s[rl * 64 + v] * p.hy_w2[(j * 64 + v) * 64 + u];
    h2 = sinf(fr * h2);
    HID2[((size_t)j * 4352 + row0 + rl) * 64 + u] = h2;
    __syncthreads();
  }
}

__device__ __forceinline__ void phase_filtgen(const P& p, int j, const float* HID2, u16* FILT, float* SUMSQ, float* sm) {
  float* hs = sm;
  const int tid = otid();
  for (int it = blockIdx.x; it < 272; it += gridDim.x) {
    int lc, lt, ct;
    if (it < 256) { lc = 0; lt = it >> 2; ct = it & 3; }
    else { lc = 1; lt = (it - 256) >> 2; ct = it & 3; }
    const int L = lc ? 256 : 4096;
    const int lag0 = lt * 64;
    const int rowbase = lc ? 4096 : 0;
    for (int e = tid; e < 4096; e += NTHR) hs[e] = HID2[((size_t)j * 4352 + rowbase + lag0) * 64 + e];
    __syncthreads();
    const int col = ct * 512 + tid;
    const int order = col >> 10, dir = (col >> 9) & 1, ch = col & 511;
    float w3c[64];
#pragma unroll
    for (int u = 0; u < 64; ++u) w3c[u] = p.hy_w3[((size_t)j * 64 + u) * 2048 + col];
    const float delta = 3.0701134573253947f + (float)ch * (12.280453829301577f / 511.f);
    u16* fdst = FILT + (lc ? (size_t)2 * 512 * 8192 : 0) + (size_t)(order * 512 + ch) * (2 * L);
    float ss = 0.f;
    for (int ll = 0; ll < 64; ++ll) {
      float raw = 0.f;
#pragma unroll
      for (int u = 0; u < 64; ++u) raw += hs[ll * 64 + u] * w3c[u];
      int lag = lag0 + ll;
      float tn = (float)lag / (float)(L - 1);
      float val = raw * __expf(-tn * delta);
      if (dir == 0) { ss += val * val; fdst[L - lag] = f2bf(val); }
      else if (lag > 0) { ss += val * val; fdst[L + lag] = f2bf(val); }
    }
    atomicAdd(&SUMSQ[((j * 2 + lc) * 2 + order) * 512 + ch], ss);
    __syncthreads();
  }
}

__device__ __forceinline__ void conv_wt(const float* __restrict__ src, int ld, int K, int N, u16* __restrict__ dst, int ldd,
                                        const float* __restrict__ scale, float* sm) {
  const int tid = otid();
  const int KT = K >> 6;
  const int nt_total = KT * (N >> 6);
  for (int t = blockIdx.x; t < nt_total; t += gridDim.x) {
    int kt = t % KT, nt = t / KT;
    for (int e = tid; e < 4096; e += NTHR) {
      int kk = e >> 6, nn = e & 63;
      float v = src[(size_t)(kt * 64 + kk) * ld + nt * 64 + nn];
      if (scale) v *= scale[kt * 64 + kk];
      sm[kk * 65 + nn] = v;
    }
    __syncthreads();
    for (int e = tid; e < 4096; e += NTHR) {
      int nn = e >> 6, kk = e & 63;
      dst[(size_t)(nt * 64 + nn) * ldd + kt * 64 + kk] = f2bf(sm[kk * 65 + nn]);
    }
    __syncthreads();
  }
}

__device__ __forceinline__ void conv_mix_weights(const P& p, int l, char* ws, float* sm) {
  u16* WIN = (u16*)(ws + OFF_WIN);
  u16* WOUT = (u16*)(ws + OFF_WOUT);
  const int j = l >> 1;
  if ((l & 1) == 0) {
    conv_wt(p.ab_w_in + (size_t)j * 1024 * 2560, 2560, 1024, 2560, WIN, 1024, nullptr, sm);
  } else {
    conv_wt(p.cd_w_in + (size_t)j * 1024 * 3584, 3584, 1024, 3584, WIN, 1024, nullptr, sm);
    for (int d = 0; d < 2; ++d) {
      const float* w1 = p.rw_w1 + (size_t)(j * 2 + d) * 1024 * 64;
      const float* a1 = p.rw_a1 + (size_t)(j * 2 + d) * 1024 * 64;
      u16* base = WIN + (size_t)(3584 + d * 256) * 1024;
      conv_wt(w1, 64, 1024, 64, base, 1024, nullptr, sm);
      conv_wt(w1, 64, 1024, 64, base + 64 * 1024, 1024, p.rw_mu_x + (size_t)(j * 2 + 0) * 1024, sm);
      conv_wt(a1, 64, 1024, 64, base + 128 * 1024, 1024, nullptr, sm);
      conv_wt(a1, 64, 1024, 64, base + 192 * 1024, 1024, p.rw_mu_x + (size_t)(j * 2 + 1) * 1024, sm);
    }
  }
  conv_wt(p.w_out + (size_t)l * 1024 * 1024, 1024, 1024, 1024, WOUT, 1024, nullptr, sm);
}
__device__ __forceinline__ void conv_mlp_weights(const P& p, int l, char* ws, float* sm) {
  conv_wt(p.mlp_w1 + (size_t)l * 1024 * 4096, 4096, 1024, 4096, (u16*)(ws + OFF_W1T), 1024, nullptr, sm);
  conv_wt(p.mlp_w2 + (size_t)l * 4096 * 1024, 1024, 4096, 1024, (u16*)(ws + OFF_W2T), 4096, nullptr, sm);
}

#define LSTR 72
template <int EPI>
__device__ __forceinline__ void gemm_phase(const u16* __restrict__ A, int lda, const u16* __restrict__ Bt, int K, int N,
                                           u16* __restrict__ C, int ldc, int flag, u16* __restrict__ UT, float* __restrict__ X,
                                           const float* __restrict__ gate, char* smem) {
  u16* As = (u16*)smem;
  u16* Bs = As + 2 * 256 * LSTR;
  const int tid = otid(), wid = tid >> 6, lane = tid & 63, wr = wid >> 1, wc = wid & 1, fr = lane & 15, fq = lane >> 4;
  const int NT = N >> 7, ntiles = 160 * NT, nk = K >> 6;
  const int crow = tid >> 3, ccol = (tid & 7) * 8;
  for (int tile = blockIdx.x; tile < ntiles; tile += gridDim.x) {
    const int mt = tile / NT, nt = tile - mt * NT;
    const int m0 = mt << 8, n0 = nt << 7;
    f32x4 acc[4][4];
#pragma unroll
    for (int i = 0; i < 4; ++i)
#pragma unroll
      for (int k = 0; k < 4; ++k) acc[i][k] = f32x4{0.f, 0.f, 0.f, 0.f};
    const u16* Ap = A + (size_t)(m0 + crow) * lda + ccol;
    const u16* Bp = Bt + (size_t)(n0 + crow) * K + ccol;
    uint4 ra[4], rb[2];
#pragma unroll
    for (int i = 0; i < 4; ++i) ra[i] = *(const uint4*)(Ap + (size_t)i * 64 * lda);
#pragma unroll
    for (int i = 0; i < 2; ++i) rb[i] = *(const uint4*)(Bp + (size_t)i * 64 * K);
#pragma unroll
    for (int i = 0; i < 4; ++i) *(uint4*)(As + (crow + 64 * i) * LSTR + ccol) = ra[i];
#pragma unroll
    for (int i = 0; i < 2; ++i) *(uint4*)(Bs + (crow + 64 * i) * LSTR + ccol) = rb[i];
    __syncthreads();
    for (int kt = 0; kt < nk; ++kt) {
      const int cur = kt & 1;
      if (kt + 1 < nk) {
        const int ko = (kt + 1) << 6;
#pragma unroll
        for (int i = 0; i < 4; ++i) ra[i] = *(const uint4*)(Ap + (size_t)i * 64 * lda + ko);
#pragma unroll
        for (int i = 0; i < 2; ++i) rb[i] = *(const uint4*)(Bp + (size_t)i * 64 * K + ko);
      }
      const u16* as = As + cur * 256 * LSTR + (wr * 64 + fr) * LSTR + fq * 8;
      const u16* bs = Bs + cur * 128 * LSTR + (wc * 64 + fr) * LSTR + fq * 8;
#pragma unroll
      for (int kk = 0; kk < 2; ++kk) {
        bf16x8 a[4], b[4];
#pragma unroll
        for (int i = 0; i < 4; ++i) {
          a[i] = *(const bf16x8*)(as + i * 16 * LSTR + kk * 32);
          b[i] = *(const bf16x8*)(bs + i * 16 * LSTR + kk * 32);
        }
#pragma unroll
        for (int mi = 0; mi < 4; ++mi)
#pragma unroll
          for (int ni = 0; ni < 4; ++ni) acc[mi][ni] = __builtin_amdgcn_mfma_f32_16x16x32_bf16(a[mi], b[ni], acc[mi][ni], 0, 0, 0);
      }
      if (kt + 1 < nk) {
        u16* asw = As + (cur ^ 1) * 256 * LSTR;
        u16* bsw = Bs + (cur ^ 1) * 128 * LSTR;
#pragma unroll
        for (int i = 0; i < 4; ++i) *(uint4*)(asw + (crow + 64 * i) * LSTR + ccol) = ra[i];
#pragma unroll
        for (int i = 0; i < 2; ++i) *(uint4*)(bsw + (crow + 64 * i) * LSTR + ccol) = rb[i];
      }
      __syncthreads();
    }
#pragma unroll
    for (int mi = 0; mi < 4; ++mi) {
      const int mb = m0 + wr * 64 + mi * 16 + fq * 4;
#pragma unroll
      for (int ni = 0; ni < 4; ++ni) {
        const int n = n0 + wc * 64 + ni * 16 + fr;
        if (EPI == 0) {
#pragma unroll
          for (int r = 0; r < 4; ++r) {
            float v = acc[mi][ni][r];
            if (flag) { v = fmaxf(v, 0.f); v = v * v; }
            C[(size_t)(mb + r) * ldc + n] = f2bf(v);
          }
        } else if (EPI == 1) {
          if (n0 < 1536) {
            uint2 pk;
            pk.x = pack2(acc[mi][ni][0], acc[mi][ni][1]);
            pk.y = pack2(acc[mi][ni][2], acc[mi][ni][3]);
            *(uint2*)(UT + (size_t)n * MTOK + mb) = pk;
          } else {
#pragma unroll
            for (int r = 0; r < 4; ++r) C[(size_t)(mb + r) * 2560 + (n - 1536)] = f2bf(acc[mi][ni][r]);
          }
        } else {
#pragma unroll
          for (int r = 0; r < 4; ++r) {
            const int m = mb + r;
            const int rm = flag ? perm_row(m) : m;
            float* xp = X + (size_t)rm * 1024 + n;
            *xp = ALPHA * (*xp) + gate[(size_t)mods_row(m) * 6144 + n] * acc[mi][ni][r];
          }
        }
      }
    }
  }
}

__device__ __forceinline__ void phase_xinit(const P& p, float* X, const float* mods0, u16* H) {
  const int lane = otid() & 63;
  const int gw = blockIdx.x * 8 + (otid() >> 6);
  for (int m = gw; m < MTOK; m += gridDim.x * 8) {
    const float* src = m < MCTX ? p.x_prompt + (size_t)m * 1024 : p.x_sample + (size_t)(m - MCTX) * 1024;
    const float* md = mods0 + (size_t)mods_row(m) * 6144;
#pragma unroll
    for (int i = 0; i < 4; ++i) {
      int col = lane * 4 + i * 256;
      float4 v = *(const float4*)(src + col);
      *(float4*)(X + (size_t)m * 1024 + col) = v;
      float4 sh = *(const float4*)(md + col);
      float4 sc = *(const float4*)(md + 1024 + col);
      uint2 pk;
      pk.x = pack2(v.x * (1.f + sc.x) + sh.x, v.y * (1.f + sc.y) + sh.y);
      pk.y = pack2(v.z * (1.f + sc.z) + sh.z, v.w * (1.f + sc.w) + sh.w);
      *(uint2*)(H + (size_t)m * 1024 + col) = pk;
    }
  }
}

__device__ __forceinline__ void phase_ln(float* X, const float* g, const float* b, const float* modl, int sh_off, int sc_off,
                                         u16* H, int write_h, int permflag) {
  const int lane = otid() & 63;
  const int gw = blockIdx.x * 8 + (otid() >> 6);
  for (int m = gw; m < MTOK; m += gridDim.x * 8) {
    float4 v[4];
    float s = 0.f;
#pragma unroll
    for (int i = 0; i < 4; ++i) {
      v[i] = *(const float4*)(X + (size_t)m * 1024 + lane * 4 + i * 256);
      s += v[i].x + v[i].y + v[i].z + v[i].w;
    }
    const float mean = wsum(s) * (1.f / 1024.f);
    float q = 0.f;
#pragma unroll
    for (int i = 0; i < 4; ++i) {
      v[i].x -= mean; v[i].y -= mean; v[i].z -= mean; v[i].w -= mean;
      q += v[i].x * v[i].x + v[i].y * v[i].y + v[i].z * v[i].z + v[i].w * v[i].w;
    }
    const float rstd = rsqrtf(wsum(q) * (1.f / 1024.f) + 1e-5f);
    const float* md = modl + (size_t)mods_row(m) * 6144;
    const int dst = permflag ? perm_row(m) : m;
#pragma unroll
    for (int i = 0; i < 4; ++i) {
      int col = lane * 4 + i * 256;
      float4 gg = *(const float4*)(g + col);
      float4 bb = *(const float4*)(b + col);
      float4 o;
      o.x = v[i].x * rstd * gg.x + bb.x; o.y = v[i].y * rstd * gg.y + bb.y;
      o.z = v[i].z * rstd * gg.z + bb.z; o.w = v[i].w * rstd * gg.w + bb.w;
      *(float4*)(X + (size_t)m * 1024 + col) = o;
      if (write_h) {
        float4 sh = *(const float4*)(md + sh_off + col);
        float4 sc = *(const float4*)(md + sc_off + col);
        uint2 pk;
        pk.x = pack2(o.x * (1.f + sc.x) + sh.x, o.y * (1.f + sc.y) + sh.y);
        pk.y = pack2(o.z * (1.f + sc.z) + sh.z, o.w * (1.f + sc.w) + sh.w);
        *(uint2*)(H + (size_t)dst * 1024 + col) = pk;
      }
    }
  }
}

__device__ __forceinline__ void phase_lru(const P& p, int j, const u16* __restrict__ proj, float* __restrict__ hfb,
                                          float* out_lru, int* ctr, char* smem) {
  float* XC = (float*)smem;
  float* GA = XC + 4096;
  float* GU = GA + 4096;
  float* WA = GU + 4096;
  float* WI = WA + 4096;
  float* cw = WI + 4096;
  float* cb = cw + 256;
  float* bba = cb + 64;
  float* bbi = bba + 64;
  float* spl = bbi + 64;
  int* sitem = (int*)(spl + 64);
  const int tid = otid();
  for (;;) {
    if (tid == 0) *sitem = atomicAdd(ctr, 1);
    __syncthreads();
    const int it = *sitem;
    __syncthreads();
    if (it >= 640) break;
    const int lat = it < 128;
    const int it2 = lat ? it : it - 128;
    const int b = it2 >> 4, hd = (it2 >> 1) & 7, d = it2 & 1;
    const int mbase = lat ? MCTX + b * 4096 : b * 256;
    const int Lseq = lat ? 4096 : 256;
    const int line = lat ? 64 : 256;
    const int nchunk = Lseq >> 6;
    for (int e = tid; e < 4096; e += NTHR) {
      WA[e] = p.lru_wa[((size_t)((j * 2 + d) * 8 + hd)) * 4096 + e];
      WI[e] = p.lru_wi[((size_t)((j * 2 + d) * 8 + hd)) * 4096 + e];
    }
    if (tid < 256) cw[tid] = p.lru_conv[(j * 4 + (tid >> 6)) * 512 + hd * 64 + (tid & 63)];
    if (tid < 64) {
      cb[tid] = p.lru_conv_b[j * 512 + hd * 64 + tid];
      bba[tid] = p.lru_ba[(j * 2 + d) * 512 + hd * 64 + tid];
      bbi[tid] = p.lru_bi[(j * 2 + d) * 512 + hd * 64 + tid];
      spl[tid] = softplusf_(-p.lru_lambda[(j * 2 + d) * 512 + hd * 64 + tid]);
    }
    float h = 0.f;
    if (tid < 64 && lat) h = p.state_lru[((size_t)(b * 2 + j) * 2 + d) * 512 + hd * 64 + tid];
    __syncthreads();
    for (int cc = 0; cc < nchunk; ++cc) {
      const int ci = d ? nchunk - 1 - cc : cc;
      const int s0 = ci << 6;
      for (int e = tid; e < 4096; e += NTHR) {
        int tok = e >> 6, ch = e & 63;
        int pos = (s0 + tok) & (line - 1);
        const u16* pr = proj + (size_t)(mbase + s0 + tok) * 2560 + 2048 + hd * 64 + ch;
        float a = cb[ch];
#pragma unroll
        for (int k = 0; k < 4; ++k) {
          int off = k - 2;
          if (pos + off >= 0 && pos + off < line) a += bf2f(pr[off * 2560]) * cw[k * 64 + ch];
        }
        XC[e] = a;
      }
      __syncthreads();
      {
        const int tok = tid >> 3, cg = (tid & 7) * 8;
        float ar[8], ai[8];
#pragma unroll
        for (int q = 0; q < 8; ++q) { ar[q] = bba[cg + q]; ai[q] = bbi[cg + q]; }
        for (int i = 0; i < 64; ++i) {
          float xv = XC[tok * 64 + i];
          float4 w0 = *(const float4*)(WA + i * 64 + cg), w1 = *(const float4*)(WA + i * 64 + cg + 4);
          float4 v0 = *(const float4*)(WI + i * 64 + cg), v1 = *(const float4*)(WI + i * 64 + cg + 4);
          ar[0] += xv * w0.x; ar[1] += xv * w0.y; ar[2] += xv * w0.z; ar[3] += xv * w0.w;
          ar[4] += xv * w1.x; ar[5] += xv * w1.y; ar[6] += xv * w1.z; ar[7] += xv * w1.w;
          ai[0] += xv * v0.x; ai[1] += xv * v0.y; ai[2] += xv * v0.z; ai[3] += xv * v0.w;
          ai[4] += xv * v1.x; ai[5] += xv * v1.y; ai[6] += xv * v1.z; ai[7] += xv * v1.w;
        }
#pragma unroll
        for (int q = 0; q < 8; ++q) {
          int ch = cg + q;
          float r = sigmoidf_(ar[q]);
          float ig = sigmoidf_(ai[q]);
          float la = -8.f * r * spl[ch];
          float a = __expf(la);
          float u = sqrtf(-expm1f(2.f * la)) * ig * XC[tok * 64 + ch];
          GA[tok * 64 + ch] = a;
          GU[tok * 64 + ch] = u;
        }
      }
      __syncthreads();
      if (tid < 64) {
        for (int tt = 0; tt < 64; ++tt) {
          int tok = d ? 63 - tt : tt;
          h = GA[tok * 64 + tid] * h + GU[tok * 64 + tid];
          GU[tok * 64 + tid] = h;
        }
      }
      __syncthreads();
      for (int e = tid; e < 4096; e += NTHR) {
        int tok = e >> 6, ch = e & 63;
        hfb[((size_t)(mbase + s0 + tok) * 2 + d) * 512 + hd * 64 + ch] = GU[e];
      }
    }
    if (!lat && tid < 64) out_lru[((size_t)(b * 2 + j) * 2 + d) * 512 + hd * 64 + tid] = h;
    __syncthreads();
  }
}

__device__ __forceinline__ void phase_abmix(const P& p, int j, const u16* __restrict__ proj, const float* __restrict__ hfb,
                                            u16* __restrict__ mix) {
  for (int e = blockIdx.x * NTHR + otid(); e < MTOK * 64; e += gridDim.x * NTHR) {
    const int m = e >> 6, c8 = (e & 63) * 8;
    const int line = m < MCTX ? 256 : 64;
    const int pos = m & (line - 1);
    const bool mL = pos > 0, mR = pos < line - 1;
    const u16* pr = proj + (size_t)m * 2560;
    uint4 sb = *(const uint4*)(pr + c8);
    uint4 sc0 = *(const uint4*)(pr + 512 + c8), sv0 = *(const uint4*)(pr + 1024 + c8);
    uint4 gg = *(const uint4*)(pr + 1536 + c8);
    uint4 z = make_uint4(0, 0, 0, 0);
    uint4 scl = mL ? *(const uint4*)(pr - 2560 + 512 + c8) : z, svl = mL ? *(const uint4*)(pr - 2560 + 1024 + c8) : z;
    uint4 scr = mR ? *(const uint4*)(pr + 2560 + 512 + c8) : z, svr = mR ? *(const uint4*)(pr + 2560 + 1024 + c8) : z;
    const u32* sbp = (const u32*)&sb; const u32* scp = (const u32*)&sc0; const u32* svp = (const u32*)&sv0;
    const u32* ggp = (const u32*)&gg; const u32* sclp = (const u32*)&scl; const u32* svlp = (const u32*)&svl;
    const u32* scrp = (const u32*)&scr; const u32* svrp = (const u32*)&svr;
    const float* hf = hfb + (size_t)m * 1024 + c8;
    float ya[8], yb[8];
#pragma unroll
    for (int q = 0; q < 8; ++q) {
      const int ch = c8 + q;
      const int w = q >> 1;
      const bool hi = q & 1;
      float s_b = hi ? bfhi(sbp[w]) : bflo(sbp[w]);
      float c1 = (hi ? bfhi(scp[w]) : bflo(scp[w])) * (hi ? bfhi(svp[w]) : bflo(svp[w]));
      float c0 = (hi ? bfhi(sclp[w]) : bflo(sclp[w])) * (hi ? bfhi(svlp[w]) : bflo(svlp[w]));
      float c2 = (hi ? bfhi(scrp[w]) : bflo(scrp[w])) * (hi ? bfhi(svrp[w]) : bflo(svrp[w]));
      float w0 = p.sc_conv[(j * 3 + 0) * 512 + ch], w1 = p.sc_conv[(j * 3 + 1) * 512 + ch], w2 = p.sc_conv[(j * 3 + 2) * 512 + ch];
      ya[q] = s_b * (c0 * w0 + c1 * w1 + c2 * w2);
      float g = hi ? bfhi(ggp[w]) : bflo(ggp[w]);
      float ge = 0.5f * g * (1.f + tanhf(0.7978845608028654f * (g + 0.044715f * g * g * g)));
      yb[q] = ge * (hf[q] + hf[512 + q]);
    }
    uint4 oa, ob;
    oa.x = pack2(ya[0], ya[1]); oa.y = pack2(ya[2], ya[3]); oa.z = pack2(ya[4], ya[5]); oa.w = pack2(ya[6], ya[7]);
    ob.x = pack2(yb[0], yb[1]); ob.y = pack2(yb[2], yb[3]); ob.z = pack2(yb[4], yb[5]); ob.w = pack2(yb[6], yb[7]);
    *(uint4*)(mix + (size_t)m * 1024 + c8) = oa;
    *(uint4*)(mix + (size_t)m * 1024 + 512 + c8) = ob;
  }
}

__device__ __forceinline__ void rwkv_item(const P& p, int j, int it, const u16* __restrict__ prw, u16* __restrict__ obuf,
                                          float* __restrict__ bonus, float* out_rwkv, char* smem) {
  float* RM = (float*)smem;
  float* KD = RM + 2048;
  float* VM = KD + 2048;
  float* KK = VM + 2048;
  float* WD = KK + 2048;
  float* KA = WD + 2048;
  float* TW = KA + 2048;
  float* LA = TW + 2048;
  float* OB = LA + 2048;
  float* W2S = OB + 2048;
  float* A2S = W2S + 4096;
  float* mur = A2S + 4096;
  float* muk = mur + 64;
  float* muv = muk + 64;
  float* kkp = muv + 64;
  float* kap = kkp + 64;
  float* rkp = kap + 64;
  float* w0p = rkp + 64;
  float* a0p = w0p + 64;
  const int tid = otid();
  const int lat = it < 128;
  const int it2 = lat ? it : it - 128;
  const int b = it2 >> 4, hd = (it2 >> 1) & 7, d = it2 & 1;
  const int mbase = lat ? MCTX + b * 4096 : b * 256;
  const int Lseq = lat ? 4096 : 256;
  const int line = lat ? 64 : 256;
  const int nchunk = Lseq >> 5;
  for (int e = tid; e < 4096; e += NTHR) {
    int u = e >> 6, ch = e & 63;
    W2S[e] = p.rw_w2[((size_t)(j * 2 + d) * 64 + u) * 512 + hd * 64 + ch];
    A2S[e] = p.rw_a2[((size_t)(j * 2 + d) * 64 + u) * 512 + hd * 64 + ch];
  }
  if (tid < 64) {
    int cidx = hd * 64 + tid;
    mur[tid] = p.rw_mu[(j * 4 + 0) * 512 + cidx];
    muk[tid] = p.rw_mu[(j * 4 + 1) * 512 + cidx];
    muv[tid] = p.rw_mu[(j * 4 + 2) * 512 + cidx];
    kkp[tid] = p.rw_kk[j * 512 + cidx];
    kap[tid] = p.rw_ka[j * 512 + cidx];
    rkp[tid] = p.rw_rk[(j * 8 + hd) * 64 + tid];
    w0p[tid] = p.rw_w0[(j * 2 + d) * 512 + cidx];
    a0p[tid] = p.rw_a0[(j * 2 + d) * 512 + cidx];
  }
  const int sv = tid >> 3, sq = tid & 7;
  float S[8];
  {
    const float* s0p = p.state_rwkv + ((((size_t)(b * 2 + j) * 2 + d) * 8 + hd) * 64 + sv) * 64 + sq * 8;
#pragma unroll
    for (int e = 0; e < 8; ++e) S[e] = lat ? s0p[e] : 0.f;
  }
  __syncthreads();
  for (int cc = 0; cc < nchunk; ++cc) {
    const int ci = d ? nchunk - 1 - cc : cc;
    const int s0 = ci << 5;
#pragma unroll
    for (int i = 0; i < 4; ++i) {
      const int e = tid + NTHR * i;
      const int tok = e >> 6, ch = e & 63;
      const int s = s0 + tok;
      const int pos = s & (line - 1);
      const float mL = pos > 0 ? 0.5f : 0.f, mR = pos < line - 1 ? 0.5f : 0.f;
      const u16* pr = prw + (size_t)(mbase + s) * 2560;
      const u16* pl = pos > 0 ? pr - 2560 : pr;
      const u16* pq = pos < line - 1 ? pr + 2560 : pr;
      {
        int col = hd * 64 + ch;
        float x0 = bf2f(pr[col]), xl = bf2f(pl[col]), xr = bf2f(pq[col]);
        RM[e] = x0 + (mL * xl + mR * xr - x0) * mur[ch];
        col += 512;
        x0 = bf2f(pr[col]); xl = bf2f(pl[col]); xr = bf2f(pq[col]);
        KD[e] = x0 + (mL * xl + mR * xr - x0) * muk[ch];
        col += 512;
        x0 = bf2f(pr[col]); xl = bf2f(pl[col]); xr = bf2f(pq[col]);
        VM[e] = x0 + (mL * xl + mR * xr - x0) * muv[ch];
      }
      {
        int col = 2048 + d * 256 + ch;
        float rw = bf2f(pr[col]);
        float q0 = bf2f(pr[col + 64]), ql = bf2f(pl[col + 64]), qr = bf2f(pq[col + 64]);
        TW[e] = tanhf(rw + mL * ql + mR * qr - q0);
        float ra_ = bf2f(pr[col + 128]);
        q0 = bf2f(pr[col + 192]); ql = bf2f(pl[col + 192]); qr = bf2f(pq[col + 192]);
        LA[e] = ra_ + mL * ql + mR * qr - q0;
      }
    }
    __syncthreads();
    {
      const int tok = tid >> 4, cg = (tid & 15) * 4;
      float aw[4] = {0.f, 0.f, 0.f, 0.f}, aa[4] = {0.f, 0.f, 0.f, 0.f};
      for (int u = 0; u < 64; ++u) {
        float t = TW[tok * 64 + u], l = LA[tok * 64 + u];
        float4 w4 = *(const float4*)(W2S + u * 64 + cg);
        float4 a4 = *(const float4*)(A2S + u * 64 + cg);
        aw[0] += t * w4.x; aw[1] += t * w4.y; aw[2] += t * w4.z; aw[3] += t * w4.w;
        aa[0] += l * a4.x; aa[1] += l * a4.y; aa[2] += l * a4.z; aa[3] += l * a4.w;
      }
      float ss = 0.f, bon = 0.f;
      float av[4], kkv[4];
#pragma unroll
      for (int q = 0; q < 4; ++q) {
        const int ch = cg + q;
        float wraw = -softplusf_(-(w0p[ch] + aw[q])) - 0.5f;
        float dec = __expf(-__expf(wraw));
        float a = sigmoidf_(a0p[ch] + aa[q]);
        float km = KD[tok * 64 + ch];
        float kv = km * kkp[ch];
        ss += kv * kv;
        float kd = km * (1.f + (a - 1.f) * kap[ch]);
        bon += RM[tok * 64 + ch] * kd * rkp[ch];
        WD[tok * 64 + ch] = dec;
        KD[tok * 64 + ch] = kd;
        av[q] = a;
        kkv[q] = kv;
      }
#pragma unroll
      for (int o = 1; o < 16; o <<= 1) { ss += __shfl_xor(ss, o); bon += __shfl_xor(bon, o); }
      const float inv = rsqrtf(ss + 1e-12f);
#pragma unroll
      for (int q = 0; q < 4; ++q) {
        float kk = kkv[q] * inv;
        KK[tok * 64 + cg + q] = kk;
        KA[tok * 64 + cg + q] = kk * av[q];
      }
      if ((tid & 15) == 0) bonus[((size_t)(mbase + s0 + tok) * 2 + d) * 8 + hd] = bon;
    }
    __syncthreads();
    for (int tt = 0; tt < 32; ++tt) {
      const int tok = d ? 31 - tt : tt;
      const int o8 = tok * 64 + sq * 8;
      float4 k0 = *(const float4*)(KK + o8), k1 = *(const float4*)(KK + o8 + 4);
      float sa = S[0] * k0.x + S[1] * k0.y + S[2] * k0.z + S[3] * k0.w + S[4] * k1.x + S[5] * k1.y + S[6] * k1.z + S[7] * k1.w;
      sa += __shfl_xor(sa, 1); sa += __shfl_xor(sa, 2); sa += __shfl_xor(sa, 4);
      const float vv = VM[tok * 64 + sv];
      float4 w0 = *(const float4*)(WD + o8), w1 = *(const float4*)(WD + o8 + 4);
      float4 b0 = *(const float4*)(KA + o8), b1 = *(const float4*)(KA + o8 + 4);
      float4 d0 = *(const float4*)(KD + o8), d1 = *(const float4*)(KD + o8 + 4);
      float4 r0 = *(const float4*)(RM + o8), r1 = *(const float4*)(RM + o8 + 4);
      S[0] = S[0] * w0.x - sa * b0.x + vv * d0.x; S[1] = S[1] * w0.y - sa * b0.y + vv * d0.y;
      S[2] = S[2] * w0.z - sa * b0.z + vv * d0.z; S[3] = S[3] * w0.w - sa * b0.w + vv * d0.w;
      S[4] = S[4] * w1.x - sa * b1.x + vv * d1.x; S[5] = S[5] * w1.y - sa * b1.y + vv * d1.y;
      S[6] = S[6] * w1.z - sa * b1.z + vv * d1.z; S[7] = S[7] * w1.w - sa * b1.w + vv * d1.w;
      float o = S[0] * r0.x + S[1] * r0.y + S[2] * r0.z + S[3] * r0.w + S[4] * r1.x + S[5] * r1.y + S[6] * r1.z + S[7] * r1.w;
      o += __shfl_xor(o, 1); o += __shfl_xor(o, 2); o += __shfl_xor(o, 4);
      if (sq == 0) OB[tok * 64 + sv] = o;
    }
    __syncthreads();
#pragma unroll
    for (int i = 0; i < 4; ++i) {
      const int e = tid + NTHR * i;
      const int tok = e >> 6, ch = e & 63;
      obuf[((size_t)(mbase + s0 + tok) * 2 + d) * 512 + hd * 64 + ch] = f2bf(OB[e]);
    }
  }
  if (!lat) {
    float* dst = out_rwkv + ((((size_t)(b * 2 + j) * 2 + d) * 8 + hd) * 64 + sv) * 64 + sq * 8;
#pragma unroll
    for (int e = 0; e < 8; ++e) dst[e] = S[e];
  }
  __syncthreads();
}

template <int GRP>
struct HyCfg {
  static constexpr int NB = GRP == 0 ? 8 : 32;
  static constexpr int NBLK = GRP == 0 ? 64 : 4;
  static constexpr int LSEQ = GRP == 0 ? 4096 : 256;
  static constexpr int NTW = GRP == 0 ? 4 : 1;
  static constexpr int MB = GRP == 0 ? MCTX : 0;
  static constexpr int LINE = GRP == 0 ? 64 : 256;
};

template <int GRP>
__device__ __forceinline__ void hyena_conv(const u16* ZS, const float* FL, f32x4 (&acc)[4][HyCfg<GRP>::NTW], int wave, int fr,
                                           int fq) {
  typedef HyCfg<GRP> Cf;
  const int colw0 = wave * Cf::NTW * 16;
  const int i_lo = colw0 / Cf::NB, i_hi = (colw0 + Cf::NTW * 16 - 1) / Cf::NB;
#pragma unroll 1
  for (int d = -(Cf::NBLK - 1); d <= Cf::NBLK - 1; ++d) {
    if (i_hi - d < 0 || i_lo - d > Cf::NBLK - 1) continue;
#pragma unroll
    for (int ks = 0; ks < 2; ++ks) {
      bf16x8 af[4];
#pragma unroll
      for (int mb = 0; mb < 4; ++mb) {
        const float* fp = FL + Cf::LSEQ + (32 * ks + 8 * fq) - (16 * mb + fr) - 64 * d;
        u32 w0 = (__float_as_uint(fp[0]) >> 16) | (__float_as_uint(fp[1]) & 0xffff0000u);
        u32 w1 = (__float_as_uint(fp[2]) >> 16) | (__float_as_uint(fp[3]) & 0xffff0000u);
        u32 w2 = (__float_as_uint(fp[4]) >> 16) | (__float_as_uint(fp[5]) & 0xffff0000u);
        u32 w3 = (__float_as_uint(fp[6]) >> 16) | (__float_as_uint(fp[7]) & 0xffff0000u);
        uint4 t = make_uint4(w0, w1, w2, w3);
        af[mb] = *(bf16x8*)&t;
      }
#pragma unroll
      for (int nt = 0; nt < Cf::NTW; ++nt) {
        const int colg0 = colw0 + nt * 16;
        const int t_lo = colg0 / Cf::NB, t_hi = (colg0 + 15) / Cf::NB;
        if (t_hi - d < 0 || t_lo - d > Cf::NBLK - 1) continue;
        const int colg = colg0 + fr;
        const int i = colg / Cf::NB, b = colg % Cf::NB;
        const int k = i - d;
        const bool valid = (k >= 0) && (k < Cf::NBLK);
        uint4 t = make_uint4(0, 0, 0, 0);
        if (valid) t = *(const uint4*)(ZS + b * Cf::LSEQ + 64 * k + 32 * ks + 8 * fq);
        bf16x8 bfv = *(bf16x8*)&t;
#pragma unroll
        for (int mb = 0; mb < 4; ++mb) acc[mb][nt] = __builtin_amdgcn_mfma_f32_16x16x32_bf16(af[mb], bfv, acc[mb][nt], 0, 0, 0);
      }
      asm volatile("" ::: "memory");
    }
  }
}

template <int GRP>
__device__ __forceinline__ void hyena_item(const P& p, int j, int c, u16* UT, const u16* FILT,
                                           const float* SUMSQ, char* smem) {
  typedef HyCfg<GRP> Cf;
  u16* ZS = (u16*)smem;
  float* FL = (float*)(smem + 65536);
  constexpr int FLEN = 2 * Cf::LSEQ;
  const u16* filt0 = FILT + (GRP == 0 ? (size_t)0 : (size_t)2 * 512 * 8192);
  const int tid = otid(), wave = tid >> 6, lane = tid & 63, fr = lane & 15, fq = lane >> 4;
  const size_t MM = MTOK;
  {
    const float h0 = p.hy_conv[(j * 3 + 0) * 1536 + c], h1 = p.hy_conv[(j * 3 + 1) * 1536 + c], h2 = p.hy_conv[(j * 3 + 2) * 1536 + c];
    const u16* ur = UT + (size_t)c * MM + Cf::MB;
#pragma unroll 2
    for (int e = tid; e < Cf::NB * Cf::LSEQ; e += NTHR) {
      const int pos = e & (Cf::LINE - 1);
      float v = bf2f(ur[e]) * h1;
      if (pos > 0) v += bf2f(ur[e - 1]) * h0;
      if (pos < Cf::LINE - 1) v += bf2f(ur[e + 1]) * h2;
      ZS[e] = f2bf(v);
    }
    const u16* f = filt0 + (size_t)(0 * 512 + c) * FLEN;
#pragma unroll 2
    for (int e = tid; e < FLEN; e += NTHR) FL[e] = bf2f(f[e]);
  }
  __syncthreads();
  f32x4 acc[4][Cf::NTW];
#pragma unroll
  for (int mb = 0; mb < 4; ++mb)
#pragma unroll
    for (int nt = 0; nt < Cf::NTW; ++nt) acc[mb][nt] = f32x4{0.f, 0.f, 0.f, 0.f};
  hyena_conv<GRP>(ZS, FL, acc, wave, fr, fq);
  {
    const float scale = rsqrtf(SUMSQ[((j * 2 + GRP) * 2 + 0) * 512 + c] + 1e-6f);
    const float bias = p.hy_bias[(j * 2 + 0) * 512 + c];
    const float g0 = p.hy_conv[(j * 3 + 0) * 1536 + 512 + c], g1 = p.hy_conv[(j * 3 + 1) * 1536 + 512 + c],
                g2 = p.hy_conv[(j * 3 + 2) * 1536 + 512 + c];
    const u16* u1 = UT + (size_t)(512 + c) * MM + Cf::MB;
#pragma unroll
    for (int mb = 0; mb < 4; ++mb)
#pragma unroll
      for (int nt = 0; nt < Cf::NTW; ++nt) {
        const int colg = (wave * Cf::NTW + nt) * 16 + fr;
        const int i = colg / Cf::NB, b = colg % Cf::NB;
        {
          const int t0 = 64 * i + 16 * mb + 4 * fq;
          const int e0 = b * Cf::LSEQ + t0;
          const uint2 raw = *(const uint2*)(u1 + e0);
          const uint2 zr = *(const uint2*)(ZS + e0);
          const float xm = ((t0 & (Cf::LINE - 1)) > 0) ? bf2f(u1[e0 - 1]) : 0.f;
          const float xp = (((t0 + 3) & (Cf::LINE - 1)) < Cf::LINE - 1) ? bf2f(u1[e0 + 4]) : 0.f;
          const float x0 = bflo(raw.x), x1 = bfhi(raw.x), x2 = bflo(raw.y), x3 = bfhi(raw.y);
          acc[mb][nt][0] = (x0 * g1 + xm * g0 + x1 * g2) * (scale * acc[mb][nt][0] + bias * bflo(zr.x));
          acc[mb][nt][1] = (x1 * g1 + x0 * g0 + x2 * g2) * (scale * acc[mb][nt][1] + bias * bfhi(zr.x));
          acc[mb][nt][2] = (x2 * g1 + x1 * g0 + x3 * g2) * (scale * acc[mb][nt][2] + bias * bflo(zr.y));
          acc[mb][nt][3] = (x3 * g1 + x2 * g0 + xp * g2) * (scale * acc[mb][nt][3] + bias * bfhi(zr.y));
          asm volatile("" : "+v"(acc[mb][nt]) : : "memory");
          __builtin_amdgcn_sched_barrier(0);
        }
      }
  }
  __syncthreads();
#pragma unroll
  for (int mb = 0; mb < 4; ++mb)
#pragma unroll
    for (int nt = 0; nt < Cf::NTW; ++nt) {
      const int colg = (wave * Cf::NTW + nt) * 16 + fr;
      const int i = colg / Cf::NB, b = colg % Cf::NB;
      const int e0 = b * Cf::LSEQ + 64 * i + 16 * mb + 4 * fq;
      uint2 pk;
      pk.x = pack2(acc[mb][nt][0], acc[mb][nt][1]);
      pk.y = pack2(acc[mb][nt][2], acc[mb][nt][3]);
      *(uint2*)(ZS + e0) = pk;
      acc[mb][nt] = f32x4{0.f, 0.f, 0.f, 0.f};
    }
  {
    const u16* f = filt0 + (size_t)(1 * 512 + c) * FLEN;
#pragma unroll 2
    for (int e = tid; e < FLEN; e += NTHR) FL[e] = bf2f(f[e]);
  }
  __syncthreads();
  hyena_conv<GRP>(ZS, FL, acc, wave, fr, fq);
  {
    const float scale = rsqrtf(SUMSQ[((j * 2 + GRP) * 2 + 1) * 512 + c] + 1e-6f);
    const float bias = p.hy_bias[(j * 2 + 1) * 512 + c];
    const float g0 = p.hy_conv[(j * 3 + 0) * 1536 + 1024 + c], g1 = p.hy_conv[(j * 3 + 1) * 1536 + 1024 + c],
                g2 = p.hy_conv[(j * 3 + 2) * 1536 + 1024 + c];
    const u16* u2 = UT + (size_t)(1024 + c) * MM + Cf::MB;
    u16* yo = UT + (size_t)c * MM + Cf::MB;
#pragma unroll
    for (int mb = 0; mb < 4; ++mb)
#pragma unroll
      for (int nt = 0; nt < Cf::NTW; ++nt) {
        const int colg = (wave * Cf::NTW + nt) * 16 + fr;
        const int i = colg / Cf::NB, b = colg % Cf::NB;
        float y[4];
        const int t0 = 64 * i + 16 * mb + 4 * fq;
        const int e0 = b * Cf::LSEQ + t0;
        {
          const uint2 raw = *(const uint2*)(u2 + e0);
          const uint2 zr = *(const uint2*)(ZS + e0);
          const float xm = ((t0 & (Cf::LINE - 1)) > 0) ? bf2f(u2[e0 - 1]) : 0.f;
          const float xp = (((t0 + 3) & (Cf::LINE - 1)) < Cf::LINE - 1) ? bf2f(u2[e0 + 4]) : 0.f;
          const float x0 = bflo(raw.x), x1 = bfhi(raw.x), x2 = bflo(raw.y), x3 = bfhi(raw.y);
          y[0] = (x0 * g1 + xm * g0 + x1 * g2) * (scale * acc[mb][nt][0] + bias * bflo(zr.x));
          y[1] = (x1 * g1 + x0 * g0 + x2 * g2) * (scale * acc[mb][nt][1] + bias * bfhi(zr.x));
          y[2] = (x2 * g1 + x1 * g0 + x3 * g2) * (scale * acc[mb][nt][2] + bias * bflo(zr.y));
          y[3] = (x3 * g1 + x2 * g0 + xp * g2) * (scale * acc[mb][nt][3] + bias * bfhi(zr.y));
        }
        uint2 pk;
        pk.x = pack2(y[0], y[1]);
        pk.y = pack2(y[2], y[3]);
        *(uint2*)(yo + e0) = pk;
        asm volatile("" ::: "memory");
        __builtin_amdgcn_sched_barrier(0);
      }
  }
  __syncthreads();
}

__device__ __forceinline__ void phase_cdscan(const P& p, int j, const u16* prw, u16* obuf, float* bonus, float* out_rwkv, u16* UT,
                                             const u16* FILT, const float* SUMSQ, int* ctr, char* smem) {
  int* sitem = (int*)(smem + SMEM_BYTES - 16);
  for (;;) {
    if (otid() == 0) *sitem = atomicAdd(ctr, 1);
    __syncthreads();
    const int it = *sitem;
    __syncthreads();
    if (it >= 640 + 1024) break;
    if (it < 640) {
#ifndef NO_RW
      rwkv_item(p, j, it, prw, obuf, bonus, out_rwkv, smem);
#endif
    } else if (it < 640 + 512) {
#ifndef NO_HY0
      hyena_item<0>(p, j, it - 640, UT, FILT, SUMSQ, smem);
#endif
    } else {
#ifndef NO_HY1
      hyena_item<1>(p, j, it - 1152, UT, FILT, SUMSQ, smem);
#endif
    }
  }
}

__device__ __forceinline__ void phase_cdfinal(const P& p, int j, const u16* __restrict__ prw, const u16* __restrict__ obuf,
                                              const float* __restrict__ bonus, const u16* __restrict__ UT, u16* __restrict__ mix,
                                              char* smem) {
  const int tid = otid(), lane = tid & 63;
  {
    const int gw = blockIdx.x * 8 + (tid >> 6);
    for (int wi = gw; wi < MTOK * 8; wi += gridDim.x * 8) {
      const int m = wi >> 3, hd = wi & 7;
      const int cidx = hd * 64 + lane;
      float o = bf2f(obuf[((size_t)m * 2 + 0) * 512 + cidx]) + bf2f(obuf[((size_t)m * 2 + 1) * 512 + cidx]);
      const float mean = wsum(o) * (1.f / 64.f);
      const float oc = o - mean;
      const float var = wsum(oc * oc) * (1.f / 64.f);
      const float on = oc * rsqrtf(var + 64e-5f) * p.rw_gn_g[j * 512 + cidx] + p.rw_gn_b[j * 512 + cidx];
      const int line = m < MCTX ? 256 : 64;
      const int pos = m & (line - 1);
      const float mL = pos > 0 ? 0.5f : 0.f, mR = pos < line - 1 ? 0.5f : 0.f;
      const u16* pr = prw + (size_t)m * 2560;
      const u16* pl = pos > 0 ? pr - 2560 : pr;
      const u16* pq = pos < line - 1 ? pr + 2560 : pr;
      float x0 = bf2f(pr[1024 + cidx]), xl = bf2f(pl[1024 + cidx]), xr = bf2f(pq[1024 + cidx]);
      const float vm = x0 + (mL * xl + mR * xr - x0) * p.rw_mu[(j * 4 + 2) * 512 + cidx];
      x0 = bf2f(pr[1536 + cidx]); xl = bf2f(pl[1536 + cidx]); xr = bf2f(pq[1536 + cidx]);
      const float gm = x0 + (mL * xl + mR * xr - x0) * p.rw_mu[(j * 4 + 3) * 512 + cidx];
      const float bon = bonus[((size_t)m * 2 + 0) * 8 + hd] + bonus[((size_t)m * 2 + 1) * 8 + hd];
      const float y = (on + bon * vm) * sigmoidf_(gm);
      mix[(size_t)m * 1024 + 512 + cidx] = f2bf(y);
    }
  }
  {
    u16* tl = (u16*)smem;
    for (int t = blockIdx.x; t < 640 * 8; t += gridDim.x) {
      const int mt = t >> 3, ct = t & 7;
      for (int e = tid; e < 4096; e += NTHR) {
        int cc = e >> 6, mm = e & 63;
        tl[cc * 66 + mm] = UT[(size_t)(ct * 64 + cc) * MTOK + mt * 64 + mm];
      }
      __syncthreads();
      for (int e = tid; e < 4096; e += NTHR) {
        int mm = e >> 6, cc = e & 63;
        mix[(size_t)(mt * 64 + mm) * 1024 + ct * 64 + cc] = tl[cc * 66 + mm];
      }
      __syncthreads();
    }
  }
}

#ifndef PHMASK
#define PHMASK 0xffffffffu
#endif
#define PHS(b) ((PHMASK >> (b)) & 1u)
__global__ void __launch_bounds__(NTHR) fwd_megakernel(P p, int ph_begin, int ph_end) {
  extern __shared__ __attribute__((aligned(16))) char smem[];
  cg::grid_group grid = cg::this_grid();
  char* ws = p.ws;
  float* mods = (float*)(ws + OFF_MODS);
  float* bonus = (float*)(ws + OFF_BONUS);
  float* HID2 = (float*)(ws + OFF_HID2);
  float* SUMSQ = (float*)(ws + OFF_SUMSQ);
  int* CTR = (int*)(ws + OFF_CTR);
  u16* WIN = (u16*)(ws + OFF_WIN);
  u16* WOUT = (u16*)(ws + OFF_WOUT);
  u16* W1T = (u16*)(ws + OFF_W1T);
  u16* W2T = (u16*)(ws + OFF_W2T);
  u16* FILT = (u16*)(ws + OFF_FILT);
  u16* H = (u16*)(ws + OFF_H);
  char* arena = ws + OFF_ARENA;
  float* X = p.out;
  float* out_lru = p.out + (size_t)MTOK * 1024;
  float* out_rwkv = out_lru + 32 * 2 * 2 * 512;
  float* smf = (float*)smem;

  for (int ph = ph_begin; ph < ph_end; ++ph) {
    if (ph == 0) {
      if (blockIdx.x == 0 && otid() < 16) CTR[otid()] = 0;
      for (int i = blockIdx.x * NTHR + otid(); i < 2 * 2 * 2 * 512; i += gridDim.x * NTHR) SUMSQ[i] = 0.f;
      if (PHS(0)) phase_mods(p, mods, smf);
      __syncthreads();
      if (PHS(1)) phase_hid2(p, HID2, smf);
      if (PHS(2)) { conv_mix_weights(p, 0, ws, smf);
      conv_mlp_weights(p, 0, ws, smf); }
    } else if (ph == 1) {
      if (PHS(3)) phase_xinit(p, X, mods, H);
      if (PHS(4)) phase_filtgen(p, 0, HID2, FILT, SUMSQ, smf);
    } else {
      const int l = (ph - 2) >> 3, s = (ph - 2) & 7;
      const int j = l >> 1;
      const bool cd = l & 1;
      const float* modl = mods + (size_t)l * 9 * 6144;
      if (s == 0) {
        if (!cd) {
          if (PHS(5)) gemm_phase<0>(H, 1024, WIN, 1024, 2560, (u16*)arena, 2560, 0, nullptr, nullptr, nullptr, smem);
          if (l == 2 && PHS(4)) phase_filtgen(p, 1, HID2, FILT, SUMSQ, smf);
        } else {
          if (PHS(6)) gemm_phase<1>(H, 1024, WIN, 1024, 4096, (u16*)arena, 2560, 0, (u16*)(arena + ARENA_B), nullptr, nullptr, smem);
        }
        if (l > 0 && PHS(2)) conv_mlp_weights(p, l, ws, smf);
      } else if (s == 1) {
        if (!cd) { if (PHS(7)) phase_lru(p, j, (const u16*)arena, (float*)(arena + ARENA_B), out_lru, CTR + l, smem); }
        else if (PHS(8)) phase_cdscan(p, j, (const u16*)arena, H, bonus, out_rwkv, (u16*)(arena + ARENA_B), FILT, SUMSQ, CTR + l, smem);
      } else if (s == 2) {
        if (!cd) { if (PHS(9)) phase_abmix(p, j, (const u16*)arena, (const float*)(arena + ARENA_B), H); }
        else if (PHS(10)) phase_cdfinal(p, j, (const u16*)arena, H, bonus, (const u16*)(arena + ARENA_B),
                           (u16*)(arena + ARENA_B) + (size_t)512 * MTOK, smem);
      } else if (s == 3) {
        const u16* mixp = cd ? (const u16*)(arena + ARENA_B) + (size_t)512 * MTOK : H;
        if (PHS(11)) gemm_phase<2>(mixp, 1024, WOUT, 1024, 1024, nullptr, 0, cd ? 1 : 0, nullptr, X, modl + 2048, smem);
      } else if (s == 4) {
        if (PHS(12)) phase_ln(X, p.ln1_g + l * 1024, p.ln1_b + l * 1024, modl, 3072, 4096, H, 1, 0);
      } else if (s == 5) {
        if (PHS(5)) gemm_phase<0>(H, 1024, W1T, 1024, 4096, (u16*)arena, 4096, 1, nullptr, nullptr, nullptr, smem);
        if (l < 3 && PHS(2)) conv_mix_weights(p, l + 1, ws, smf);
      } else if (s == 6) {
        if (PHS(11)) gemm_phase<2>((const u16*)arena, 4096, W2T, 4096, 1024, nullptr, 0, 0, nullptr, X, modl + 5120, smem);
      } else {
        const float* modn = mods + (size_t)(l + 1) * 9 * 6144;
        if (PHS(12)) phase_ln(X, p.ln2_g + l * 1024, p.ln2_b + l * 1024, l < 3 ? modn : modl, 0, 1024, H, l < 3 ? 1 : 0, ((l + 1) & 1));
      }
    }
    if (ph + 1 < ph_end) grid.sync();
  }
}

extern "C" void kernel_launch(void* const* d_in, const int* in_sizes, int n_in, void* d_out, int out_size, void* d_ws,
                              size_t ws_size, hipStream_t stream) {
  static int grid_blocks = 0;
  if (!grid_blocks) {
    int dev = 0, cus = 0, per_cu = 0;
    hipGetDevice(&dev);
    hipDeviceGetAttribute(&cus, hipDeviceAttributeMultiprocessorCount, dev);
    hipFuncSetAttribute((const void*)fwd_megakernel, hipFuncAttributeMaxDynamicSharedMemorySize, SMEM_BYTES);
    hipOccupancyMaxActiveBlocksPerMultiprocessor(&per_cu, fwd_megakernel, NTHR, SMEM_BYTES);
    if (per_cu < 1) per_cu = 1;
    grid_blocks = cus * per_cu;
  }
  if (ws_size < WS_NEED) fprintf(stderr, "workspace too small: %zu < %llu\n", ws_size, (unsigned long long)WS_NEED);
  P p{};
  const float** pp = (const float**)&p;
  for (int i = 0; i < 46; ++i) pp[i] = (const float*)d_in[i];
  p.out = (float*)d_out;
  p.ws = (char*)d_ws;
  int ph0 = 0, ph1 = 34;
  void* args[] = {&p, &ph0, &ph1};
  hipError_t e = hipLaunchCooperativeKernel((void*)fwd_megakernel, dim3(grid_blocks), dim3(NTHR), args, SMEM_BYTES, stream);
  if (e != hipSuccess) fprintf(stderr, "cooperative launch failed: %s (grid %d)\n", hipGetErrorString(e), grid_blocks);
}
```

```cpp
#include <hip/hip_runtime.h>
#include <hip/hip_bf16.h>
#include <hip/hip_cooperative_groups.h>
#include <cstdio>
namespace cg = cooperative_groups;

typedef unsigned short u16;
typedef unsigned int u32;
using bf16x8 = __attribute__((ext_vector_type(8))) short;
using f32x4 = __attribute__((ext_vector_type(4))) float;

#define REP_G 1
#define REP_E2 1
#define REP_FG 1
#define REP_LN 1
#define REP_HY 1
#define REP_SYNC 1
#define REP_O 1
#define REP_M2 0
#define REP_RW 1
#define REP_LRU 1
#define NTHR 512
#define MTOK 40960
#define MCTX 8192
#define ALPHA 1.6817928305074292f
#define SMEM_BYTES 122880

struct P {
  const float *x_prompt, *x_sample, *state_lru, *state_rwkv, *c, *c_ctx, *w_mod, *b_mod, *ln1_g, *ln1_b, *ln2_g, *ln2_b,
      *mlp_w1, *mlp_w2, *w_out, *ab_w_in, *sc_conv, *lru_conv, *lru_conv_b, *lru_wa, *lru_ba, *lru_wi, *lru_bi, *lru_lambda,
      *cd_w_in, *hy_conv, *hy_w1, *hy_b1, *hy_w2, *hy_b2, *hy_w3, *hy_freq, *hy_bias, *rw_mu, *rw_mu_x, *rw_w0, *rw_w1, *rw_w2,
      *rw_a0, *rw_a1, *rw_a2, *rw_kk, *rw_ka, *rw_rk, *rw_gn_g, *rw_gn_b;
  float* out;
  char* ws;
};

#define MiB (1024ull * 1024ull)
#define OFF_MODS (0ull)
#define OFF_BONUS (1ull * MiB)
#define OFF_HID2 (4ull * MiB)
#define OFF_SUMSQ (7ull * MiB)
#define OFF_CTR (7ull * MiB + 65536ull)
#define OFF_WIN (8ull * MiB)
#define OFF_WOUT (16ull * MiB)
#define OFF_W1T (18ull * MiB)
#define OFF_W2T (26ull * MiB)
#define OFF_FILT (34ull * MiB)
#define OFF_H (52ull * MiB)
#define OFF_ARENA (132ull * MiB)
#define ARENA_B (200ull * MiB)
#define WS_NEED (492ull * MiB)

__device__ __forceinline__ int otid() {
  int t = threadIdx.x;
  asm volatile("" : "+v"(t));
  return t;
}
__device__ __forceinline__ u16 f2bf(float f) {
  u32 u = __float_as_uint(f);
  u += 0x7fffu + ((u >> 16) & 1u);
  return (u16)(u >> 16);
}
__device__ __forceinline__ float bf2f(u16 h) { return __uint_as_float(((u32)h) << 16); }
__device__ __forceinline__ float bflo(u32 u) { return __uint_as_float(u << 16); }
__device__ __forceinline__ float bfhi(u32 u) { return __uint_as_float(u & 0xffff0000u); }
__device__ __forceinline__ u32 pack2(float a, float b) { return (u32)f2bf(a) | ((u32)f2bf(b) << 16); }
__device__ __forceinline__ float sigmoidf_(float x) { return 1.f / (1.f + __expf(-x)); }
__device__ __forceinline__ float softplusf_(float x) { return fmaxf(x, 0.f) + log1pf(__expf(-fabsf(x))); }
__device__ __forceinline__ float wsum(float v) {
#pragma unroll
  for (int o = 32; o > 0; o >>= 1) v += __shfl_xor(v, o);
  return v;
}
__device__ __forceinline__ int mods_row(int m) { return m < MCTX ? 0 : 1 + ((m - MCTX) >> 12); }
__device__ __forceinline__ int perm_row(int m) {
  if (m < MCTX) return m;
  int t = m - MCTX;
  int b = t >> 12, s = t & 4095;
  return MCTX + (b << 12) + ((s & 63) << 6) + (s >> 6);
}

__device__ __forceinline__ void phase_mods(const P& p, float* mods, float* sm) {
  float* sc = sm;
  float* red = sm + 9 * 1024;
  const int tid = otid();
  for (int i = tid; i < 9 * 1024; i += NTHR) {
    int r = i >> 10, k = i & 1023;
    float v = (r == 0) ? p.c_ctx[k] : p.c[(r - 1) * 1024 + k];
    sc[i] = v / (1.f + __expf(-v));
  }
  __syncthreads();
  const int nl = tid & 63, ks = tid >> 6;
  for (int it = blockIdx.x; it < 4 * 96; it += gridDim.x) {
    int l = it / 96, ng = it % 96;
    int n = ng * 64 + nl;
    const float* w = p.w_mod + (size_t)l * 1024 * 6144 + n;
    float a0 = 0, a1 = 0, a2 = 0, a3 = 0, a4 = 0, a5 = 0, a6 = 0, a7 = 0, a8 = 0;
#pragma unroll 4
    for (int k = ks * 128; k < ks * 128 + 128; ++k) {
      float wv = w[(size_t)k * 6144];
      a0 += sc[k] * wv; a1 += sc[1024 + k] * wv; a2 += sc[2048 + k] * wv; a3 += sc[3072 + k] * wv;
      a4 += sc[4096 + k] * wv; a5 += sc[5120 + k] * wv; a6 += sc[6144 + k] * wv; a7 += sc[7168 + k] * wv;
      a8 += sc[8192 + k] * wv;
    }
    red[(ks * 9 + 0) * 64 + nl] = a0; red[(ks * 9 + 1) * 64 + nl] = a1; red[(ks * 9 + 2) * 64 + nl] = a2;
    red[(ks * 9 + 3) * 64 + nl] = a3; red[(ks * 9 + 4) * 64 + nl] = a4; red[(ks * 9 + 5) * 64 + nl] = a5;
    red[(ks * 9 + 6) * 64 + nl] = a6; red[(ks * 9 + 7) * 64 + nl] = a7; red[(ks * 9 + 8) * 64 + nl] = a8;
    __syncthreads();
    for (int o = tid; o < 9 * 64; o += NTHR) {
      int r = o >> 6, cc = o & 63;
      float s = 0;
#pragma unroll
      for (int q = 0; q < 8; ++q) s += red[(q * 9 + r) * 64 + cc];
      int nn = ng * 64 + cc;
      mods[(size_t)(l * 9 + r) * 6144 + nn] = s + p.b_mod[l * 6144 + nn];
    }
    __syncthreads();
  }
}

__device__ __forceinline__ void phase_hid2(const P& p, float* HID2, float* sm) {
  float* ft = sm;
  float* h1s = sm + 8 * 36;
  const int tid = otid();
  for (int it = blockIdx.x; it < 2 * 544; it += gridDim.x) {
    int j = it / 544, rg = it % 544;
    int row0 = rg * 8;
    if (tid < 8 * 33) {
      int r = tid / 33, f = tid % 33;
      int row = row0 + r;
      int L = row < 4096 ? 4096 : 256;
      int lag = row < 4096 ? row : row - 4096;
      float val;
      if (f == 0) val = (float)lag / (float)(L - 1);
      else {
        int bi = (f - 1) & 15;
        float band = 1e-4f + (float)bi * ((15.f - 1e-4f) / 15.f);
        float ang = (6.283185307179586f / (float)L) * (float)lag * band;
        val = (f <= 16) ? cosf(ang) : -sinf(ang);
      }
      ft[r * 36 + f] = val;
    }
    __syncthreads();
    int rl = tid >> 6, u = tid & 63;
    float fr = p.hy_freq[j * 64 + u];
    float h1 = p.hy_b1[j * 64 + u];
    for (int f = 0; f < 33; ++f) h1 += ft[rl * 36 + f] * p.hy_w1[(j * 33 + f) * 64 + u];
    h1 = sinf(fr * h1);
    h1s[rl * 64 + u] = h1;
    __syncthreads();
    float h2 = p.hy_b2[j * 64 + u];
    for (int v = 0; v < 64; ++v) h2 += h1s[rl * 64 + v] * p.hy_w2[(j * 64 + v) * 64 + u];
    h2 = sinf(fr * h2);
    HID2[((size_t)j * 4352 + row0 + rl) * 64 + u] = h2;
    __syncthreads();
  }
}

__device__ __forceinline__ void phase_filtgen(const P& p, int j, const float* HID2, u16* FILT, float* SUMSQ, float* sm) {
  float* hs = sm;
  const int tid = otid();
  for (int it = blockIdx.x; it < 272; it += gridDim.x) {
    int lc, lt, ct;
    if (it < 256) { lc = 0; lt = it >> 2; ct = it & 3; }
    else { lc = 1; lt = (it - 256) >> 2; ct = it & 3; }
    const int L = lc ? 256 : 4096;
    const int lag0 = lt * 64;
    const int rowbase = lc ? 4096 : 0;
    for (int e = tid; e < 4096; e += NTHR) hs[e] = HID2[((size_t)j * 4352 + rowbase + lag0) * 64 + e];
    __syncthreads();
    const int col = ct * 512 + tid;
    const int order = col >> 10, dir = (col >> 9) & 1, ch = col & 511;
    float w3c[64];
#pragma unroll
    for (int u = 0; u < 64; ++u) w3c[u] = p.hy_w3[((size_t)j * 64 + u) * 2048 + col];
    const float delta = 3.0701134573253947f + (float)ch * (12.280453829301577f / 511.f);
    u16* fdst = FILT + (lc ? (size_t)2 * 512 * 8192 : 0) + (size_t)(order * 512 + ch) * (2 * L);
    float ss = 0.f;
    for (int ll = 0; ll < 64; ++ll) {
      float raw = 0.f;
#pragma unroll
      for (int u = 0; u < 64; ++u) raw += hs[ll * 64 + u] * w3c[u];
      int lag = lag0 + ll;
      float tn = (float)lag / (float)(L - 1);
      float val = raw * __expf(-tn * delta);
      if (dir == 0) { ss += val * val; fdst[L - lag] = f2bf(val); }
      else if (lag > 0) { ss += val * val; fdst[L + lag] = f2bf(val); }
    }
    atomicAdd(&SUMSQ[((j * 2 + lc) * 2 + order) * 512 + ch], ss);
    __syncthreads();
  }
}

__device__ __forceinline__ void conv_wt(const float* __restrict__ src, int ld, int K, int N, u16* __restrict__ dst, int ldd,
                                        const float* __restrict__ scale, float* sm) {
  const int tid = otid();
  const int KT = K >> 6;
  const int nt_total = KT * (N >> 6);
  for (int t = blockIdx.x; t < nt_total; t += gridDim.x) {
    int kt = t % KT, nt = t / KT;
    for (int e = tid; e < 4096; e += NTHR) {
      int kk = e >> 6, nn = e & 63;
      float v = src[(size_t)(kt * 64 + kk) * ld + nt * 64 + nn];
      if (scale) v *= scale[kt * 64 + kk];
      sm[kk * 65 + nn] = v;
    }
    __syncthreads();
    for (int e = tid; e < 4096; e += NTHR) {
      int nn = e >> 6, kk = e & 63;
      dst[(size_t)(nt * 64 + nn) * ldd + kt * 64 + kk] = f2bf(sm[kk * 65 + nn]);
    }
    __syncthreads();
  }
}

__device__ __forceinline__ void conv_mix_weights(const P& p, int l, char* ws, float* sm) {
  u16* WIN = (u16*)(ws + OFF_WIN);
  u16* WOUT = (u16*)(ws + OFF_WOUT);
  const int j = l >> 1;
  if ((l & 1) == 0) {
    conv_wt(p.ab_w_in + (size_t)j * 1024 * 2560, 2560, 1024, 2560, WIN, 1024, nullptr, sm);
  } else {
    conv_wt(p.cd_w_in + (size_t)j * 1024 * 3584, 3584, 1024, 3584, WIN, 1024, nullptr, sm);
    for (int d = 0; d < 2; ++d) {
      const float* w1 = p.rw_w1 + (size_t)(j * 2 + d) * 1024 * 64;
      const float* a1 = p.rw_a1 + (size_t)(j * 2 + d) * 1024 * 64;
      u16* base = WIN + (size_t)(3584 + d * 256) * 1024;
      conv_wt(w1, 64, 1024, 64, base, 1024, nullptr, sm);
      conv_wt(w1, 64, 1024, 64, base + 64 * 1024, 1024, p.rw_mu_x + (size_t)(j * 2 + 0) * 1024, sm);
      conv_wt(a1, 64, 1024, 64, base + 128 * 1024, 1024, nullptr, sm);
      conv_wt(a1, 64, 1024, 64, base + 192 * 1024, 1024, p.rw_mu_x + (size_t)(j * 2 + 1) * 1024, sm);
    }
  }
  conv_wt(p.w_out + (size_t)l * 1024 * 1024, 1024, 1024, 1024, WOUT, 1024, nullptr, sm);
}
__device__ __forceinline__ void conv_mlp_weights(const P& p, int l, char* ws, float* sm) {
  conv_wt(p.mlp_w1 + (size_t)l * 1024 * 4096, 4096, 1024, 4096, (u16*)(ws + OFF_W1T), 1024, nullptr, sm);
  conv_wt(p.mlp_w2 + (size_t)l * 4096 * 1024, 1024, 4096, 1024, (u16*)(ws + OFF_W2T), 4096, nullptr, sm);
}

#define LSTR 40
#define GSTAGE (512 * LSTR)
template <int EPI>
__device__ __forceinline__ void gemm_phase(const u16* __restrict__ A, int lda, const u16* __restrict__ Bt, int K, int N,
                                           u16* __restrict__ C, int ldc, int flag, u16* __restrict__ UT, float* __restrict__ X,
                                           const float* __restrict__ gate, char* smem) {
  constexpr bool SWAP = (EPI != 1);
  u16* Ls = (u16*)smem;
  const int tid = otid(), wid = tid >> 6, lane = tid & 63, wr = wid >> 1, wc = wid & 1, fr = lane & 15, fq = lane >> 4;
  const int NT = N >> 8, ntiles = 160 * NT, nk = K >> 5;
  const int crow = tid >> 2, ccol = (tid & 3) * 8;
  for (int tile = blockIdx.x; tile < ntiles; tile += gridDim.x) {
    const int mt = tile / NT, nt = tile - mt * NT;
    const int m0 = mt << 8, n0 = nt << 8;
    f32x4 acc[4][8];
#pragma unroll
    for (int i = 0; i < 4; ++i)
#pragma unroll
      for (int k = 0; k < 8; ++k) acc[i][k] = f32x4{0.f, 0.f, 0.f, 0.f};
    const u16* Ap = A + (size_t)(m0 + crow) * lda + ccol;
    const u16* Bp = Bt + (size_t)(n0 + crow) * K + ccol;
    const size_t a128 = (size_t)128 * lda, b128 = (size_t)128 * K;
    uint4 r0a0, r0a1, r0b0, r0b1, r1a0, r1a1, r1b0, r1b1;
    r0a0 = *(const uint4*)(Ap); r0a1 = *(const uint4*)(Ap + a128);
    r0b0 = *(const uint4*)(Bp); r0b1 = *(const uint4*)(Bp + b128);
    r1a0 = *(const uint4*)(Ap + 32); r1a1 = *(const uint4*)(Ap + a128 + 32);
    r1b0 = *(const uint4*)(Bp + 32); r1b1 = *(const uint4*)(Bp + b128 + 32);
    u16* wA = Ls + crow * LSTR + ccol;
    u16* wB = Ls + (256 + crow) * LSTR + ccol;
    *(uint4*)(wA) = r0a0; *(uint4*)(wA + 128 * LSTR) = r0a1;
    *(uint4*)(wB) = r0b0; *(uint4*)(wB + 128 * LSTR) = r0b1;
    __syncthreads();
    const u16* rA = Ls + (wr * 64 + fr) * LSTR + fq * 8;
    const u16* rB = Ls + (256 + wc * 128 + fr) * LSTR + fq * 8;
#define GEMM_COMPUTE(STG)                                                                                           \
  {                                                                                                                 \
    bf16x8 a[4], b[4];                                                                                              \
    _Pragma("unroll") for (int i = 0; i < 4; ++i) a[i] = *(const bf16x8*)(rA + (STG) * GSTAGE + i * 16 * LSTR);     \
    _Pragma("unroll") for (int h = 0; h < 2; ++h) {                                                                 \
      _Pragma("unroll") for (int i = 0; i < 4; ++i) b[i] = *(const bf16x8*)(rB + (STG) * GSTAGE + (h * 4 + i) * 16 * LSTR); \
      _Pragma("unroll") for (int mi = 0; mi < 4; ++mi) _Pragma("unroll") for (int ni = 0; ni < 4; ++ni) {            \
        if (SWAP) acc[mi][h * 4 + ni] = __builtin_amdgcn_mfma_f32_16x16x32_bf16(b[ni], a[mi], acc[mi][h * 4 + ni], 0, 0, 0); \
        else acc[mi][h * 4 + ni] = __builtin_amdgcn_mfma_f32_16x16x32_bf16(a[mi], b[ni], acc[mi][h * 4 + ni], 0, 0, 0);      \
      }                                                                                                             \
    }                                                                                                               \
  }
    for (int kt = 0; kt < nk; kt += 2) {
      {
        const int ko = min(kt + 2, nk - 1) << 5;
        r0a0 = *(const uint4*)(Ap + ko); r0a1 = *(const uint4*)(Ap + a128 + ko);
        r0b0 = *(const uint4*)(Bp + ko); r0b1 = *(const uint4*)(Bp + b128 + ko);
      }
      __builtin_amdgcn_sched_barrier(0);
      GEMM_COMPUTE(0)
      *(uint4*)(wA + GSTAGE) = r1a0; *(uint4*)(wA + GSTAGE + 128 * LSTR) = r1a1;
      *(uint4*)(wB + GSTAGE) = r1b0; *(uint4*)(wB + GSTAGE + 128 * LSTR) = r1b1;
      asm volatile("s_waitcnt lgkmcnt(0)\n\ts_barrier" ::: "memory");
      {
        const int ko = min(kt + 3, nk - 1) << 5;
        r1a0 = *(const uint4*)(Ap + ko); r1a1 = *(const uint4*)(Ap + a128 + ko);
        r1b0 = *(const uint4*)(Bp + ko); r1b1 = *(const uint4*)(Bp + b128 + ko);
      }
      __builtin_amdgcn_sched_barrier(0);
      GEMM_COMPUTE(1)
      *(uint4*)(wA) = r0a0; *(uint4*)(wA + 128 * LSTR) = r0a1;
      *(uint4*)(wB) = r0b0; *(uint4*)(wB + 128 * LSTR) = r0b1;
      asm volatile("s_waitcnt lgkmcnt(0)\n\ts_barrier" ::: "memory");
    }
#undef GEMM_COMPUTE
#pragma unroll
    for (int mi = 0; mi < 4; ++mi) {
#pragma unroll
      for (int ni = 0; ni < 8; ++ni) {
        if (EPI == 0) {
          const int m = m0 + wr * 64 + mi * 16 + fr;
          const int n4 = n0 + wc * 128 + ni * 16 + fq * 4;
          float v0 = acc[mi][ni][0], v1 = acc[mi][ni][1], v2 = acc[mi][ni][2], v3 = acc[mi][ni][3];
          if (flag) {
            v0 = fmaxf(v0, 0.f); v0 *= v0; v1 = fmaxf(v1, 0.f); v1 *= v1;
            v2 = fmaxf(v2, 0.f); v2 *= v2; v3 = fmaxf(v3, 0.f); v3 *= v3;
          }
          uint2 pk;
          pk.x = pack2(v0, v1);
          pk.y = pack2(v2, v3);
          *(uint2*)(C + (size_t)m * ldc + n4) = pk;
        } else if (EPI == 1) {
          const int mb = m0 + wr * 64 + mi * 16 + fq * 4;
          const int n = n0 + wc * 128 + ni * 16 + fr;
          if (n0 < 1536) {
            uint2 pk;
            pk.x = pack2(acc[mi][ni][0], acc[mi][ni][1]);
            pk.y = pack2(acc[mi][ni][2], acc[mi][ni][3]);
            *(uint2*)(UT + (size_t)n * MTOK + mb) = pk;
          } else {
#pragma unroll
            for (int r = 0; r < 4; ++r) C[(size_t)(mb + r) * 2560 + (n - 1536)] = f2bf(acc[mi][ni][r]);
          }
        } else {
          const int m = m0 + wr * 64 + mi * 16 + fr;
          const int n4 = n0 + wc * 128 + ni * 16 + fq * 4;
          const int rm = flag ? perm_row(m) : m;
          float4* xp = (float4*)(X + (size_t)rm * 1024 + n4);
          const float4 g4 = *(const float4*)(gate + (size_t)mods_row(m) * 6144 + n4);
          float4 xv = *xp;
          xv.x = ALPHA * xv.x + g4.x * acc[mi][ni][0];
          xv.y = ALPHA * xv.y + g4.y * acc[mi][ni][1];
          xv.z = ALPHA * xv.z + g4.z * acc[mi][ni][2];
          xv.w = ALPHA * xv.w + g4.w * acc[mi][ni][3];
          *xp = xv;
        }
      }
    }
  }
}

__device__ __forceinline__ void phase_xinit(const P& p, float* X, const float* mods0, u16* H) {
  const int lane = otid() & 63;
  const int gw = blockIdx.x * 8 + (otid() >> 6);
  for (int m = gw; m < MTOK; m += gridDim.x * 8) {
    const float* src = m < MCTX ? p.x_prompt + (size_t)m * 1024 : p.x_sample + (size_t)(m - MCTX) * 1024;
    const float* md = mods0 + (size_t)mods_row(m) * 6144;
#pragma unroll
    for (int i = 0; i < 4; ++i) {
      int col = lane * 4 + i * 256;
      float4 v = *(const float4*)(src + col);
      *(float4*)(X + (size_t)m * 1024 + col) = v;
      float4 sh = *(const float4*)(md + col);
      float4 sc = *(const float4*)(md + 1024 + col);
      uint2 pk;
      pk.x = pack2(v.x * (1.f + sc.x) + sh.x, v.y * (1.f + sc.y) + sh.y);
      pk.y = pack2(v.z * (1.f + sc.z) + sh.z, v.w * (1.f + sc.w) + sh.w);
      *(uint2*)(H + (size_t)m * 1024 + col) = pk;
    }
  }
}

__device__ __forceinline__ void phase_ln(float* X, const float* g, const float* b, const float* modl, int sh_off, int sc_off,
                                         u16* H, int write_h, int permflag, int write_x = 1) {
  const int lane = otid() & 63;
  const int gw = blockIdx.x * 8 + (otid() >> 6);
  for (int m = gw; m < MTOK; m += gridDim.x * 8) {
    float4 v[4];
    float s = 0.f;
#pragma unroll
    for (int i = 0; i < 4; ++i) {
      v[i] = *(const float4*)(X + (size_t)m * 1024 + lane * 4 + i * 256);
      s += v[i].x + v[i].y + v[i].z + v[i].w;
    }
    const float mean = wsum(s) * (1.f / 1024.f);
    float q = 0.f;
#pragma unroll
    for (int i = 0; i < 4; ++i) {
      v[i].x -= mean; v[i].y -= mean; v[i].z -= mean; v[i].w -= mean;
      q += v[i].x * v[i].x + v[i].y * v[i].y + v[i].z * v[i].z + v[i].w * v[i].w;
    }
    const float rstd = rsqrtf(wsum(q) * (1.f / 1024.f) + 1e-5f);
    const float* md = modl + (size_t)mods_row(m) * 6144;
    const int dst = permflag ? perm_row(m) : m;
#pragma unroll
    for (int i = 0; i < 4; ++i) {
      int col = lane * 4 + i * 256;
      float4 gg = *(const float4*)(g + col);
      float4 bb = *(const float4*)(b + col);
      float4 o;
      o.x = v[i].x * rstd * gg.x + bb.x; o.y = v[i].y * rstd * gg.y + bb.y;
      o.z = v[i].z * rstd * gg.z + bb.z; o.w = v[i].w * rstd * gg.w + bb.w;
      if (write_x) *(float4*)(X + (size_t)m * 1024 + col) = o;
      if (write_h) {
        float4 sh = *(const float4*)(md + sh_off + col);
        float4 sc = *(const float4*)(md + sc_off + col);
        uint2 pk;
        pk.x = pack2(o.x * (1.f + sc.x) + sh.x, o.y * (1.f + sc.y) + sh.y);
        pk.y = pack2(o.z * (1.f + sc.z) + sh.z, o.w * (1.f + sc.w) + sh.w);
        *(uint2*)(H + (size_t)dst * 1024 + col) = pk;
      }
    }
  }
}

__device__ __forceinline__ void phase_lru(const P& p, int j, const u16* __restrict__ proj, float* __restrict__ hfb,
                                          float* out_lru, int* ctr, char* smem) {
  float* XC = (float*)smem;
  float* GA = XC + 4096;
  float* GU = GA + 4096;
  float* WA = GU + 4096;
  float* WI = WA + 4096;
  float* cw = WI + 4096;
  float* cb = cw + 256;
  float* bba = cb + 64;
  float* bbi = bba + 64;
  float* spl = bbi + 64;
  int* sitem = (int*)(spl + 64);
  const int tid = otid();
  for (;;) {
    if (tid == 0) *sitem = atomicAdd(ctr, 1);
    __syncthreads();
    const int it = *sitem;
    __syncthreads();
    if (it >= 640) break;
    const int lat = it < 128;
    const int it2 = lat ? it : it - 128;
    const int b = it2 >> 4, hd = (it2 >> 1) & 7, d = it2 & 1;
    const int mbase = lat ? MCTX + b * 4096 : b * 256;
    const int Lseq = lat ? 4096 : 256;
    const int line = lat ? 64 : 256;
    const int nchunk = Lseq >> 6;
    for (int e = tid; e < 4096; e += NTHR) {
      WA[e] = p.lru_wa[((size_t)((j * 2 + d) * 8 + hd)) * 4096 + e];
      WI[e] = p.lru_wi[((size_t)((j * 2 + d) * 8 + hd)) * 4096 + e];
    }
    if (tid < 256) cw[tid] = p.lru_conv[(j * 4 + (tid >> 6)) * 512 + hd * 64 + (tid & 63)];
    if (tid < 64) {
      cb[tid] = p.lru_conv_b[j * 512 + hd * 64 + tid];
      bba[tid] = p.lru_ba[(j * 2 + d) * 512 + hd * 64 + tid];
      bbi[tid] = p.lru_bi[(j * 2 + d) * 512 + hd * 64 + tid];
      spl[tid] = softplusf_(-p.lru_lambda[(j * 2 + d) * 512 + hd * 64 + tid]);
    }
    float h = 0.f;
    if (tid < 64 && lat) h = p.state_lru[((size_t)(b * 2 + j) * 2 + d) * 512 + hd * 64 + tid];
    __syncthreads();
    for (int cc = 0; cc < nchunk; ++cc) {
      const int ci = d ? nchunk - 1 - cc : cc;
      const int s0 = ci << 6;
      for (int e = tid; e < 4096; e += NTHR) {
        int tok = e >> 6, ch = e & 63;
        int pos = (s0 + tok) & (line - 1);
        const u16* pr = proj + (size_t)(mbase + s0 + tok) * 2560 + 2048 + hd * 64 + ch;
        float a = cb[ch];
#pragma unroll
        for (int k = 0; k < 4; ++k) {
          int off = k - 2;
          if (pos + off >= 0 && pos + off < line) a += bf2f(pr[off * 2560]) * cw[k * 64 + ch];
        }
        XC[e] = a;
      }
      __syncthreads();
      {
        const int tok = tid >> 3, cg = (tid & 7) * 8;
        float ar[8], ai[8];
#pragma unroll
        for (int q = 0; q < 8; ++q) { ar[q] = bba[cg + q]; ai[q] = bbi[cg + q]; }
        for (int i = 0; i < 64; ++i) {
          float xv = XC[tok * 64 + i];
          float4 w0 = *(const float4*)(WA + i * 64 + cg), w1 = *(const float4*)(WA + i * 64 + cg + 4);
          float4 v0 = *(const float4*)(WI + i * 64 + cg), v1 = *(const float4*)(WI + i * 64 + cg + 4);
          ar[0] += xv * w0.x; ar[1] += xv * w0.y; ar[2] += xv * w0.z; ar[3] += xv * w0.w;
          ar[4] += xv * w1.x; ar[5] += xv * w1.y; ar[6] += xv * w1.z; ar[7] += xv * w1.w;
          ai[0] += xv * v0.x; ai[1] += xv * v0.y; ai[2] += xv * v0.z; ai[3] += xv * v0.w;
          ai[4] += xv * v1.x; ai[5] += xv * v1.y; ai[6] += xv * v1.z; ai[7] += xv * v1.w;
        }
#pragma unroll
        for (int q = 0; q < 8; ++q) {
          int ch = cg + q;
          float r = sigmoidf_(ar[q]);
          float ig = sigmoidf_(ai[q]);
          float la = -8.f * r * spl[ch];
          float a = __expf(la);
          float u = sqrtf(-expm1f(2.f * la)) * ig * XC[tok * 64 + ch];
          GA[tok * 64 + ch] = a;
          GU[tok * 64 + ch] = u;
        }
      }
      __syncthreads();
      if (tid < 64) {
        for (int tt = 0; tt < 64; ++tt) {
          int tok = d ? 63 - tt : tt;
          h = GA[tok * 64 + tid] * h + GU[tok * 64 + tid];
          GU[tok * 64 + tid] = h;
        }
      }
      __syncthreads();
      for (int e = tid; e < 4096; e += NTHR) {
        int tok = e >> 6, ch = e & 63;
        hfb[((size_t)(mbase + s0 + tok) * 2 + d) * 512 + hd * 64 + ch] = GU[e];
      }
    }
    if (!lat && tid < 64) out_lru[((size_t)(b * 2 + j) * 2 + d) * 512 + hd * 64 + tid] = h;
    __syncthreads();
  }
}

__device__ __forceinline__ void phase_abmix(const P& p, int j, const u16* __restrict__ proj, const float* __restrict__ hfb,
                                            u16* __restrict__ mix) {
  for (int e = blockIdx.x * NTHR + otid(); e < MTOK * 64; e += gridDim.x * NTHR) {
    const int m = e >> 6, c8 = (e & 63) * 8;
    const int line = m < MCTX ? 256 : 64;
    const int pos = m & (line - 1);
    const bool mL = pos > 0, mR = pos < line - 1;
    const u16* pr = proj + (size_t)m * 2560;
    uint4 sb = *(const uint4*)(pr + c8);
    uint4 sc0 = *(const uint4*)(pr + 512 + c8), sv0 = *(const uint4*)(pr + 1024 + c8);
    uint4 gg = *(const uint4*)(pr + 1536 + c8);
    uint4 z = make_uint4(0, 0, 0, 0);
    uint4 scl = mL ? *(const uint4*)(pr - 2560 + 512 + c8) : z, svl = mL ? *(const uint4*)(pr - 2560 + 1024 + c8) : z;
    uint4 scr = mR ? *(const uint4*)(pr + 2560 + 512 + c8) : z, svr = mR ? *(const uint4*)(pr + 2560 + 1024 + c8) : z;
    const u32* sbp = (const u32*)&sb; const u32* scp = (const u32*)&sc0; const u32* svp = (const u32*)&sv0;
    const u32* ggp = (const u32*)&gg; const u32* sclp = (const u32*)&scl; const u32* svlp = (const u32*)&svl;
    const u32* scrp = (const u32*)&scr; const u32* svrp = (const u32*)&svr;
    const float* hf = hfb + (size_t)m * 1024 + c8;
    float ya[8], yb[8];
#pragma unroll
    for (int q = 0; q < 8; ++q) {
      const int ch = c8 + q;
      const int w = q >> 1;
      const bool hi = q & 1;
      float s_b = hi ? bfhi(sbp[w]) : bflo(sbp[w]);
      float c1 = (hi ? bfhi(scp[w]) : bflo(scp[w])) * (hi ? bfhi(svp[w]) : bflo(svp[w]));
      float c0 = (hi ? bfhi(sclp[w]) : bflo(sclp[w])) * (hi ? bfhi(svlp[w]) : bflo(svlp[w]));
      float c2 = (hi ? bfhi(scrp[w]) : bflo(scrp[w])) * (hi ? bfhi(svrp[w]) : bflo(svrp[w]));
      float w0 = p.sc_conv[(j * 3 + 0) * 512 + ch], w1 = p.sc_conv[(j * 3 + 1) * 512 + ch], w2 = p.sc_conv[(j * 3 + 2) * 512 + ch];
      ya[q] = s_b * (c0 * w0 + c1 * w1 + c2 * w2);
      float g = hi ? bfhi(ggp[w]) : bflo(ggp[w]);
      float ge = 0.5f * g * (1.f + tanhf(0.7978845608028654f * (g + 0.044715f * g * g * g)));
      yb[q] = ge * (hf[q] + hf[512 + q]);
    }
    uint4 oa, ob;
    oa.x = pack2(ya[0], ya[1]); oa.y = pack2(ya[2], ya[3]); oa.z = pack2(ya[4], ya[5]); oa.w = pack2(ya[6], ya[7]);
    ob.x = pack2(yb[0], yb[1]); ob.y = pack2(yb[2], yb[3]); ob.z = pack2(yb[4], yb[5]); ob.w = pack2(yb[6], yb[7]);
    *(uint4*)(mix + (size_t)m * 1024 + c8) = oa;
    *(uint4*)(mix + (size_t)m * 1024 + 512 + c8) = ob;
  }
}

template <int CTRL>
__device__ __forceinline__ float dpp_mov(float v) {
  return __int_as_float(__builtin_amdgcn_update_dpp(0, __float_as_int(v), CTRL, 0xf, 0xf, true));
}
__device__ __forceinline__ float sum8(float v) {
  v += dpp_mov<0xB1>(v);
  v += dpp_mov<0x4E>(v);
  v += dpp_mov<0x141>(v);
  return v;
}
#define RSTR 72
__device__ __forceinline__ void rwkv_item(const P& p, int j, int it, const u16* __restrict__ prw, u16* __restrict__ obuf,
                                          float* __restrict__ bonus, float* out_rwkv, char* smem) {
  float* RM = (float*)smem;
  float* KD = RM + 2048;
  float* VM = KD + 2048;
  float* KK = VM + 2048;
  float* WD = KK + 2048;
  float* KA = WD + 2048;
  float* OB = KA + 2048;
  float* SSB = OB + 2048;
  float* mur = SSB + 64;
  float* muk = mur + 64;
  float* muv = muk + 64;
  float* kkp = muv + 64;
  float* kap = kkp + 64;
  float* rkp = kap + 64;
  float* w0p = rkp + 64;
  float* a0p = w0p + 64;
  u16* TWb = (u16*)(a0p + 64);
  u16* LAb = TWb + 32 * RSTR;
  u16* W2T = LAb + 32 * RSTR;
  u16* A2T = W2T + 64 * RSTR;
  const int tid = otid();
  const int lat = it < 128;
  const int it2 = lat ? it : it - 128;
  const int b = it2 >> 4, hd = (it2 >> 1) & 7, d = it2 & 1;
  const int mbase = lat ? MCTX + b * 4096 : b * 256;
  const int Lseq = lat ? 4096 : 256;
  const int line = lat ? 64 : 256;
  const int nchunk = Lseq >> 5;
  for (int e = tid; e < 4096; e += NTHR) {
    int u = e >> 6, ch = e & 63;
    W2T[ch * RSTR + u] = f2bf(p.rw_w2[((size_t)(j * 2 + d) * 64 + u) * 512 + hd * 64 + ch]);
    A2T[ch * RSTR + u] = f2bf(p.rw_a2[((size_t)(j * 2 + d) * 64 + u) * 512 + hd * 64 + ch]);
  }
  if (tid < 64) {
    int cidx = hd * 64 + tid;
    mur[tid] = p.rw_mu[(j * 4 + 0) * 512 + cidx];
    muk[tid] = p.rw_mu[(j * 4 + 1) * 512 + cidx];
    muv[tid] = p.rw_mu[(j * 4 + 2) * 512 + cidx];
    kkp[tid] = p.rw_kk[j * 512 + cidx];
    kap[tid] = p.rw_ka[j * 512 + cidx];
    rkp[tid] = p.rw_rk[(j * 8 + hd) * 64 + tid];
    w0p[tid] = p.rw_w0[(j * 2 + d) * 512 + cidx];
    a0p[tid] = p.rw_a0[(j * 2 + d) * 512 + cidx];
  }
  const int sq = tid & 7, rp = (tid >> 3) & 31;
  float S0[8], S1[8];
  {
    const float* s0p = p.state_rwkv + ((((size_t)(b * 2 + j) * 2 + d) * 8 + hd) * 64 + 2 * rp) * 64 + sq * 8;
#pragma unroll
    for (int e = 0; e < 8; ++e) {
      S0[e] = (lat && tid < 256) ? s0p[e] : 0.f;
      S1[e] = (lat && tid < 256) ? s0p[64 + e] : 0.f;
    }
  }
  const int ptok = tid >> 4, c4 = (tid & 15) * 4;
  uint2 pf[17];
#define RW_PREFETCH(S0_)                                                                   \
  {                                                                                        \
    const int s_ = (S0_) + ptok;                                                           \
    const int pos_ = s_ & (line - 1);                                                      \
    const u16* pr_ = prw + (size_t)(mbase + s_) * 2560;                                    \
    const u16* pl_ = pos_ > 0 ? pr_ - 2560 : pr_;                                          \
    const u16* pq_ = pos_ < line - 1 ? pr_ + 2560 : pr_;                                   \
    const int cr_ = hd * 64 + c4, cl_ = 2048 + d * 256 + c4;                               \
    pf[0] = *(const uint2*)(pr_ + cr_); pf[1] = *(const uint2*)(pl_ + cr_); pf[2] = *(const uint2*)(pq_ + cr_);                      \
    pf[3] = *(const uint2*)(pr_ + cr_ + 512); pf[4] = *(const uint2*)(pl_ + cr_ + 512); pf[5] = *(const uint2*)(pq_ + cr_ + 512);    \
    pf[6] = *(const uint2*)(pr_ + cr_ + 1024); pf[7] = *(const uint2*)(pl_ + cr_ + 1024); pf[8] = *(const uint2*)(pq_ + cr_ + 1024); \
    pf[9] = *(const uint2*)(pr_ + cl_);                                                                                             \
    pf[10] = *(const uint2*)(pr_ + cl_ + 64); pf[11] = *(const uint2*)(pl_ + cl_ + 64); pf[12] = *(const uint2*)(pq_ + cl_ + 64);    \
    pf[13] = *(const uint2*)(pr_ + cl_ + 128);                                                                                      \
    pf[14] = *(const uint2*)(pr_ + cl_ + 192); pf[15] = *(const uint2*)(pl_ + cl_ + 192); pf[16] = *(const uint2*)(pq_ + cl_ + 192); \
  }
  RW_PREFETCH((d ? nchunk - 1 : 0) << 5)
  __syncthreads();
  const int wave = tid >> 6, lane = tid & 63, fr = lane & 15, fq = lane >> 4;
  for (int cc = 0; cc < nchunk; ++cc) {
    const int ci = d ? nchunk - 1 - cc : cc;
    const int s0 = ci << 5;
    {
      const int pos = (s0 + ptok) & (line - 1);
      const float mL = pos > 0 ? 0.5f : 0.f, mR = pos < line - 1 ? 0.5f : 0.f;
      float rm[4], km[4], vm[4], tw[4], la[4];
#pragma unroll
      for (int q = 0; q < 4; ++q) {
        const int ch = c4 + q;
#define PFV(i) ((q & 1) ? bfhi((q >> 1) ? pf[i].y : pf[i].x) : bflo((q >> 1) ? pf[i].y : pf[i].x))
        float x0 = PFV(0), xl = PFV(1), xr = PFV(2);
        rm[q] = x0 + (mL * xl + mR * xr - x0) * mur[ch];
        x0 = PFV(3); xl = PFV(4); xr = PFV(5);
        km[q] = x0 + (mL * xl + mR * xr - x0) * muk[ch];
        x0 = PFV(6); xl = PFV(7); xr = PFV(8);
        vm[q] = x0 + (mL * xl + mR * xr - x0) * muv[ch];
        tw[q] = tanhf(PFV(9) + mL * PFV(11) + mR * PFV(12) - PFV(10));
        la[q] = PFV(13) + mL * PFV(15) + mR * PFV(16) - PFV(14);
#undef PFV
      }
      *(float4*)(RM + ptok * 64 + c4) = make_float4(rm[0], rm[1], rm[2], rm[3]);
      *(float4*)(KD + ptok * 64 + c4) = make_float4(km[0], km[1], km[2], km[3]);
      *(float4*)(VM + ptok * 64 + c4) = make_float4(vm[0], vm[1], vm[2], vm[3]);
      uint2 t2, l2;
      t2.x = pack2(tw[0], tw[1]); t2.y = pack2(tw[2], tw[3]);
      l2.x = pack2(la[0], la[1]); l2.y = pack2(la[2], la[3]);
      *(uint2*)(TWb + ptok * RSTR + c4) = t2;
      *(uint2*)(LAb + ptok * RSTR + c4) = l2;
      if (tid < 64) SSB[tid] = 0.f;
    }
    if (cc + 1 < nchunk) {
      const int cn = d ? nchunk - 2 - cc : cc + 1;
      RW_PREFETCH(cn << 5)
    }
    __syncthreads();
    float kv4[4], a4[4];
    const int tb = wave & 1, cb = wave >> 1;
    const int tok2 = 16 * tb + fr, ch2 = 16 * cb + 4 * fq;
    {
      f32x4 accw = {0.f, 0.f, 0.f, 0.f}, acca = {0.f, 0.f, 0.f, 0.f};
#pragma unroll
      for (int ks = 0; ks < 2; ++ks) {
        bf16x8 wa = *(const bf16x8*)(W2T + (16 * cb + fr) * RSTR + ks * 32 + fq * 8);
        bf16x8 tb8 = *(const bf16x8*)(TWb + (16 * tb + fr) * RSTR + ks * 32 + fq * 8);
        accw = __builtin_amdgcn_mfma_f32_16x16x32_bf16(wa, tb8, accw, 0, 0, 0);
        bf16x8 aa = *(const bf16x8*)(A2T + (16 * cb + fr) * RSTR + ks * 32 + fq * 8);
        bf16x8 lb8 = *(const bf16x8*)(LAb + (16 * tb + fr) * RSTR + ks * 32 + fq * 8);
        acca = __builtin_amdgcn_mfma_f32_16x16x32_bf16(aa, lb8, acca, 0, 0, 0);
      }
      const float4 km4 = *(const float4*)(KD + tok2 * 64 + ch2);
      const float4 rm4 = *(const float4*)(RM + tok2 * 64 + ch2);
      const float kmv[4] = {km4.x, km4.y, km4.z, km4.w};
      const float rmv[4] = {rm4.x, rm4.y, rm4.z, rm4.w};
      float ss = 0.f, bon = 0.f;
      float dec[4], kd[4];
#pragma unroll
      for (int r = 0; r < 4; ++r) {
        const int ch = ch2 + r;
        float wraw = -softplusf_(-(w0p[ch] + accw[r])) - 0.5f;
        dec[r] = __expf(-__expf(wraw));
        float a = sigmoidf_(a0p[ch] + acca[r]);
        float kv = kmv[r] * kkp[ch];
        ss += kv * kv;
        kd[r] = kmv[r] * (1.f + (a - 1.f) * kap[ch]);
        bon += rmv[r] * kd[r] * rkp[ch];
        a4[r] = a;
        kv4[r] = kv;
      }
      *(float4*)(WD + tok2 * 64 + ch2) = make_float4(dec[0], dec[1], dec[2], dec[3]);
      *(float4*)(KD + tok2 * 64 + ch2) = make_float4(kd[0], kd[1], kd[2], kd[3]);
      ss += __shfl_xor(ss, 16); ss += __shfl_xor(ss, 32);
      bon += __shfl_xor(bon, 16); bon += __shfl_xor(bon, 32);
      if (fq == 0) { atomicAdd(&SSB[tok2], ss); atomicAdd(&SSB[32 + tok2], bon); }
    }
    __syncthreads();
    {
      const float inv = rsqrtf(SSB[tok2] + 1e-12f);
      float kk[4];
#pragma unroll
      for (int r = 0; r < 4; ++r) kk[r] = kv4[r] * inv;
      *(float4*)(KK + tok2 * 64 + ch2) = make_float4(kk[0], kk[1], kk[2], kk[3]);
      *(float4*)(KA + tok2 * 64 + ch2) = make_float4(kk[0] * a4[0], kk[1] * a4[1], kk[2] * a4[2], kk[3] * a4[3]);
      if (cb == 0 && fq == 0) bonus[((size_t)(mbase + s0 + tok2) * 2 + d) * 8 + hd] = SSB[32 + tok2];
    }
    __syncthreads();
    if (tid < 256) {
#pragma unroll 2
      for (int tt = 0; tt < 32; ++tt) {
        const int tok = d ? 31 - tt : tt;
        const int o8 = tok * 64 + sq * 8;
        const float4 k0 = *(const float4*)(KK + o8), k1 = *(const float4*)(KK + o8 + 4);
        const float4 w0 = *(const float4*)(WD + o8), w1 = *(const float4*)(WD + o8 + 4);
        const float4 b0 = *(const float4*)(KA + o8), b1 = *(const float4*)(KA + o8 + 4);
        const float4 d0 = *(const float4*)(KD + o8), d1 = *(const float4*)(KD + o8 + 4);
        const float4 r0 = *(const float4*)(RM + o8), r1 = *(const float4*)(RM + o8 + 4);
        const float2 vv = *(const float2*)(VM + tok * 64 + 2 * rp);
        float sa0 = (S0[0] * k0.x + S0[1] * k0.y) + (S0[2] * k0.z + S0[3] * k0.w) + (S0[4] * k1.x + S0[5] * k1.y) + (S0[6] * k1.z + S0[7] * k1.w);
        float sa1 = (S1[0] * k0.x + S1[1] * k0.y) + (S1[2] * k0.z + S1[3] * k0.w) + (S1[4] * k1.x + S1[5] * k1.y) + (S1[6] * k1.z + S1[7] * k1.w);
        sa0 = sum8(sa0);
        sa1 = sum8(sa1);
        S0[0] = S0[0] * w0.x - sa0 * b0.x + vv.x * d0.x; S0[1] = S0[1] * w0.y - sa0 * b0.y + vv.x * d0.y;
        S0[2] = S0[2] * w0.z - sa0 * b0.z + vv.x * d0.z; S0[3] = S0[3] * w0.w - sa0 * b0.w + vv.x * d0.w;
        S0[4] = S0[4] * w1.x - sa0 * b1.x + vv.x * d1.x; S0[5] = S0[5] * w1.y - sa0 * b1.y + vv.x * d1.y;
        S0[6] = S0[6] * w1.z - sa0 * b1.z + vv.x * d1.z; S0[7] = S0[7] * w1.w - sa0 * b1.w + vv.x * d1.w;
        S1[0] = S1[0] * w0.x - sa1 * b0.x + vv.y * d0.x; S1[1] = S1[1] * w0.y - sa1 * b0.y + vv.y * d0.y;
        S1[2] = S1[2] * w0.z - sa1 * b0.z + vv.y * d0.z; S1[3] = S1[3] * w0.w - sa1 * b0.w + vv.y * d0.w;
        S1[4] = S1[4] * w1.x - sa1 * b1.x + vv.y * d1.x; S1[5] = S1[5] * w1.y - sa1 * b1.y + vv.y * d1.y;
        S1[6] = S1[6] * w1.z - sa1 * b1.z + vv.y * d1.z; S1[7] = S1[7] * w1.w - sa1 * b1.w + vv.y * d1.w;
        float o0 = (S0[0] * r0.x + S0[1] * r0.y) + (S0[2] * r0.z + S0[3] * r0.w) + (S0[4] * r1.x + S0[5] * r1.y) + (S0[6] * r1.z + S0[7] * r1.w);
        float o1 = (S1[0] * r0.x + S1[1] * r0.y) + (S1[2] * r0.z + S1[3] * r0.w) + (S1[4] * r1.x + S1[5] * r1.y) + (S1[6] * r1.z + S1[7] * r1.w);
        o0 = sum8(o0);
        o1 = sum8(o1);
        if (sq == 0) *(float2*)(OB + tok * 64 + 2 * rp) = make_float2(o0, o1);
      }
    }
    __syncthreads();
    {
      const float4 o4 = *(const float4*)(OB + ptok * 64 + c4);
      uint2 pk;
      pk.x = pack2(o4.x, o4.y);
      pk.y = pack2(o4.z, o4.w);
      *(uint2*)(obuf + ((size_t)(mbase + s0 + ptok) * 2 + d) * 512 + hd * 64 + c4) = pk;
    }
  }
#undef RW_PREFETCH
  if (!lat && tid < 256) {
    float* dst = out_rwkv + ((((size_t)(b * 2 + j) * 2 + d) * 8 + hd) * 64 + 2 * rp) * 64 + sq * 8;
#pragma unroll
    for (int e = 0; e < 8; ++e) { dst[e] = S0[e]; dst[64 + e] = S1[e]; }
  }
  __syncthreads();
}

template <int GRP>
struct HyCfg {
  static constexpr int NB = GRP == 0 ? 8 : 32;
  static constexpr int NBLK = GRP == 0 ? 64 : 4;
  static constexpr int LSEQ = GRP == 0 ? 4096 : 256;
  static constexpr int NTW = GRP == 0 ? 4 : 1;
  static constexpr int MB = GRP == 0 ? MCTX : 0;
  static constexpr int LINE = GRP == 0 ? 64 : 256;
};

template <int GRP>
__device__ __forceinline__ void hyena_conv(const u16* ZS, const float* FL, f32x4 (&acc)[4][HyCfg<GRP>::NTW], int wave, int fr,
                                           int fq) {
  typedef HyCfg<GRP> Cf;
  const int colw0 = wave * Cf::NTW * 16;
  const int i_lo = colw0 / Cf::NB, i_hi = (colw0 + Cf::NTW * 16 - 1) / Cf::NB;
#pragma unroll 1
  for (int d = -(Cf::NBLK - 1); d <= Cf::NBLK - 1; ++d) {
    if (i_hi - d < 0 || i_lo - d > Cf::NBLK - 1) continue;
#pragma unroll
    for (int ks = 0; ks < 2; ++ks) {
      bf16x8 af[4];
#pragma unroll
      for (int mb = 0; mb < 4; ++mb) {
        const float* fp = FL + Cf::LSEQ + (32 * ks + 8 * fq) - (16 * mb + fr) - 64 * d;
        u32 w0 = (__float_as_uint(fp[0]) >> 16) | (__float_as_uint(fp[1]) & 0xffff0000u);
        u32 w1 = (__float_as_uint(fp[2]) >> 16) | (__float_as_uint(fp[3]) & 0xffff0000u);
        u32 w2 = (__float_as_uint(fp[4]) >> 16) | (__float_as_uint(fp[5]) & 0xffff0000u);
        u32 w3 = (__float_as_uint(fp[6]) >> 16) | (__float_as_uint(fp[7]) & 0xffff0000u);
        uint4 t = make_uint4(w0, w1, w2, w3);
        af[mb] = *(bf16x8*)&t;
      }
#pragma unroll
      for (int nt = 0; nt < Cf::NTW; ++nt) {
        const int colg0 = colw0 + nt * 16;
        const int t_lo = colg0 / Cf::NB, t_hi = (colg0 + 15) / Cf::NB;
        if (t_hi - d < 0 || t_lo - d > Cf::NBLK - 1) continue;
        const int colg = colg0 + fr;
        const int i = colg / Cf::NB, b = colg % Cf::NB;
        const int k = i - d;
        const bool valid = (k >= 0) && (k < Cf::NBLK);
        uint4 t = make_uint4(0, 0, 0, 0);
        if (valid) t = *(const uint4*)(ZS + b * Cf::LSEQ + 64 * k + 32 * ks + 8 * fq);
        bf16x8 bfv = *(bf16x8*)&t;
#pragma unroll
        for (int mb = 0; mb < 4; ++mb) acc[mb][nt] = __builtin_amdgcn_mfma_f32_16x16x32_bf16(af[mb], bfv, acc[mb][nt], 0, 0, 0);
      }
      asm volatile("" ::: "memory");
    }
  }
}

template <int GRP>
__device__ __forceinline__ void hyena_item(const P& p, int j, int c, u16* UT, u16* YO, const u16* FILT,
                                           const float* SUMSQ, char* smem) {
  typedef HyCfg<GRP> Cf;
  u16* ZS = (u16*)smem;
  float* FL = (float*)(smem + 65536);
  constexpr int FLEN = 2 * Cf::LSEQ;
  const u16* filt0 = FILT + (GRP == 0 ? (size_t)0 : (size_t)2 * 512 * 8192);
  const int tid = otid(), wave = tid >> 6, lane = tid & 63, fr = lane & 15, fq = lane >> 4;
  const size_t MM = MTOK;
  {
    const float h0 = p.hy_conv[(j * 3 + 0) * 1536 + c], h1 = p.hy_conv[(j * 3 + 1) * 1536 + c], h2 = p.hy_conv[(j * 3 + 2) * 1536 + c];
    const u16* ur = UT + (size_t)c * MM + Cf::MB;
#pragma unroll 2
    for (int e = tid; e < Cf::NB * Cf::LSEQ; e += NTHR) {
      const int pos = e & (Cf::LINE - 1);
      float v = bf2f(ur[e]) * h1;
      if (pos > 0) v += bf2f(ur[e - 1]) * h0;
      if (pos < Cf::LINE - 1) v += bf2f(ur[e + 1]) * h2;
      ZS[e] = f2bf(v);
    }
    const u16* f = filt0 + (size_t)(0 * 512 + c) * FLEN;
#pragma unroll 2
    for (int e = tid; e < FLEN; e += NTHR) FL[e] = bf2f(f[e]);
  }
  __syncthreads();
  f32x4 acc[4][Cf::NTW];
#pragma unroll
  for (int mb = 0; mb < 4; ++mb)
#pragma unroll
    for (int nt = 0; nt < Cf::NTW; ++nt) acc[mb][nt] = f32x4{0.f, 0.f, 0.f, 0.f};
  hyena_conv<GRP>(ZS, FL, acc, wave, fr, fq);
  {
    const float scale = rsqrtf(SUMSQ[((j * 2 + GRP) * 2 + 0) * 512 + c] + 1e-6f);
    const float bias = p.hy_bias[(j * 2 + 0) * 512 + c];
    const float g0 = p.hy_conv[(j * 3 + 0) * 1536 + 512 + c], g1 = p.hy_conv[(j * 3 + 1) * 1536 + 512 + c],
                g2 = p.hy_conv[(j * 3 + 2) * 1536 + 512 + c];
    const u16* u1 = UT + (size_t)(512 + c) * MM + Cf::MB;
#pragma unroll
    for (int mb = 0; mb < 4; ++mb)
#pragma unroll
      for (int nt = 0; nt < Cf::NTW; ++nt) {
        const int colg = (wave * Cf::NTW + nt) * 16 + fr;
        const int i = colg / Cf::NB, b = colg % Cf::NB;
        {
          const int t0 = 64 * i + 16 * mb + 4 * fq;
          const int e0 = b * Cf::LSEQ + t0;
          const uint2 raw = *(const uint2*)(u1 + e0);
          const uint2 zr = *(const uint2*)(ZS + e0);
          const float xm = ((t0 & (Cf::LINE - 1)) > 0) ? bf2f(u1[e0 - 1]) : 0.f;
          const float xp = (((t0 + 3) & (Cf::LINE - 1)) < Cf::LINE - 1) ? bf2f(u1[e0 + 4]) : 0.f;
          const float x0 = bflo(raw.x), x1 = bfhi(raw.x), x2 = bflo(raw.y), x3 = bfhi(raw.y);
          acc[mb][nt][0] = (x0 * g1 + xm * g0 + x1 * g2) * (scale * acc[mb][nt][0] + bias * bflo(zr.x));
          acc[mb][nt][1] = (x1 * g1 + x0 * g0 + x2 * g2) * (scale * acc[mb][nt][1] + bias * bfhi(zr.x));
          acc[mb][nt][2] = (x2 * g1 + x1 * g0 + x3 * g2) * (scale * acc[mb][nt][2] + bias * bflo(zr.y));
          acc[mb][nt][3] = (x3 * g1 + x2 * g0 + xp * g2) * (scale * acc[mb][nt][3] + bias * bfhi(zr.y));
          asm volatile("" : "+v"(acc[mb][nt]) : : "memory");
          __builtin_amdgcn_sched_barrier(0);
        }
      }
  }
  __syncthreads();
#pragma unroll
  for (int mb = 0; mb < 4; ++mb)
#pragma unroll
    for (int nt = 0; nt < Cf::NTW; ++nt) {
      const int colg = (wave * Cf::NTW + nt) * 16 + fr;
      const int i = colg / Cf::NB, b = colg % Cf::NB;
      const int e0 = b * Cf::LSEQ + 64 * i + 16 * mb + 4 * fq;
      uint2 pk;
      pk.x = pack2(acc[mb][nt][0], acc[mb][nt][1]);
      pk.y = pack2(acc[mb][nt][2], acc[mb][nt][3]);
      *(uint2*)(ZS + e0) = pk;
      acc[mb][nt] = f32x4{0.f, 0.f, 0.f, 0.f};
    }
  {
    const u16* f = filt0 + (size_t)(1 * 512 + c) * FLEN;
#pragma unroll 2
    for (int e = tid; e < FLEN; e += NTHR) FL[e] = bf2f(f[e]);
  }
  __syncthreads();
  hyena_conv<GRP>(ZS, FL, acc, wave, fr, fq);
  {
    const float scale = rsqrtf(SUMSQ[((j * 2 + GRP) * 2 + 1) * 512 + c] + 1e-6f);
    const float bias = p.hy_bias[(j * 2 + 1) * 512 + c];
    const float g0 = p.hy_conv[(j * 3 + 0) * 1536 + 1024 + c], g1 = p.hy_conv[(j * 3 + 1) * 1536 + 1024 + c],
                g2 = p.hy_conv[(j * 3 + 2) * 1536 + 1024 + c];
    const u16* u2 = UT + (size_t)(1024 + c) * MM + Cf::MB;
    u16* yo = YO + (size_t)c * MM + Cf::MB;
#pragma unroll
    for (int mb = 0; mb < 4; ++mb)
#pragma unroll
      for (int nt = 0; nt < Cf::NTW; ++nt) {
        const int colg = (wave * Cf::NTW + nt) * 16 + fr;
        const int i = colg / Cf::NB, b = colg % Cf::NB;
        float y[4];
        const int t0 = 64 * i + 16 * mb + 4 * fq;
        const int e0 = b * Cf::LSEQ + t0;
        {
          const uint2 raw = *(const uint2*)(u2 + e0);
          const uint2 zr = *(const uint2*)(ZS + e0);
          const float xm = ((t0 & (Cf::LINE - 1)) > 0) ? bf2f(u2[e0 - 1]) : 0.f;
          const float xp = (((t0 + 3) & (Cf::LINE - 1)) < Cf::LINE - 1) ? bf2f(u2[e0 + 4]) : 0.f;
          const float x0 = bflo(raw.x), x1 = bfhi(raw.x), x2 = bflo(raw.y), x3 = bfhi(raw.y);
          y[0] = (x0 * g1 + xm * g0 + x1 * g2) * (scale * acc[mb][nt][0] + bias * bflo(zr.x));
          y[1] = (x1 * g1 + x0 * g0 + x2 * g2) * (scale * acc[mb][nt][1] + bias * bfhi(zr.x));
          y[2] = (x2 * g1 + x1 * g0 + x3 * g2) * (scale * acc[mb][nt][2] + bias * bflo(zr.y));
          y[3] = (x3 * g1 + x2 * g0 + xp * g2) * (scale * acc[mb][nt][3] + bias * bfhi(zr.y));
        }
        uint2 pk;
        pk.x = pack2(y[0], y[1]);
        pk.y = pack2(y[2], y[3]);
        *(uint2*)(yo + e0) = pk;
        asm volatile("" ::: "memory");
        __builtin_amdgcn_sched_barrier(0);
      }
  }
  __syncthreads();
}

__device__ __forceinline__ void phase_cdscan(const P& p, int j, const u16* prw, u16* obuf, float* bonus, float* out_rwkv, u16* UT,
                                             const u16* FILT, const float* SUMSQ, int* ctr, char* smem) {
  int* sitem = (int*)(smem + SMEM_BYTES - 16);
  for (;;) {
    if (otid() == 0) *sitem = atomicAdd(ctr, 1);
    __syncthreads();
    const int it = *sitem;
    __syncthreads();
    if (it >= 640 + 1024) break;
    if (it < 640) {
#ifndef NO_RW
      for (int rep = 0; rep < REP_RW; ++rep) rwkv_item(p, j, it, prw, obuf, bonus, out_rwkv, smem);
#endif
    } else if (it < 640 + 512) {
#ifndef NO_HY0
      for (int rep = 1; rep < REP_HY; ++rep) hyena_item<0>(p, j, it - 640, UT, UT + (size_t)1536 * MTOK, FILT, SUMSQ, smem);
      hyena_item<0>(p, j, it - 640, UT, UT, FILT, SUMSQ, smem);
#endif
    } else {
#ifndef NO_HY1
      for (int rep = 1; rep < REP_HY; ++rep) hyena_item<1>(p, j, it - 1152, UT, UT + (size_t)1536 * MTOK, FILT, SUMSQ, smem);
      hyena_item<1>(p, j, it - 1152, UT, UT, FILT, SUMSQ, smem);
#endif
    }
  }
}

__device__ __forceinline__ void phase_cdfinal(const P& p, int j, const u16* __restrict__ prw, const u16* __restrict__ obuf,
                                              const float* __restrict__ bonus, const u16* __restrict__ UT, u16* __restrict__ mix,
                                              char* smem) {
  const int tid = otid(), lane = tid & 63;
  {
    const int gw = blockIdx.x * 8 + (tid >> 6);
    for (int wi = gw; wi < MTOK * 8; wi += gridDim.x * 8) {
      const int m = wi >> 3, hd = wi & 7;
      const int cidx = hd * 64 + lane;
      float o = bf2f(obuf[((size_t)m * 2 + 0) * 512 + cidx]) + bf2f(obuf[((size_t)m * 2 + 1) * 512 + cidx]);
      const float mean = wsum(o) * (1.f / 64.f);
      const float oc = o - mean;
      const float var = wsum(oc * oc) * (1.f / 64.f);
      const float on = oc * rsqrtf(var + 64e-5f) * p.rw_gn_g[j * 512 + cidx] + p.rw_gn_b[j * 512 + cidx];
      const int line = m < MCTX ? 256 : 64;
      const int pos = m & (line - 1);
      const float mL = pos > 0 ? 0.5f : 0.f, mR = pos < line - 1 ? 0.5f : 0.f;
      const u16* pr = prw + (size_t)m * 2560;
      const u16* pl = pos > 0 ? pr - 2560 : pr;
      const u16* pq = pos < line - 1 ? pr + 2560 : pr;
      float x0 = bf2f(pr[1024 + cidx]), xl = bf2f(pl[1024 + cidx]), xr = bf2f(pq[1024 + cidx]);
      const float vm = x0 + (mL * xl + mR * xr - x0) * p.rw_mu[(j * 4 + 2) * 512 + cidx];
      x0 = bf2f(pr[1536 + cidx]); xl = bf2f(pl[1536 + cidx]); xr = bf2f(pq[1536 + cidx]);
      const float gm = x0 + (mL * xl + mR * xr - x0) * p.rw_mu[(j * 4 + 3) * 512 + cidx];
      const float bon = bonus[((size_t)m * 2 + 0) * 8 + hd] + bonus[((size_t)m * 2 + 1) * 8 + hd];
      const float y = (on + bon * vm) * sigmoidf_(gm);
      mix[(size_t)m * 1024 + 512 + cidx] = f2bf(y);
    }
  }
  {
    u16* tl = (u16*)smem;
    for (int t = blockIdx.x; t < 640 * 8; t += gridDim.x) {
      const int mt = t >> 3, ct = t & 7;
      for (int e = tid; e < 4096; e += NTHR) {
        int cc = e >> 6, mm = e & 63;
        tl[cc * 66 + mm] = UT[(size_t)(ct * 64 + cc) * MTOK + mt * 64 + mm];
      }
      __syncthreads();
      for (int e = tid; e < 4096; e += NTHR) {
        int mm = e >> 6, cc = e & 63;
        mix[(size_t)(mt * 64 + mm) * 1024 + ct * 64 + cc] = tl[cc * 66 + mm];
      }
      __syncthreads();
    }
  }
}

#ifndef PHMASK
#define PHMASK 0xffffffffu
#endif
#define PHS(b) ((PHMASK >> (b)) & 1u)
__global__ void __launch_bounds__(NTHR) fwd_megakernel(P p, int ph_begin, int ph_end) {
  extern __shared__ __attribute__((aligned(16))) char smem[];
  cg::grid_group grid = cg::this_grid();
  char* ws = p.ws;
  float* mods = (float*)(ws + OFF_MODS);
  float* bonus = (float*)(ws + OFF_BONUS);
  float* HID2 = (float*)(ws + OFF_HID2);
  float* SUMSQ = (float*)(ws + OFF_SUMSQ);
  int* CTR = (int*)(ws + OFF_CTR);
  u16* WIN = (u16*)(ws + OFF_WIN);
  u16* WOUT = (u16*)(ws + OFF_WOUT);
  u16* W1T = (u16*)(ws + OFF_W1T);
  u16* W2T = (u16*)(ws + OFF_W2T);
  u16* FILT = (u16*)(ws + OFF_FILT);
  u16* H = (u16*)(ws + OFF_H);
  char* arena = ws + OFF_ARENA;
  float* X = p.out;
  float* out_lru = p.out + (size_t)MTOK * 1024;
  float* out_rwkv = out_lru + 32 * 2 * 2 * 512;
  float* smf = (float*)smem;

  for (int ph = ph_begin; ph < ph_end; ++ph) {
    if (ph == 0) {
      if (blockIdx.x == 0 && otid() < 16) CTR[otid()] = 0;
      for (int i = blockIdx.x * NTHR + otid(); i < 2 * 2 * 2 * 512; i += gridDim.x * NTHR) SUMSQ[i] = 0.f;
      for (int rep = 0; rep < REP_O; ++rep) {
      if (PHS(0)) phase_mods(p, mods, smf);
      __syncthreads();
      if (PHS(1)) phase_hid2(p, HID2, smf);
      if (PHS(2)) { conv_mix_weights(p, 0, ws, smf);
      conv_mlp_weights(p, 0, ws, smf); }
      __syncthreads(); }
    } else if (ph == 1) {
      for (int rep = 0; rep < REP_O; ++rep) phase_xinit(p, X, mods, H);
      for (int rep = 1; rep < REP_FG; ++rep) phase_filtgen(p, 0, HID2, FILT, SUMSQ + 8192, smf);
      if (PHS(4)) phase_filtgen(p, 0, HID2, FILT, SUMSQ, smf);
    } else {
      const int l = (ph - 2) >> 3, s = (ph - 2) & 7;
      const int j = l >> 1;
      const bool cd = l & 1;
      const float* modl = mods + (size_t)l * 9 * 6144;
      if (s == 0) {
        if (!cd) {
          for (int rep = 0; rep < REP_G; ++rep) gemm_phase<0>(H, 1024, WIN, 1024, 2560, (u16*)arena, 2560, 0, nullptr, nullptr, nullptr, smem);
          if (l == 2) for (int rep = 1; rep < REP_FG; ++rep) phase_filtgen(p, 1, HID2, FILT, SUMSQ + 8192, smf);
          if (l == 2 && PHS(4)) phase_filtgen(p, 1, HID2, FILT, SUMSQ, smf);
        } else {
          for (int rep = 0; rep < REP_G; ++rep) gemm_phase<1>(H, 1024, WIN, 1024, 4096, (u16*)arena, 2560, 0, (u16*)(arena + ARENA_B), nullptr, nullptr, smem);
        }
        if (l > 0) for (int rep = 0; rep < REP_O; ++rep) conv_mlp_weights(p, l, ws, smf);
      } else if (s == 1) {
        if (!cd) { for (int rep = 0; rep < REP_LRU; ++rep) phase_lru(p, j, (const u16*)arena, (float*)(arena + ARENA_B), out_lru, CTR + l + 4 * rep, smem); }
        else if (PHS(8)) phase_cdscan(p, j, (const u16*)arena, H, bonus, out_rwkv, (u16*)(arena + ARENA_B), FILT, SUMSQ, CTR + l, smem);
      } else if (s == 2) {
        if (!cd) { for (int rep = 0; rep < REP_O; ++rep) phase_abmix(p, j, (const u16*)arena, (const float*)(arena + ARENA_B), H); }
        else for (int rep = 0; rep < REP_O; ++rep) phase_cdfinal(p, j, (const u16*)arena, H, bonus, (const u16*)(arena + ARENA_B),
                           (u16*)(arena + ARENA_B) + (size_t)512 * MTOK, smem);
      } else if (s == 3) {
        const u16* mixp = cd ? (const u16*)(arena + ARENA_B) + (size_t)512 * MTOK : H;
        if (!cd) for (int rep = 1; rep < REP_E2; ++rep) gemm_phase<2>(mixp, 1024, WOUT, 1024, 1024, nullptr, 0, 1, nullptr, (float*)arena, modl + 2048, smem);
        if (PHS(11)) gemm_phase<2>(mixp, 1024, WOUT, 1024, 1024, nullptr, 0, cd ? 1 : 0, nullptr, X, modl + 2048, smem);
      } else if (s == 4) {
        for (int rep = 1; rep < REP_LN; ++rep) phase_ln(X, p.ln1_g + l * 1024, p.ln1_b + l * 1024, modl, 3072, 4096, H, 1, 0, 0);
        if (PHS(12)) phase_ln(X, p.ln1_g + l * 1024, p.ln1_b + l * 1024, modl, 3072, 4096, H, 1, 0);
      } else if (s == 5) {
        for (int rep = 0; rep < REP_G; ++rep) gemm_phase<0>(H, 1024, W1T, 1024, 4096, (u16*)arena, 4096, 1, nullptr, nullptr, nullptr, smem);
        if (l < 3) for (int rep = 0; rep < REP_O; ++rep) conv_mix_weights(p, l + 1, ws, smf);
      } else if (s == 6) {
        for (int rep = 0; rep < REP_M2; ++rep) gemm_phase<0>((const u16*)arena, 4096, W2T, 4096, 1024, H, 1024, 0, nullptr, nullptr, nullptr, smem);
        if (PHS(11)) gemm_phase<2>((const u16*)arena, 4096, W2T, 4096, 1024, nullptr, 0, 0, nullptr, X, modl + 5120, smem);
      } else {
        const float* modn = mods + (size_t)(l + 1) * 9 * 6144;
        for (int rep = 1; rep < REP_LN; ++rep) phase_ln(X, p.ln2_g + l * 1024, p.ln2_b + l * 1024, l < 3 ? modn : modl, 0, 1024, H, 1, ((l + 1) & 1), 0);
        if (PHS(12)) phase_ln(X, p.ln2_g + l * 1024, p.ln2_b + l * 1024, l < 3 ? modn : modl, 0, 1024, H, l < 3 ? 1 : 0, ((l + 1) & 1));
      }
    }
    if (ph + 1 < ph_end) for (int rep = 0; rep < REP_SYNC; ++rep) grid.sync();
  }
}

extern "C" void kernel_launch(void* const* d_in, const int* in_sizes, int n_in, void* d_out, int out_size, void* d_ws,
                              size_t ws_size, hipStream_t stream) {
  static int grid_blocks = 0;
  if (!grid_blocks) {
    int dev = 0, cus = 0, per_cu = 0;
    hipGetDevice(&dev);
    hipDeviceGetAttribute(&cus, hipDeviceAttributeMultiprocessorCount, dev);
    hipFuncSetAttribute((const void*)fwd_megakernel, hipFuncAttributeMaxDynamicSharedMemorySize, SMEM_BYTES);
    hipOccupancyMaxActiveBlocksPerMultiprocessor(&per_cu, fwd_megakernel, NTHR, SMEM_BYTES);
    if (per_cu < 1) per_cu = 1;
    grid_blocks = cus * per_cu;
  }
  if (ws_size < WS_NEED) fprintf(stderr, "workspace too small: %zu < %llu\n", ws_size, (unsigned long long)WS_NEED);
  P p{};
  const float** pp = (const float**)&p;
  for (int i = 0; i < 46; ++i) pp[i] = (const float*)d_in[i];
  p.out = (float*)d_out;
  p.ws = (char*)d_ws;
  int ph0 = 0, ph1 = 34;
  void* args[] = {&p, &ph0, &ph1};
  hipError_t e = hipLaunchCooperativeKernel((void*)fwd_megakernel, dim3(grid_blocks), dim3(NTHR), args, SMEM_BYTES, stream);
  if (e != hipSuccess) fprintf(stderr, "cooperative launch failed: %s (grid %d)\n", hipGetErrorString(e), grid_blocks);
}
```

```cpp
#include <hip/hip_runtime.h>
#include <hip/hip_bf16.h>
#include <hip/hip_cooperative_groups.h>
#include <cstdio>
namespace cg = cooperative_groups;

typedef unsigned short u16;
typedef unsigned int u32;
using bf16x8 = __attribute__((ext_vector_type(8))) short;
using f32x4 = __attribute__((ext_vector_type(4))) float;

#define REP_G 1
#define TSEL 0
#define REP_E2 1
#define REP_FG 1
#define REP_LN 1
#define REP_HY 1
#define REP_SYNC 1
#define REP_O 1
#define REP_M2 0
#define REP_RW 1
#define REP_LRU 1
#define NTHR 512
#define MTOK 40960
#define MCTX 8192
#define ALPHA 1.6817928305074292f
#define SMEM_BYTES 131136

struct P {
  const float *x_prompt, *x_sample, *state_lru, *state_rwkv, *c, *c_ctx, *w_mod, *b_mod, *ln1_g, *ln1_b, *ln2_g, *ln2_b,
      *mlp_w1, *mlp_w2, *w_out, *ab_w_in, *sc_conv, *lru_conv, *lru_conv_b, *lru_wa, *lru_ba, *lru_wi, *lru_bi, *lru_lambda,
      *cd_w_in, *hy_conv, *hy_w1, *hy_b1, *hy_w2, *hy_b2, *hy_w3, *hy_freq, *hy_bias, *rw_mu, *rw_mu_x, *rw_w0, *rw_w1, *rw_w2,
      *rw_a0, *rw_a1, *rw_a2, *rw_kk, *rw_ka, *rw_rk, *rw_gn_g, *rw_gn_b;
  float* out;
  char* ws;
};

#define MiB (1024ull * 1024ull)
#define OFF_MODS (0ull)
#define OFF_BONUS (1ull * MiB)
#define OFF_HID2 (4ull * MiB)
#define OFF_SUMSQ (7ull * MiB)
#define OFF_CTR (7ull * MiB + 65536ull)
#define OFF_BAR (7ull * MiB + 131072ull)
#define OFF_WIN (8ull * MiB)
#define OFF_WOUT (16ull * MiB)
#define OFF_W1T (18ull * MiB)
#define OFF_W2T (26ull * MiB)
#define OFF_FILT (34ull * MiB)
#define OFF_H (52ull * MiB)
#define OFF_ARENA (132ull * MiB)
#define ARENA_B (200ull * MiB)
#define WS_NEED (492ull * MiB)

__device__ __forceinline__ int otid() {
  int t = threadIdx.x;
  asm volatile("" : "+v"(t));
  return t;
}
__device__ __forceinline__ u16 f2bf(float f) {
  u32 u = __float_as_uint(f);
  u += 0x7fffu + ((u >> 16) & 1u);
  return (u16)(u >> 16);
}
__device__ __forceinline__ float bf2f(u16 h) { return __uint_as_float(((u32)h) << 16); }
__device__ __forceinline__ float bflo(u32 u) { return __uint_as_float(u << 16); }
__device__ __forceinline__ float bfhi(u32 u) { return __uint_as_float(u & 0xffff0000u); }
__device__ __forceinline__ u32 pack2(float a, float b) { return (u32)f2bf(a) | ((u32)f2bf(b) << 16); }
__device__ __forceinline__ float sigmoidf_(float x) { return __builtin_amdgcn_rcpf(1.f + __expf(-x)); }
__device__ __forceinline__ float softplusf_(float x) { return fmaxf(x, 0.f) + __logf(1.f + __expf(-fabsf(x))); }
__device__ __forceinline__ float tanhf_(float x) { return 1.f - 2.f * __builtin_amdgcn_rcpf(1.f + __expf(2.f * x)); }
template <int CTRL>
__device__ __forceinline__ float dpp_mov(float v) {
  return __int_as_float(__builtin_amdgcn_update_dpp(0, __float_as_int(v), CTRL, 0xf, 0xf, true));
}
__device__ __forceinline__ float wsum(float v) {
  v += dpp_mov<0xB1>(v);
  v += dpp_mov<0x4E>(v);
  v += dpp_mov<0x141>(v);
  v += dpp_mov<0x140>(v);
  const int iv = __float_as_int(v);
  return (__int_as_float(__builtin_amdgcn_readlane(iv, 0)) + __int_as_float(__builtin_amdgcn_readlane(iv, 16))) +
         (__int_as_float(__builtin_amdgcn_readlane(iv, 32)) + __int_as_float(__builtin_amdgcn_readlane(iv, 48)));
}
__device__ __forceinline__ int mods_row(int m) { return m < MCTX ? 0 : 1 + ((m - MCTX) >> 12); }
__device__ __forceinline__ int perm_row(int m) {
  if (m < MCTX) return m;
  int t = m - MCTX;
  int b = t >> 12, s = t & 4095;
  return MCTX + (b << 12) + ((s & 63) << 6) + (s >> 6);
}

__device__ __forceinline__ void phase_mods(const P& p, float* mods, float* sm) {
  float* sc = sm;
  float* red = sm + 9 * 1024;
  const int tid = otid();
  for (int i = tid; i < 9 * 1024; i += NTHR) {
    int r = i >> 10, k = i & 1023;
    float v = (r == 0) ? p.c_ctx[k] : p.c[(r - 1) * 1024 + k];
    sc[i] = v / (1.f + __expf(-v));
  }
  __syncthreads();
  const int nl = tid & 63, ks = tid >> 6;
  for (int it = blockIdx.x; it < 4 * 96; it += gridDim.x) {
    int l = it / 96, ng = it % 96;
    int n = ng * 64 + nl;
    const float* w = p.w_mod + (size_t)l * 1024 * 6144 + n;
    float a0 = 0, a1 = 0, a2 = 0, a3 = 0, a4 = 0, a5 = 0, a6 = 0, a7 = 0, a8 = 0;
#pragma unroll 4
    for (int k = ks * 128; k < ks * 128 + 128; ++k) {
      float wv = w[(size_t)k * 6144];
      a0 += sc[k] * wv; a1 += sc[1024 + k] * wv; a2 += sc[2048 + k] * wv; a3 += sc[3072 + k] * wv;
      a4 += sc[4096 + k] * wv; a5 += sc[5120 + k] * wv; a6 += sc[6144 + k] * wv; a7 += sc[7168 + k] * wv;
      a8 += sc[8192 + k] * wv;
    }
    red[(ks * 9 + 0) * 64 + nl] = a0; red[(ks * 9 + 1) * 64 + nl] = a1; red[(ks * 9 + 2) * 64 + nl] = a2;
    red[(ks * 9 + 3) * 64 + nl] = a3; red[(ks * 9 + 4) * 64 + nl] = a4; red[(ks * 9 + 5) * 64 + nl] = a5;
    red[(ks * 9 + 6) * 64 + nl] = a6; red[(ks * 9 + 7) * 64 + nl] = a7; red[(ks * 9 + 8) * 64 + nl] = a8;
    __syncthreads();
    for (int o = tid; o < 9 * 64; o += NTHR) {
      int r = o >> 6, cc = o & 63;
      float s = 0;
#pragma unroll
      for (int q = 0; q < 8; ++q) s += red[(q * 9 + r) * 64 + cc];
      int nn = ng * 64 + cc;
      mods[(size_t)(l * 9 + r) * 6144 + nn] = s + p.b_mod[l * 6144 + nn];
    }
    __syncthreads();
  }
}

__device__ __forceinline__ void phase_hid2(const P& p, float* HID2, float* sm) {
  float* ft = sm;
  float* h1s = sm + 8 * 36;
  const int tid = otid();
  for (int it = blockIdx.x; it < 2 * 544; it += gridDim.x) {
    int j = it / 544, rg = it % 544;
    int row0 = rg * 8;
    if (tid < 8 * 33) {
      int r = tid / 33, f = tid % 33;
      int row = row0 + r;
      int L = row < 4096 ? 4096 : 256;
      int lag = row < 4096 ? row : row - 4096;
      float val;
      if (f == 0) val = (float)lag / (float)(L - 1);
      else {
        int bi = (f - 1) & 15;
        float band = 1e-4f + (float)bi * ((15.f - 1e-4f) / 15.f);
        float ang = (6.283185307179586f / (float)L) * (float)lag * band;
        val = (f <= 16) ? cosf(ang) : -sinf(ang);
      }
      ft[r * 36 + f] = val;
    }
    __syncthreads();
    int rl = tid >> 6, u = tid & 63;
    float fr = p.hy_freq[j * 64 + u];
    float h1 = p.hy_b1[j * 64 + u];
    for (int f = 0; f < 33; ++f) h1 += ft[rl * 36 + f] * p.hy_w1[(j * 33 + f) * 64 + u];
    h1 = sinf(fr * h1);
    h1s[rl * 64 + u] = h1;
    __syncthreads();
    float h2 = p.hy_b2[j * 64 + u];
    for (int v = 0; v < 64; ++v) h2 += h1s[rl * 64 + v] * p.hy_w2[(j * 64 + v) * 64 + u];
    h2 = sinf(fr * h2);
    HID2[((size_t)j * 4352 + row0 + rl) * 64 + u] = h2;
    __syncthreads();
  }
}

__device__ __forceinline__ void phase_filtgen(const P& p, int j, const float* HID2, u16* FILT, float* SUMSQ, float* sm) {
  float* hs = sm;
  const int tid = otid();
  for (int it = blockIdx.x; it < 272; it += gridDim.x) {
    int lc, lt, ct;
    if (it < 256) { lc = 0; lt = it >> 2; ct = it & 3; }
    else { lc = 1; lt = (it - 256) >> 2; ct = it & 3; }
    const int L = lc ? 256 : 4096;
    const int lag0 = lt * 64;
    const int rowbase = lc ? 4096 : 0;
    for (int e = tid; e < 4096; e += NTHR) hs[e] = HID2[((size_t)j * 4352 + rowbase + lag0) * 64 + e];
    __syncthreads();
    const int col = ct * 512 + tid;
    const int order = col >> 10, dir = (col >> 9) & 1, ch = col & 511;
    float w3c[64];
#pragma unroll
    for (int u = 0; u < 64; ++u) w3c[u] = p.hy_w3[((size_t)j * 64 + u) * 2048 + col];
    const float delta = 3.0701134573253947f + (float)ch * (12.280453829301577f / 511.f);
    u16* fdst = FILT + (lc ? (size_t)2 * 512 * 8192 : 0) + (size_t)(order * 512 + ch) * (2 * L);
    float ss = 0.f;
    for (int ll = 0; ll < 64; ++ll) {
      float raw = 0.f;
#pragma unroll
      for (int u = 0; u < 64; ++u) raw += hs[ll * 64 + u] * w3c[u];
      int lag = lag0 + ll;
      float tn = (float)lag / (float)(L - 1);
      float val = raw * __expf(-tn * delta);
      if (dir == 0) { ss += val * val; fdst[L - lag] = f2bf(val); }
      else if (lag > 0) { ss += val * val; fdst[L + lag] = f2bf(val); }
    }
    atomicAdd(&SUMSQ[((j * 2 + lc) * 2 + order) * 512 + ch], ss);
    __syncthreads();
  }
}

__device__ __forceinline__ void conv_wt(const float* __restrict__ src, int ld, int K, int N, u16* __restrict__ dst, int ldd,
                                        const float* __restrict__ scale, float* sm, bool g_conv_upper = false) {
  const int tid = otid();
  const int KT = K >> 6;
  const int nt_total = KT * (N >> 6);
  const int half = gridDim.x >> 1;
  const int t0 = g_conv_upper ? (int)blockIdx.x - half : (int)blockIdx.x;
  const int tstep = g_conv_upper ? half : (int)gridDim.x;
  if (t0 < 0) return;
  for (int t = t0; t < nt_total; t += tstep) {
    int kt = t % KT, nt = t / KT;
    for (int e = tid; e < 4096; e += NTHR) {
      int kk = e >> 6, nn = e & 63;
      float v = src[(size_t)(kt * 64 + kk) * ld + nt * 64 + nn];
      if (scale) v *= scale[kt * 64 + kk];
      sm[kk * 65 + nn] = v;
    }
    __syncthreads();
    for (int e = tid; e < 4096; e += NTHR) {
      int nn = e >> 6, kk = e & 63;
      dst[(size_t)(nt * 64 + nn) * ldd + kt * 64 + kk] = f2bf(sm[kk * 65 + nn]);
    }
    __syncthreads();
  }
}

__device__ __forceinline__ void conv_mix_weights(const P& p, int l, char* ws, float* sm, bool up = false) {
  u16* WIN = (u16*)(ws + OFF_WIN);
  u16* WOUT = (u16*)(ws + OFF_WOUT);
  const int j = l >> 1;
  if ((l & 1) == 0) {
    conv_wt(p.ab_w_in + (size_t)j * 1024 * 2560, 2560, 1024, 2560, WIN, 1024, nullptr, sm, up);
  } else {
    conv_wt(p.cd_w_in + (size_t)j * 1024 * 3584, 3584, 1024, 3584, WIN, 1024, nullptr, sm, up);
    for (int d = 0; d < 2; ++d) {
      const float* w1 = p.rw_w1 + (size_t)(j * 2 + d) * 1024 * 64;
      const float* a1 = p.rw_a1 + (size_t)(j * 2 + d) * 1024 * 64;
      u16* base = WIN + (size_t)(3584 + d * 256) * 1024;
      conv_wt(w1, 64, 1024, 64, base, 1024, nullptr, sm, up);
      conv_wt(w1, 64, 1024, 64, base + 64 * 1024, 1024, p.rw_mu_x + (size_t)(j * 2 + 0) * 1024, sm, up);
      conv_wt(a1, 64, 1024, 64, base + 128 * 1024, 1024, nullptr, sm, up);
      conv_wt(a1, 64, 1024, 64, base + 192 * 1024, 1024, p.rw_mu_x + (size_t)(j * 2 + 1) * 1024, sm, up);
    }
  }
  conv_wt(p.w_out + (size_t)l * 1024 * 1024, 1024, 1024, 1024, WOUT, 1024, nullptr, sm, up);
}
__device__ __forceinline__ void conv_mlp_weights(const P& p, int l, char* ws, float* sm, bool up = false) {
  conv_wt(p.mlp_w1 + (size_t)l * 1024 * 4096, 4096, 1024, 4096, (u16*)(ws + OFF_W1T), 1024, nullptr, sm, up);
  conv_wt(p.mlp_w2 + (size_t)l * 4096 * 1024, 1024, 4096, 1024, (u16*)(ws + OFF_W2T), 4096, nullptr, sm, up);
}

#define LSTR 64
#define GSTAGE (512 * LSTR)
template <int EPI, int MI>
__device__ __forceinline__ void gemm_part(const u16* __restrict__ A, int lda, const u16* __restrict__ Bt, int K, int N,
                                          u16* __restrict__ C, int ldc, int flag, u16* __restrict__ UT, float* __restrict__ X,
                                          const float* __restrict__ gate, char* smem, int n_items, int tbase) {
  constexpr bool SWAP = (EPI != 1);
  u16* Ls = (u16*)smem;
  const int tid = otid(), wid = tid >> 6, lane = tid & 63, wr = wid >> 1, wc = wid & 1, fr = lane & 15, fq = lane >> 4;
  const int NT = N >> 8, ntiles = n_items, nk = K >> 6;
  const int crow = tid >> 3, ccol = (tid & 7) * 8;
  const int wsw = ((tid & 7) ^ ((crow >> 1) & 7)) * 8;
  const int rsw0 = ((fq) ^ ((fr >> 1) & 7)) * 8, rsw1 = ((4 + fq) ^ ((fr >> 1) & 7)) * 8;
  uint4 ra0, ra1, ra2, ra3, rb0, rb1, rb2, rb3;
  const size_t a64 = (size_t)64 * lda, b64 = (size_t)64 * K;
  const u16* Ap = A;
  const u16* Bp = Bt;
#define GLOAD_A(KS)                                                                          \
  {                                                                                          \
    const int ko_ = min((KS), nk - 1) << 6;                                                  \
    ra0 = *(const uint4*)(Ap + ko_); ra1 = *(const uint4*)(Ap + a64 + ko_);                  \
    if (MI == 4) { ra2 = *(const uint4*)(Ap + 2 * a64 + ko_); ra3 = *(const uint4*)(Ap + 3 * a64 + ko_); } \
  }
#define GLOAD_B(KS)                                                                          \
  {                                                                                          \
    const int ko_ = min((KS), nk - 1) << 6;                                                  \
    rb0 = *(const uint4*)(Bp + ko_); rb1 = *(const uint4*)(Bp + b64 + ko_);                  \
    rb2 = *(const uint4*)(Bp + 2 * b64 + ko_); rb3 = *(const uint4*)(Bp + 3 * b64 + ko_);    \
  }
#define LWRITE_A(STG)                                                                                       \
  {                                                                                                         \
    *(uint4*)(wA + (STG) * GSTAGE) = ra0; *(uint4*)(wA + (STG) * GSTAGE + 64 * LSTR) = ra1;                 \
    if (MI == 4) { *(uint4*)(wA + (STG) * GSTAGE + 128 * LSTR) = ra2; *(uint4*)(wA + (STG) * GSTAGE + 192 * LSTR) = ra3; } \
  }
#define LWRITE_B(STG)                                                                                       \
  {                                                                                                         \
    *(uint4*)(wB + (STG) * GSTAGE) = rb0; *(uint4*)(wB + (STG) * GSTAGE + 64 * LSTR) = rb1;                 \
    *(uint4*)(wB + (STG) * GSTAGE + 128 * LSTR) = rb2; *(uint4*)(wB + (STG) * GSTAGE + 192 * LSTR) = rb3;   \
  }
#define GLOAD(KS) GLOAD_A(KS) GLOAD_B(KS)
#define LWRITE(STG) LWRITE_A(STG) LWRITE_B(STG)
#define TILE_REMAP(T) (((T) < nfull) ? (((T) & ~255) + (((T) & 7) << 5) + (((T) & 255) >> 3)) : (T))
#define ITEM_TILE(T) ((MI == 4) ? TILE_REMAP((EPI == 2 && K == 4096) ? (n_items - 1 - (T)) : (T)) : (tbase + ((T) >> 1)))
#define ITEM_MOFF(T) ((MI == 4) ? 0 : (((T) & 1) << 7))
#define GTILE_PTRS(T)                                                   \
  {                                                                     \
    const int tr_ = ITEM_TILE(T);                                       \
    const int mt_ = tr_ / NT, nt_ = tr_ - mt_ * NT;                     \
    Ap = A + (size_t)((mt_ << 8) + ITEM_MOFF(T) + crow) * lda + ccol;   \
    Bp = Bt + (size_t)((nt_ << 8) + crow) * K + ccol;                   \
  }
  u16* wA = Ls + crow * LSTR + wsw;
  u16* wB = Ls + (256 + crow) * LSTR + wsw;
  const u16* rA = Ls + (wr * 16 * MI + fr) * LSTR;
  const u16* rB = Ls + (256 + wc * 128 + fr) * LSTR;
  const int nfull = (MI == 4 && gridDim.x == 256) ? (ntiles & ~255) : 0;
  int tile = blockIdx.x;
  if (tile < ntiles) {
    GTILE_PTRS(tile)
    GLOAD(0)
  }
  while (tile < ntiles) {
    const int trm = ITEM_TILE(tile);
    const int mt = trm / NT, nt = trm - mt * NT;
    const int m0 = (mt << 8) + ITEM_MOFF(tile), n0 = nt << 8;
    f32x4 acc[MI][8];
#pragma unroll
    for (int i = 0; i < MI; ++i)
#pragma unroll
      for (int k = 0; k < 8; ++k) acc[i][k] = f32x4{0.f, 0.f, 0.f, 0.f};
    LWRITE(0)
    __builtin_amdgcn_sched_barrier(0);
    GLOAD(1)
    __builtin_amdgcn_sched_barrier(0);
    asm volatile("s_waitcnt lgkmcnt(0)\n\ts_barrier" ::: "memory");
#define GEMM_MMA_H(STG, AF, RS, H)                                                                                  \
  {                                                                                                                 \
    bf16x8 b[2];                                                                                                    \
    _Pragma("unroll") for (int i = 0; i < 2; ++i) b[i] = *(const bf16x8*)(rB + (STG) * GSTAGE + ((H) * 2 + i) * 16 * LSTR + (RS)); \
    _Pragma("unroll") for (int mi = 0; mi < MI; ++mi) _Pragma("unroll") for (int ni = 0; ni < 2; ++ni) {            \
      if (SWAP) acc[mi][(H) * 2 + ni] = __builtin_amdgcn_mfma_f32_16x16x32_bf16(b[ni], AF[mi], acc[mi][(H) * 2 + ni], 0, 0, 0); \
      else acc[mi][(H) * 2 + ni] = __builtin_amdgcn_mfma_f32_16x16x32_bf16(AF[mi], b[ni], acc[mi][(H) * 2 + ni], 0, 0, 0);      \
    }                                                                                                               \
  }
#define GEMM_LOAD_A0(STG) \
  _Pragma("unroll") for (int i = 0; i < MI / 2; ++i) a0[i] = *(const bf16x8*)(rA + (STG) * GSTAGE + i * 16 * LSTR + rsw0);
#define GEMM_LOAD_A0B(STG) \
  _Pragma("unroll") for (int i = MI / 2; i < MI; ++i) a0[i] = *(const bf16x8*)(rA + (STG) * GSTAGE + i * 16 * LSTR + rsw0);
#define GSTEP(STG, KS)                                                      \
  {                                                                         \
      \
    GEMM_LOAD_A0B(STG)                                                      \
    __builtin_amdgcn_sched_barrier(0);                                      \
    LWRITE_A((STG) ^ 1)                                                     \
    __builtin_amdgcn_sched_barrier(0);                                      \
    GLOAD_A((KS) + 2)                                                       \
    __builtin_amdgcn_sched_barrier(0);                                      \
    GEMM_MMA_H(STG, a0, rsw0, 0)                                            \
    GEMM_MMA_H(STG, a0, rsw0, 1)                                            \
    GEMM_MMA_H(STG, a0, rsw0, 2)                                            \
    GEMM_MMA_H(STG, a0, rsw0, 3)                                            \
    LWRITE_B((STG) ^ 1)                                                     \
    __builtin_amdgcn_sched_barrier(0);                                      \
    GLOAD_B((KS) + 2)                                                       \
    __builtin_amdgcn_sched_barrier(0);                                      \
    _Pragma("unroll") for (int i = 0; i < MI; ++i) a1[i] = *(const bf16x8*)(rA + (STG) * GSTAGE + i * 16 * LSTR + rsw1); \
    GEMM_MMA_H(STG, a1, rsw1, 0)                                            \
    GEMM_MMA_H(STG, a1, rsw1, 1)                                            \
    GEMM_MMA_H(STG, a1, rsw1, 2)                                            \
    _Pragma("unroll") for (int i = 0; i < 2; ++i) b3[i] = *(const bf16x8*)(rB + (STG) * GSTAGE + (6 + i) * 16 * LSTR + rsw1); \
    __builtin_amdgcn_sched_barrier(0);                                      \
    asm volatile("s_waitcnt lgkmcnt(0)\n\ts_barrier" ::: "memory");         \
    GEMM_LOAD_A0((STG) ^ 1)                                                 \
    __builtin_amdgcn_sched_barrier(0);                                      \
    GEMM_MMA_HP(STG, a1, b3, 3)                                             \
  }
#define GEMM_MMA_HP(STG, AF, BF, H)                                                                                 \
  {                                                                                                                 \
    _Pragma("unroll") for (int mi = 0; mi < MI; ++mi) _Pragma("unroll") for (int ni = 0; ni < 2; ++ni) {            \
      if (SWAP) acc[mi][(H) * 2 + ni] = __builtin_amdgcn_mfma_f32_16x16x32_bf16(BF[ni], AF[mi], acc[mi][(H) * 2 + ni], 0, 0, 0); \
      else acc[mi][(H) * 2 + ni] = __builtin_amdgcn_mfma_f32_16x16x32_bf16(AF[mi], BF[ni], acc[mi][(H) * 2 + ni], 0, 0, 0);      \
    }                                                                                                               \
  }
    bf16x8 a0[MI], a1[MI], b3[2];
    GEMM_LOAD_A0(0)
    for (int kt = 0; kt < nk; kt += 2) {
      GSTEP(0, kt)
      GSTEP(1, kt + 1)
    }
#undef GSTEP
#undef GEMM_MMA_H
#undef GEMM_MMA_HP
#undef GEMM_LOAD_A0
#undef GEMM_LOAD_A0B
    const int tile_next = tile + gridDim.x;
    if (tile_next < ntiles) {
      GTILE_PTRS(tile_next)
      GLOAD(0)
    }
    __builtin_amdgcn_sched_barrier(0);
#pragma unroll
    for (int mi = 0; mi < MI; ++mi) {
#pragma unroll
      for (int ni = 0; ni < 8; ++ni) {
        if (EPI == 0) {
          const int m = m0 + wr * 16 * MI + mi * 16 + fr;
          const int n4 = n0 + wc * 128 + ni * 16 + fq * 4;
          float v0 = acc[mi][ni][0], v1 = acc[mi][ni][1], v2 = acc[mi][ni][2], v3 = acc[mi][ni][3];
          if (flag) {
            v0 = fmaxf(v0, 0.f); v0 *= v0; v1 = fmaxf(v1, 0.f); v1 *= v1;
            v2 = fmaxf(v2, 0.f); v2 *= v2; v3 = fmaxf(v3, 0.f); v3 *= v3;
          }
          const unsigned long long pk64 = (unsigned long long)pack2(v0, v1) | ((unsigned long long)pack2(v2, v3) << 32);
          if (flag) __builtin_nontemporal_store(pk64, (unsigned long long*)(C + (size_t)m * ldc + n4));
          else *(unsigned long long*)(C + (size_t)m * ldc + n4) = pk64;
        } else if (EPI == 1) {
          const int mb = m0 + wr * 16 * MI + mi * 16 + fq * 4;
          const int n = n0 + wc * 128 + ni * 16 + fr;
          if (n0 < 1536) {
            uint2 pk;
            pk.x = pack2(acc[mi][ni][0], acc[mi][ni][1]);
            pk.y = pack2(acc[mi][ni][2], acc[mi][ni][3]);
            *(uint2*)(UT + (size_t)n * MTOK + mb) = pk;
          } else {
#pragma unroll
            for (int r = 0; r < 4; ++r) C[(size_t)(mb + r) * 2560 + (n - 1536)] = f2bf(acc[mi][ni][r]);
          }
        } else {
          const int m = m0 + wr * 16 * MI + mi * 16 + fr;
          const int n4 = n0 + wc * 128 + ni * 16 + fq * 4;
          const int rm = flag ? perm_row(m) : m;
          float4* xp = (float4*)(X + (size_t)rm * 1024 + n4);
          const float4 g4 = *(const float4*)(gate + (size_t)mods_row(m) * 6144 + n4);
          float4 xv = *xp;
          xv.x = ALPHA * xv.x + g4.x * acc[mi][ni][0];
          xv.y = ALPHA * xv.y + g4.y * acc[mi][ni][1];
          xv.z = ALPHA * xv.z + g4.z * acc[mi][ni][2];
          xv.w = ALPHA * xv.w + g4.w * acc[mi][ni][3];
          *xp = xv;
        }
      }
    }
    tile = tile_next;
  }
#undef GLOAD
#undef LWRITE
#undef GLOAD_A
#undef GLOAD_B
#undef LWRITE_A
#undef LWRITE_B
#undef GTILE_PTRS
#undef ITEM_TILE
#undef ITEM_MOFF
#undef TILE_REMAP
}

template <int EPI>
__device__ __forceinline__ void gemm_phase(const u16* __restrict__ A, int lda, const u16* __restrict__ Bt, int K, int N,
                                           u16* __restrict__ C, int ldc, int flag, u16* __restrict__ UT, float* __restrict__ X,
                                           const float* __restrict__ gate, char* smem) {
  const int ntiles = 160 * (N >> 8);
  const int rem = (gridDim.x == 256) ? (ntiles & 255) : 0;
  if (rem > 0 && rem <= 128) {
    gemm_part<EPI, 4>(A, lda, Bt, K, N, C, ldc, flag, UT, X, gate, smem, ntiles - rem, 0);
    gemm_part<EPI, 2>(A, lda, Bt, K, N, C, ldc, flag, UT, X, gate, smem, 2 * rem, ntiles - rem);
  } else {
    gemm_part<EPI, 4>(A, lda, Bt, K, N, C, ldc, flag, UT, X, gate, smem, ntiles, 0);
  }
}

__device__ __forceinline__ void phase_xinit(const P& p, float* X, const float* mods0, u16* H) {
  const int lane = otid() & 63;
  const int gw = blockIdx.x * 8 + (otid() >> 6);
  for (int m = gw; m < MTOK; m += gridDim.x * 8) {
    const float* src = m < MCTX ? p.x_prompt + (size_t)m * 1024 : p.x_sample + (size_t)(m - MCTX) * 1024;
    const float* md = mods0 + (size_t)mods_row(m) * 6144;
#pragma unroll
    for (int i = 0; i < 4; ++i) {
      int col = lane * 4 + i * 256;
      float4 v = *(const float4*)(src + col);
      *(float4*)(X + (size_t)m * 1024 + col) = v;
      float4 sh = *(const float4*)(md + col);
      float4 sc = *(const float4*)(md + 1024 + col);
      uint2 pk;
      pk.x = pack2(v.x * (1.f + sc.x) + sh.x, v.y * (1.f + sc.y) + sh.y);
      pk.y = pack2(v.z * (1.f + sc.z) + sh.z, v.w * (1.f + sc.w) + sh.w);
      *(uint2*)(H + (size_t)m * 1024 + col) = pk;
    }
  }
}

__device__ __forceinline__ void phase_ln(float* X, const float* g, const float* b, const float* modl, int sh_off, int sc_off,
                                         u16* H, int write_h, int permflag, int write_x = 1) {
  const int lane = otid() & 63;
  const int gw = blockIdx.x * 8 + (otid() >> 6);
  const int stride = gridDim.x * 8;
  for (int mb = gw; mb < MTOK; mb += 2 * stride) {
    float4 v[2][4];
#pragma unroll
    for (int r = 0; r < 2; ++r) {
      const int m = min(mb + r * stride, MTOK - 1);
#pragma unroll
      for (int i = 0; i < 4; ++i) v[r][i] = *(const float4*)(X + (size_t)m * 1024 + lane * 4 + i * 256);
    }
#pragma unroll
    for (int r = 0; r < 2; ++r) {
      const int m = mb + r * stride;
      if (m >= MTOK) break;
      float s = 0.f;
#pragma unroll
      for (int i = 0; i < 4; ++i) s += v[r][i].x + v[r][i].y + v[r][i].z + v[r][i].w;
      const float mean = wsum(s) * (1.f / 1024.f);
      float q = 0.f;
#pragma unroll
      for (int i = 0; i < 4; ++i) {
        v[r][i].x -= mean; v[r][i].y -= mean; v[r][i].z -= mean; v[r][i].w -= mean;
        q += v[r][i].x * v[r][i].x + v[r][i].y * v[r][i].y + v[r][i].z * v[r][i].z + v[r][i].w * v[r][i].w;
      }
      const float rstd = rsqrtf(wsum(q) * (1.f / 1024.f) + 1e-5f);
      const float* md = modl + (size_t)mods_row(m) * 6144;
      const int dst = permflag ? perm_row(m) : m;
#pragma unroll
      for (int i = 0; i < 4; ++i) {
        int col = lane * 4 + i * 256;
        float4 gg = *(const float4*)(g + col);
        float4 bb = *(const float4*)(b + col);
        float4 o;
        o.x = v[r][i].x * rstd * gg.x + bb.x; o.y = v[r][i].y * rstd * gg.y + bb.y;
        o.z = v[r][i].z * rstd * gg.z + bb.z; o.w = v[r][i].w * rstd * gg.w + bb.w;
        if (write_x) *(float4*)(X + (size_t)m * 1024 + col) = o;
        if (write_h) {
          float4 sh = *(const float4*)(md + sh_off + col);
          float4 sc = *(const float4*)(md + sc_off + col);
          uint2 pk;
          pk.x = pack2(o.x * (1.f + sc.x) + sh.x, o.y * (1.f + sc.y) + sh.y);
          pk.y = pack2(o.z * (1.f + sc.z) + sh.z, o.w * (1.f + sc.w) + sh.w);
          *(uint2*)(H + (size_t)dst * 1024 + col) = pk;
        }
      }
    }
  }
}

__device__ __forceinline__ void phase_lru_gates(const P& p, int j, const u16* __restrict__ proj, u32* __restrict__ PK, char* smem) {
  float* XCf = (float*)smem;
  float* cw = XCf + 4096;
  float* cb = cw + 256;
  float* bba = cb + 64;
  float* bbi = bba + 128;
  float* spl = bbi + 128;
  u16* XR = (u16*)(spl + 128);
  u16* XCb = XR + 68 * 64;
  u16* WT = XCb + 64 * 72;
  const int tid = otid();
  const int wave = tid >> 6, lane = tid & 63, fr = lane & 15, fq = lane >> 4;
  const int ptok = tid >> 3, c8 = (tid & 7) * 8;
  const int hd = blockIdx.x & 7;
  const int cstep = gridDim.x >> 3;
  for (int e = tid; e < 4 * 4096; e += NTHR) {
    const int mat = e >> 12, i = (e >> 6) & 63, jj = e & 63;
    const int d = mat >> 1;
    const float* src = (mat & 1) ? p.lru_wi : p.lru_wa;
    WT[(mat * 64 + jj) * 72 + i] = f2bf(src[((size_t)((j * 2 + d) * 8 + hd)) * 4096 + i * 64 + jj]);
  }
  if (tid < 256) cw[tid] = p.lru_conv[(j * 4 + (tid >> 6)) * 512 + hd * 64 + (tid & 63)];
  if (tid < 64) cb[tid] = p.lru_conv_b[j * 512 + hd * 64 + tid];
  if (tid < 128) {
    const int d = tid >> 6, ch = tid & 63;
    bba[tid] = p.lru_ba[(j * 2 + d) * 512 + hd * 64 + ch];
    bbi[tid] = p.lru_bi[(j * 2 + d) * 512 + hd * 64 + ch];
    spl[tid] = softplusf_(-p.lru_lambda[(j * 2 + d) * 512 + hd * 64 + ch]);
  }
  uint4 pmain, phalo;
#define LRUA_PREFETCH(CK)                                                                                   \
  {                                                                                                         \
    const int m0_ = (CK) * 64;                                                                              \
    const u16* base_ = proj + (size_t)m0_ * 2560 + 2048 + hd * 64 + c8;                                      \
    pmain = *(const uint4*)(base_ + (size_t)ptok * 2560);                                                    \
    phalo = make_uint4(0, 0, 0, 0);                                                                          \
    if (tid < 24 && m0_ < MCTX) {                                                                            \
      const int hr_ = tid >> 3;                                                                              \
      const int so_ = hr_ == 0 ? -2 : (hr_ == 1 ? -1 : 64);                                                  \
      const int sg_ = (m0_ & 255) + so_;                                                                     \
      if (sg_ >= 0 && sg_ < 256) phalo = *(const uint4*)(base_ + (long)so_ * 2560);                          \
    }                                                                                                        \
  }
  int ck = blockIdx.x >> 3;
  if (ck < 640) LRUA_PREFETCH(ck)
  __syncthreads();
  for (; ck < 640; ck += cstep) {
    const int m0 = ck * 64;
    *(uint4*)(XR + (ptok + 2) * 64 + c8) = pmain;
    if (tid < 24) {
      const int hr = tid >> 3;
      *(uint4*)(XR + (hr == 2 ? 66 : hr) * 64 + c8) = phalo;
    }
    if (ck + cstep < 640) LRUA_PREFETCH(ck + cstep)
    __syncthreads();
    {
      float xc[8];
#pragma unroll
      for (int q = 0; q < 8; ++q) xc[q] = cb[c8 + q];
#pragma unroll
      for (int k = 0; k < 4; ++k) {
        const uint4 rv = *(const uint4*)(XR + (ptok + k) * 64 + c8);
        const u32 w[4] = {rv.x, rv.y, rv.z, rv.w};
#pragma unroll
        for (int q = 0; q < 8; ++q) {
          const float xv = (q & 1) ? bfhi(w[q >> 1]) : bflo(w[q >> 1]);
          xc[q] += xv * cw[k * 64 + c8 + q];
        }
      }
      *(float4*)(XCf + ptok * 64 + c8) = make_float4(xc[0], xc[1], xc[2], xc[3]);
      *(float4*)(XCf + ptok * 64 + c8 + 4) = make_float4(xc[4], xc[5], xc[6], xc[7]);
      uint4 pk;
      pk.x = pack2(xc[0], xc[1]); pk.y = pack2(xc[2], xc[3]); pk.z = pack2(xc[4], xc[5]); pk.w = pack2(xc[6], xc[7]);
      *(uint4*)(XCb + ptok * 72 + c8) = pk;
    }
    __syncthreads();
    {
      const int tb = wave & 3, d = wave >> 2;
      const int tok = 16 * tb + fr;
      const u16* WA = WT + (size_t)(d * 2 + 0) * 64 * 72;
      const u16* WI = WT + (size_t)(d * 2 + 1) * 64 * 72;
      const bf16x8 xb0 = *(const bf16x8*)(XCb + (16 * tb + fr) * 72 + fq * 8);
      const bf16x8 xb1 = *(const bf16x8*)(XCb + (16 * tb + fr) * 72 + 32 + fq * 8);
#pragma unroll
      for (int cblk = 0; cblk < 4; ++cblk) {
        f32x4 accr = {0.f, 0.f, 0.f, 0.f}, acci = {0.f, 0.f, 0.f, 0.f};
        accr = __builtin_amdgcn_mfma_f32_16x16x32_bf16(*(const bf16x8*)(WA + (16 * cblk + fr) * 72 + fq * 8), xb0, accr, 0, 0, 0);
        accr = __builtin_amdgcn_mfma_f32_16x16x32_bf16(*(const bf16x8*)(WA + (16 * cblk + fr) * 72 + 32 + fq * 8), xb1, accr, 0, 0, 0);
        acci = __builtin_amdgcn_mfma_f32_16x16x32_bf16(*(const bf16x8*)(WI + (16 * cblk + fr) * 72 + fq * 8), xb0, acci, 0, 0, 0);
        acci = __builtin_amdgcn_mfma_f32_16x16x32_bf16(*(const bf16x8*)(WI + (16 * cblk + fr) * 72 + 32 + fq * 8), xb1, acci, 0, 0, 0);
        const int ch4 = 16 * cblk + 4 * fq;
        const float4 x4 = *(const float4*)(XCf + tok * 64 + ch4);
        const float xv[4] = {x4.x, x4.y, x4.z, x4.w};
        u32 pk[4];
#pragma unroll
        for (int r = 0; r < 4; ++r) {
          const int ch = ch4 + r;
          const float rg = sigmoidf_(accr[r] + bba[d * 64 + ch]);
          const float ig = sigmoidf_(acci[r] + bbi[d * 64 + ch]);
          const float la = -8.f * rg * spl[d * 64 + ch];
          const float u = __builtin_amdgcn_sqrtf(fmaxf(1.f - __expf(2.f * la), 0.f)) * ig * xv[r];
          pk[r] = (u32)f2bf(la) | ((u32)f2bf(u) << 16);
        }
        *(uint4*)(PK + ((size_t)(m0 + tok) * 2 + d) * 512 + hd * 64 + ch4) = make_uint4(pk[0], pk[1], pk[2], pk[3]);
      }
    }
  }
#undef LRUA_PREFETCH
  __syncthreads();
}

__device__ __forceinline__ void phase_lru_scan(const P& p, int j, u32* PK, float* out_lru, int* ctr, char* smem) {
  float* SEGA = (float*)smem;
  float* SEGU = SEGA + 512;
  float* HC = SEGU + 512;
  int* sitem = (int*)(HC + 64);
  const int tid = otid();
  const int ch = tid & 63, seg = tid >> 6;
  for (;;) {
    if (tid == 0) *sitem = atomicAdd(ctr, 1);
    __syncthreads();
    const int it = *sitem;
    __syncthreads();
    if (it >= 640) break;
    const int lat = it < 128;
    const int it2 = lat ? it : it - 128;
    const int b = it2 >> 4, hd = (it2 >> 1) & 7, d = it2 & 1;
    const int mbase = lat ? MCTX + b * 4096 : b * 256;
    const int Lseq = lat ? 4096 : 256;
    const int seglen = lat ? 64 : 32;
    const int nsc = Lseq / (8 * seglen);
    if (tid < 64) HC[tid] = lat ? p.state_lru[((size_t)(b * 2 + j) * 2 + d) * 512 + hd * 64 + tid] : 0.f;
    __syncthreads();
    float hlast = 0.f;
    for (int sc = 0; sc < nsc; ++sc) {
      const int p0 = (sc * 8 + seg) * seglen;
      u32 vals[64];
#pragma unroll
      for (int i = 0; i < 64; ++i) {
        const int pp = p0 + min(i, seglen - 1);
        const int sidx = d ? (Lseq - 1 - pp) : pp;
        vals[i] = PK[((size_t)(mbase + sidx) * 2 + d) * 512 + hd * 64 + ch];
      }
      float A = 1.f, U = 0.f;
#pragma unroll
      for (int i = 0; i < 64; ++i) {
        if (i < seglen) {
          const float a = __expf(bflo(vals[i]));
          U = a * U + bfhi(vals[i]);
          A *= a;
        }
      }
      SEGA[seg * 64 + ch] = A;
      SEGU[seg * 64 + ch] = U;
      __syncthreads();
      float h = HC[ch];
      for (int s2 = 0; s2 < seg; ++s2) h = SEGA[s2 * 64 + ch] * h + SEGU[s2 * 64 + ch];
#pragma unroll
      for (int i = 0; i < 64; ++i) {
        if (i < seglen) {
          const int pp = p0 + i;
          const int sidx = d ? (Lseq - 1 - pp) : pp;
          h = __expf(bflo(vals[i])) * h + bfhi(vals[i]);
          ((float*)PK)[((size_t)(mbase + sidx) * 2 + d) * 512 + hd * 64 + ch] = h;
        }
      }
      hlast = h;
      __syncthreads();
      if (seg == 7) HC[ch] = hlast;
      __syncthreads();
    }
    if (!lat && tid < 64) out_lru[((size_t)(b * 2 + j) * 2 + d) * 512 + hd * 64 + tid] = HC[tid];
    __syncthreads();
  }
}

__device__ __forceinline__ void phase_abmix(const P& p, int j, const u16* __restrict__ proj, const float* __restrict__ hfb,
                                            u16* __restrict__ mix) {
  for (int e = blockIdx.x * NTHR + otid(); e < MTOK * 64; e += gridDim.x * NTHR) {
    const int m = e >> 6, c8 = (e & 63) * 8;
    const int line = m < MCTX ? 256 : 64;
    const int pos = m & (line - 1);
    const bool mL = pos > 0, mR = pos < line - 1;
    const u16* pr = proj + (size_t)m * 2560;
    uint4 sb = *(const uint4*)(pr + c8);
    uint4 sc0 = *(const uint4*)(pr + 512 + c8), sv0 = *(const uint4*)(pr + 1024 + c8);
    uint4 gg = *(const uint4*)(pr + 1536 + c8);
    uint4 z = make_uint4(0, 0, 0, 0);
    uint4 scl = mL ? *(const uint4*)(pr - 2560 + 512 + c8) : z, svl = mL ? *(const uint4*)(pr - 2560 + 1024 + c8) : z;
    uint4 scr = mR ? *(const uint4*)(pr + 2560 + 512 + c8) : z, svr = mR ? *(const uint4*)(pr + 2560 + 1024 + c8) : z;
    const u32* sbp = (const u32*)&sb; const u32* scp = (const u32*)&sc0; const u32* svp = (const u32*)&sv0;
    const u32* ggp = (const u32*)&gg; const u32* sclp = (const u32*)&scl; const u32* svlp = (const u32*)&svl;
    const u32* scrp = (const u32*)&scr; const u32* svrp = (const u32*)&svr;
    const float* hf = hfb + (size_t)m * 1024 + c8;
    float ya[8], yb[8];
#pragma unroll
    for (int q = 0; q < 8; ++q) {
      const int ch = c8 + q;
      const int w = q >> 1;
      const bool hi = q & 1;
      float s_b = hi ? bfhi(sbp[w]) : bflo(sbp[w]);
      float c1 = (hi ? bfhi(scp[w]) : bflo(scp[w])) * (hi ? bfhi(svp[w]) : bflo(svp[w]));
      float c0 = (hi ? bfhi(sclp[w]) : bflo(sclp[w])) * (hi ? bfhi(svlp[w]) : bflo(svlp[w]));
      float c2 = (hi ? bfhi(scrp[w]) : bflo(scrp[w])) * (hi ? bfhi(svrp[w]) : bflo(svrp[w]));
      float w0 = p.sc_conv[(j * 3 + 0) * 512 + ch], w1 = p.sc_conv[(j * 3 + 1) * 512 + ch], w2 = p.sc_conv[(j * 3 + 2) * 512 + ch];
      ya[q] = s_b * (c0 * w0 + c1 * w1 + c2 * w2);
      float g = hi ? bfhi(ggp[w]) : bflo(ggp[w]);
      float ge = 0.5f * g * (1.f + tanhf_(0.7978845608028654f * (g + 0.044715f * g * g * g)));
      yb[q] = ge * (hf[q] + hf[512 + q]);
    }
    uint4 oa, ob;
    oa.x = pack2(ya[0], ya[1]); oa.y = pack2(ya[2], ya[3]); oa.z = pack2(ya[4], ya[5]); oa.w = pack2(ya[6], ya[7]);
    ob.x = pack2(yb[0], yb[1]); ob.y = pack2(yb[2], yb[3]); ob.z = pack2(yb[4], yb[5]); ob.w = pack2(yb[6], yb[7]);
    *(uint4*)(mix + (size_t)m * 1024 + c8) = oa;
    *(uint4*)(mix + (size_t)m * 1024 + 512 + c8) = ob;
  }
}

__device__ __forceinline__ float sum8(float v) {
  v += dpp_mov<0xB1>(v);
  v += dpp_mov<0x4E>(v);
  v += dpp_mov<0x141>(v);
  return v;
}
#define RSTR 72
__device__ __forceinline__ void rwkv_item(const P& p, int j, int it, const u16* __restrict__ prw, u16* __restrict__ obuf,
                                          float* __restrict__ bonus, float* out_rwkv, char* smem) {
  float* BUF = (float*)smem;
  float* OBB = BUF + 12288;
  float* SSB = OBB + 2048;
  float* mur = SSB + 32;
  float* muk = mur + 64;
  float* muv = muk + 64;
  float* kkp = muv + 64;
  float* kap = kkp + 64;
  float* rkp = kap + 64;
  float* w0p = rkp + 64;
  float* a0p = w0p + 64;
  u16* TWb = (u16*)(a0p + 64);
  u16* LAb = TWb + 16 * RSTR;
  u16* W2T = LAb + 16 * RSTR;
  u16* A2T = W2T + 64 * RSTR;
  const int tid = otid();
  const int lat = it < 256;
  const int it2 = lat ? it : it - 256;
  const int b = it2 >> 5, hd = (it2 >> 2) & 7, d = (it2 >> 1) & 1, half = it2 & 1;
  const int mbase = lat ? MCTX + b * 4096 : b * 256;
  const int Lseq = lat ? 4096 : 256;
  const int line = lat ? 64 : 256;
  const int nchunk = Lseq >> 4;
  for (int e = tid; e < 4096; e += NTHR) {
    int u = e >> 6, ch = e & 63;
    W2T[ch * RSTR + u] = f2bf(p.rw_w2[((size_t)(j * 2 + d) * 64 + u) * 512 + hd * 64 + ch]);
    A2T[ch * RSTR + u] = f2bf(p.rw_a2[((size_t)(j * 2 + d) * 64 + u) * 512 + hd * 64 + ch]);
  }
  if (tid < 64) {
    int cidx = hd * 64 + tid;
    mur[tid] = p.rw_mu[(j * 4 + 0) * 512 + cidx];
    muk[tid] = p.rw_mu[(j * 4 + 1) * 512 + cidx];
    muv[tid] = p.rw_mu[(j * 4 + 2) * 512 + cidx];
    kkp[tid] = p.rw_kk[j * 512 + cidx];
    kap[tid] = p.rw_ka[j * 512 + cidx];
    rkp[tid] = p.rw_rk[(j * 8 + hd) * 64 + tid];
    w0p[tid] = p.rw_w0[(j * 2 + d) * 512 + cidx];
    a0p[tid] = p.rw_a0[(j * 2 + d) * 512 + cidx];
  }
  const bool isprep = tid >= 256;
  const int pt = tid & 255;
  const int sq = pt & 7, srow = half * 32 + (pt >> 3);
  float S0[8];
  {
    const float* s0p = p.state_rwkv + ((((size_t)(b * 2 + j) * 2 + d) * 8 + hd) * 64 + srow) * 64 + sq * 8;
#pragma unroll
    for (int e = 0; e < 8; ++e) S0[e] = (lat && !isprep) ? s0p[e] : 0.f;
  }
  const int ptok = pt >> 4, c4 = (pt & 15) * 4;
  const int lane = tid & 63, fr = lane & 15, fq = lane >> 4, pw = (tid >> 6) & 3;
  uint2 pf[17];
#define RW_PREFETCH(S0_)                                                                   \
  {                                                                                        \
    const int s_ = (S0_) + ptok;                                                           \
    const int pos_ = s_ & (line - 1);                                                      \
    const u16* pr_ = prw + (size_t)(mbase + s_) * 2560;                                    \
    const u16* pl_ = pos_ > 0 ? pr_ - 2560 : pr_;                                          \
    const u16* pq_ = pos_ < line - 1 ? pr_ + 2560 : pr_;                                   \
    const int cr_ = hd * 64 + c4, cl_ = 2048 + d * 256 + c4;                               \
    pf[0] = *(const uint2*)(pr_ + cr_); pf[1] = *(const uint2*)(pl_ + cr_); pf[2] = *(const uint2*)(pq_ + cr_);                      \
    pf[3] = *(const uint2*)(pr_ + cr_ + 512); pf[4] = *(const uint2*)(pl_ + cr_ + 512); pf[5] = *(const uint2*)(pq_ + cr_ + 512);    \
    pf[6] = *(const uint2*)(pr_ + cr_ + 1024); pf[7] = *(const uint2*)(pl_ + cr_ + 1024); pf[8] = *(const uint2*)(pq_ + cr_ + 1024); \
    pf[9] = *(const uint2*)(pr_ + cl_);                                                                                             \
    pf[10] = *(const uint2*)(pr_ + cl_ + 64); pf[11] = *(const uint2*)(pl_ + cl_ + 64); pf[12] = *(const uint2*)(pq_ + cl_ + 64);    \
    pf[13] = *(const uint2*)(pr_ + cl_ + 128);                                                                                      \
    pf[14] = *(const uint2*)(pr_ + cl_ + 192); pf[15] = *(const uint2*)(pl_ + cl_ + 192); pf[16] = *(const uint2*)(pq_ + cl_ + 192); \
  }
#define RW_CHUNK_S0(I) ((d ? nchunk - 1 - (I) : (I)) << 4)
#pragma unroll
  for (int q = 0; q < 17; ++q) pf[q] = make_uint2(0, 0);
  if (isprep) RW_PREFETCH(RW_CHUNK_S0(0))
  __syncthreads();
  float kv4[4] = {0.f, 0.f, 0.f, 0.f}, a4[4] = {0.f, 0.f, 0.f, 0.f};
#define RW_DECL(X) float4 k0##X, k1##X, w0##X, w1##X, b0##X, b1##X, d0##X, d1##X, r0##X, r1##X; float vv##X;
#define RW_LOAD(X, TT)                                                                     \
  {                                                                                        \
    const int tk_ = d ? 15 - (TT) : (TT);                                                  \
    const int o8_ = tk_ * 64 + sq * 8;                                                     \
    k0##X = *(const float4*)(sb + 3072 + o8_); k1##X = *(const float4*)(sb + 3072 + o8_ + 4);   \
    w0##X = *(const float4*)(sb + 4096 + o8_); w1##X = *(const float4*)(sb + 4096 + o8_ + 4);   \
    b0##X = *(const float4*)(sb + 5120 + o8_); b1##X = *(const float4*)(sb + 5120 + o8_ + 4);   \
    d0##X = *(const float4*)(sb + 1024 + o8_); d1##X = *(const float4*)(sb + 1024 + o8_ + 4);   \
    r0##X = *(const float4*)(sb + o8_); r1##X = *(const float4*)(sb + o8_ + 4);                 \
    vv##X = sb[2048 + tk_ * 64 + srow];                                                          \
  }
#define RW_STEP(X, TT)                                                                                                      \
  {                                                                                                                         \
    const int tk_ = d ? 15 - (TT) : (TT);                                                                                   \
    float sa0 = (S0[0] * k0##X.x + S0[1] * k0##X.y) + (S0[2] * k0##X.z + S0[3] * k0##X.w) + (S0[4] * k1##X.x + S0[5] * k1##X.y) + \
                (S0[6] * k1##X.z + S0[7] * k1##X.w);                                                                        \
    sa0 = sum8(sa0);                                                                                                        \
    S0[0] = S0[0] * w0##X.x - sa0 * b0##X.x + vv##X * d0##X.x; S0[1] = S0[1] * w0##X.y - sa0 * b0##X.y + vv##X * d0##X.y;   \
    S0[2] = S0[2] * w0##X.z - sa0 * b0##X.z + vv##X * d0##X.z; S0[3] = S0[3] * w0##X.w - sa0 * b0##X.w + vv##X * d0##X.w;   \
    S0[4] = S0[4] * w1##X.x - sa0 * b1##X.x + vv##X * d1##X.x; S0[5] = S0[5] * w1##X.y - sa0 * b1##X.y + vv##X * d1##X.y;   \
    S0[6] = S0[6] * w1##X.z - sa0 * b1##X.z + vv##X * d1##X.z; S0[7] = S0[7] * w1##X.w - sa0 * b1##X.w + vv##X * d1##X.w;   \
    float o0 = (S0[0] * r0##X.x + S0[1] * r0##X.y) + (S0[2] * r0##X.z + S0[3] * r0##X.w) + (S0[4] * r1##X.x + S0[5] * r1##X.y) + \
               (S0[6] * r1##X.z + S0[7] * r1##X.w);                                                                         \
    o0 = sum8(o0);                                                                                                          \
    if (sq == 0) ob[tk_ * 64 + srow] = o0;                                                                                  \
  }
#define RW_RUN(T0, T1)                                          \
  {                                                             \
    RW_LOAD(A, T0)                                              \
    _Pragma("unroll") for (int tt = (T0); tt < (T1); tt += 2) { \
      RW_LOAD(B, min(tt + 1, 15))                               \
      __builtin_amdgcn_sched_barrier(0);                        \
      RW_STEP(A, tt)                                            \
      RW_LOAD(A, min(tt + 2, 15))                               \
      __builtin_amdgcn_sched_barrier(0);                        \
      if (tt + 1 < (T1)) RW_STEP(B, tt + 1)                     \
    }                                                           \
  }
  RW_DECL(A) RW_DECL(B)
  for (int i = 0; i <= nchunk + 1; ++i) {
    const bool doprep = isprep && (i < nchunk);
    const bool doscan = (!isprep) && (i >= 1) && (i <= nchunk);
    float* pbuf = BUF + (i & 1) * 6144;
    const float* sb = BUF + ((i - 1) & 1) * 6144;
    float* ob = OBB + ((i - 1) & 1) * 1024;
    const int s0 = RW_CHUNK_S0(i);
    if (isprep) {
      if (i >= 2) {
        const int c2 = half * 32 + (pt & 15) * 2;
        const float2 o2 = *(const float2*)(OBB + (i & 1) * 1024 + ptok * 64 + c2);
        *(u32*)(obuf + ((size_t)(mbase + RW_CHUNK_S0(i - 2) + ptok) * 2 + d) * 512 + hd * 64 + c2) = pack2(o2.x, o2.y);
      }
      if (doprep) {
        const int pos = (s0 + ptok) & (line - 1);
        const float mL = pos > 0 ? 0.5f : 0.f, mR = pos < line - 1 ? 0.5f : 0.f;
        float rm[4], km[4], vm[4], tw[4], la[4];
#pragma unroll
        for (int q = 0; q < 4; ++q) {
          const int ch = c4 + q;
#define PFV(ix) ((q & 1) ? bfhi((q >> 1) ? pf[ix].y : pf[ix].x) : bflo((q >> 1) ? pf[ix].y : pf[ix].x))
          float x0 = PFV(0), xl = PFV(1), xr = PFV(2);
          rm[q] = x0 + (mL * xl + mR * xr - x0) * mur[ch];
          x0 = PFV(3); xl = PFV(4); xr = PFV(5);
          km[q] = x0 + (mL * xl + mR * xr - x0) * muk[ch];
          x0 = PFV(6); xl = PFV(7); xr = PFV(8);
          vm[q] = x0 + (mL * xl + mR * xr - x0) * muv[ch];
          tw[q] = tanhf_(PFV(9) + mL * PFV(11) + mR * PFV(12) - PFV(10));
          la[q] = PFV(13) + mL * PFV(15) + mR * PFV(16) - PFV(14);
#undef PFV
        }
        *(float4*)(pbuf + ptok * 64 + c4) = make_float4(rm[0], rm[1], rm[2], rm[3]);
        *(float4*)(pbuf + 1024 + ptok * 64 + c4) = make_float4(km[0], km[1], km[2], km[3]);
        *(float4*)(pbuf + 2048 + ptok * 64 + c4) = make_float4(vm[0], vm[1], vm[2], vm[3]);
        uint2 t2, l2;
        t2.x = pack2(tw[0], tw[1]); t2.y = pack2(tw[2], tw[3]);
        l2.x = pack2(la[0], la[1]); l2.y = pack2(la[2], la[3]);
        *(uint2*)(TWb + ptok * RSTR + c4) = t2;
        *(uint2*)(LAb + ptok * RSTR + c4) = l2;
        if (pt < 32) SSB[pt] = 0.f;
        if (i + 1 < nchunk) RW_PREFETCH(RW_CHUNK_S0(i + 1))
      }
    } else if (doscan) {
      RW_RUN(0, 6)
    }
    __syncthreads();
    const int tok2 = fr, ch2 = 16 * pw + 4 * fq;
    if (isprep) {
      if (doprep) {
        f32x4 accw = {0.f, 0.f, 0.f, 0.f}, acca = {0.f, 0.f, 0.f, 0.f};
#pragma unroll
        for (int ks = 0; ks < 2; ++ks) {
          bf16x8 wa = *(const bf16x8*)(W2T + (16 * pw + fr) * RSTR + ks * 32 + fq * 8);
          bf16x8 tb8 = *(const bf16x8*)(TWb + fr * RSTR + ks * 32 + fq * 8);
          accw = __builtin_amdgcn_mfma_f32_16x16x32_bf16(wa, tb8, accw, 0, 0, 0);
          bf16x8 aa = *(const bf16x8*)(A2T + (16 * pw + fr) * RSTR + ks * 32 + fq * 8);
          bf16x8 lb8 = *(const bf16x8*)(LAb + fr * RSTR + ks * 32 + fq * 8);
          acca = __builtin_amdgcn_mfma_f32_16x16x32_bf16(aa, lb8, acca, 0, 0, 0);
        }
        const float4 km4 = *(const float4*)(pbuf + 1024 + tok2 * 64 + ch2);
        const float4 rm4 = *(const float4*)(pbuf + tok2 * 64 + ch2);
        const float kmv[4] = {km4.x, km4.y, km4.z, km4.w};
        const float rmv[4] = {rm4.x, rm4.y, rm4.z, rm4.w};
        float ss = 0.f, bon = 0.f;
        float dec[4], kd[4];
#pragma unroll
        for (int r = 0; r < 4; ++r) {
          const int ch = ch2 + r;
          float wraw = -softplusf_(-(w0p[ch] + accw[r])) - 0.5f;
          dec[r] = __expf(-__expf(wraw));
          float a = sigmoidf_(a0p[ch] + acca[r]);
          float kv = kmv[r] * kkp[ch];
          ss += kv * kv;
          kd[r] = kmv[r] * (1.f + (a - 1.f) * kap[ch]);
          bon += rmv[r] * kd[r] * rkp[ch];
          a4[r] = a;
          kv4[r] = kv;
        }
        *(float4*)(pbuf + 4096 + tok2 * 64 + ch2) = make_float4(dec[0], dec[1], dec[2], dec[3]);
        *(float4*)(pbuf + 1024 + tok2 * 64 + ch2) = make_float4(kd[0], kd[1], kd[2], kd[3]);
        ss += __shfl_xor(ss, 16); ss += __shfl_xor(ss, 32);
        bon += __shfl_xor(bon, 16); bon += __shfl_xor(bon, 32);
        if (fq == 0) { atomicAdd(&SSB[tok2], ss); atomicAdd(&SSB[16 + tok2], bon); }
      }
    } else if (doscan) {
      RW_RUN(6, 11)
    }
    __syncthreads();
    if (isprep) {
      if (doprep) {
        const float inv = rsqrtf(SSB[tok2] + 1e-12f);
        float kk[4];
#pragma unroll
        for (int r = 0; r < 4; ++r) kk[r] = kv4[r] * inv;
        *(float4*)(pbuf + 3072 + tok2 * 64 + ch2) = make_float4(kk[0], kk[1], kk[2], kk[3]);
        *(float4*)(pbuf + 5120 + tok2 * 64 + ch2) = make_float4(kk[0] * a4[0], kk[1] * a4[1], kk[2] * a4[2], kk[3] * a4[3]);
        if (half == 0 && pw == 0 && fq == 0) bonus[((size_t)(mbase + s0 + tok2) * 2 + d) * 8 + hd] = SSB[16 + tok2];
      }
    } else if (doscan) {
      RW_RUN(11, 16)
    }
    __syncthreads();
  }
#undef RW_PREFETCH
#undef RW_CHUNK_S0
#undef RW_DECL
#undef RW_LOAD
#undef RW_STEP
#undef RW_RUN
  if (!lat && !isprep) {
    float* dst = out_rwkv + ((((size_t)(b * 2 + j) * 2 + d) * 8 + hd) * 64 + srow) * 64 + sq * 8;
#pragma unroll
    for (int e = 0; e < 8; ++e) dst[e] = S0[e];
  }
  __syncthreads();
}

template <int GRP>
struct HyCfg {
  static constexpr int NB = GRP == 0 ? 8 : 32;
  static constexpr int NBLK = GRP == 0 ? 64 : 4;
  static constexpr int LSEQ = GRP == 0 ? 4096 : 256;
  static constexpr int NTW = GRP == 0 ? 4 : 1;
  static constexpr int MB = GRP == 0 ? MCTX : 0;
  static constexpr int LINE = GRP == 0 ? 64 : 256;
};

template <int GRP>
__device__ __forceinline__ void hyena_conv(const u16* ZS, const u16* FLB, f32x4 (&acc)[4][HyCfg<GRP>::NTW], int wave, int fr,
                                           int fq) {
  typedef HyCfg<GRP> Cf;
  constexpr int FLEN = 2 * Cf::LSEQ;
  const int colw0 = wave * Cf::NTW * 16;
  const int i_lo = colw0 / Cf::NB, i_hi = (colw0 + Cf::NTW * 16 - 1) / Cf::NB;
  const int o0 = Cf::LSEQ + 8 * fq - fr;
  const u16* fbase = (fr & 1) ? (FLB + FLEN + o0 - 1) : (FLB + o0);
#pragma unroll 1
  for (int d = -(Cf::NBLK - 1); d <= Cf::NBLK - 1; ++d) {
    if (i_hi - d < 0 || i_lo - d > Cf::NBLK - 1) continue;
    const u16* fd = fbase - 64 * d;
    bf16x8 f[6];
#pragma unroll
    for (int v = 0; v < 6; ++v) {
      const int off = (v < 4) ? (-16 * v) : (v == 4 ? 32 : 16);
      const u32* fp = (const u32*)(fd + off);
      uint4 t = make_uint4(fp[0], fp[1], fp[2], fp[3]);
      f[v] = *(bf16x8*)&t;
    }
#pragma unroll
    for (int nt = 0; nt < Cf::NTW; ++nt) {
      const int colg0 = colw0 + nt * 16;
      const int t_lo = colg0 / Cf::NB, t_hi = (colg0 + 15) / Cf::NB;
      if (t_hi - d < 0 || t_lo - d > Cf::NBLK - 1) continue;
      const int colg = colg0 + fr;
      const int i = colg / Cf::NB, b = colg % Cf::NB;
      const int k = i - d;
      const bool valid = (k >= 0) && (k < Cf::NBLK);
      uint4 t0 = make_uint4(0, 0, 0, 0), t1 = make_uint4(0, 0, 0, 0);
      if (valid) {
        t0 = *(const uint4*)(ZS + b * Cf::LSEQ + 64 * k + 8 * fq);
        t1 = *(const uint4*)(ZS + b * Cf::LSEQ + 64 * k + 32 + 8 * fq);
      }
      const bf16x8 b0 = *(bf16x8*)&t0, b1 = *(bf16x8*)&t1;
      acc[0][nt] = __builtin_amdgcn_mfma_f32_16x16x32_bf16(f[0], b0, acc[0][nt], 0, 0, 0);
      acc[1][nt] = __builtin_amdgcn_mfma_f32_16x16x32_bf16(f[1], b0, acc[1][nt], 0, 0, 0);
      acc[2][nt] = __builtin_amdgcn_mfma_f32_16x16x32_bf16(f[2], b0, acc[2][nt], 0, 0, 0);
      acc[3][nt] = __builtin_amdgcn_mfma_f32_16x16x32_bf16(f[3], b0, acc[3][nt], 0, 0, 0);
      acc[0][nt] = __builtin_amdgcn_mfma_f32_16x16x32_bf16(f[4], b1, acc[0][nt], 0, 0, 0);
      acc[1][nt] = __builtin_amdgcn_mfma_f32_16x16x32_bf16(f[5], b1, acc[1][nt], 0, 0, 0);
      acc[2][nt] = __builtin_amdgcn_mfma_f32_16x16x32_bf16(f[0], b1, acc[2][nt], 0, 0, 0);
      acc[3][nt] = __builtin_amdgcn_mfma_f32_16x16x32_bf16(f[1], b1, acc[3][nt], 0, 0, 0);
      if (nt & 1) asm volatile("" ::: "memory");
    }
  }
}

template <int FLEN>
__device__ __forceinline__ void hyena_load_filter(const u16* __restrict__ f, u16* FLB, int tid) {
  for (int e8 = tid; e8 < FLEN / 8; e8 += NTHR) {
    const uint4 v = *(const uint4*)(f + e8 * 8);
    const u32 nx = (e8 * 8 + 8 < FLEN) ? (u32)f[e8 * 8 + 8] : 0u;
    *(uint4*)(FLB + e8 * 8) = v;
    uint4 sft;
    sft.x = (v.x >> 16) | (v.y << 16);
    sft.y = (v.y >> 16) | (v.z << 16);
    sft.z = (v.z >> 16) | (v.w << 16);
    sft.w = (v.w >> 16) | (nx << 16);
    *(uint4*)(FLB + FLEN + e8 * 8) = sft;
  }
}

template <int GRP>
__device__ __forceinline__ void hyena_item(const P& p, int j, int c, u16* UT, u16* YO, const u16* FILT,
                                           const float* SUMSQ, char* smem) {
  typedef HyCfg<GRP> Cf;
  u16* ZS = (u16*)smem;
  u16* FLB = (u16*)(smem + 65536);
  constexpr int FLEN = 2 * Cf::LSEQ;
  const u16* filt0 = FILT + (GRP == 0 ? (size_t)0 : (size_t)2 * 512 * 8192);
  const int tid = otid(), wave = tid >> 6, lane = tid & 63, fr = lane & 15, fq = lane >> 4;
  const size_t MM = MTOK;
  {
    const float h0 = p.hy_conv[(j * 3 + 0) * 1536 + c], h1 = p.hy_conv[(j * 3 + 1) * 1536 + c], h2 = p.hy_conv[(j * 3 + 2) * 1536 + c];
    const u16* ur = UT + (size_t)c * MM + Cf::MB;
#pragma unroll 2
    for (int e8 = tid; e8 < Cf::NB * Cf::LSEQ / 8; e8 += NTHR) {
      const int e0 = e8 * 8;
      const int pos = e0 & (Cf::LINE - 1);
      const uint4 v = *(const uint4*)(ur + e0);
      const float xm = pos > 0 ? bf2f(ur[e0 - 1]) : 0.f;
      const float xp = pos + 8 < Cf::LINE ? bf2f(ur[e0 + 8]) : 0.f;
      const float x0 = bflo(v.x), x1 = bfhi(v.x), x2 = bflo(v.y), x3 = bfhi(v.y), x4 = bflo(v.z), x5 = bfhi(v.z), x6 = bflo(v.w),
                  x7 = bfhi(v.w);
      uint4 o;
      o.x = pack2(x0 * h1 + xm * h0 + x1 * h2, x1 * h1 + x0 * h0 + x2 * h2);
      o.y = pack2(x2 * h1 + x1 * h0 + x3 * h2, x3 * h1 + x2 * h0 + x4 * h2);
      o.z = pack2(x4 * h1 + x3 * h0 + x5 * h2, x5 * h1 + x4 * h0 + x6 * h2);
      o.w = pack2(x6 * h1 + x5 * h0 + x7 * h2, x7 * h1 + x6 * h0 + xp * h2);
      *(uint4*)(ZS + e0) = o;
    }
    hyena_load_filter<FLEN>(filt0 + (size_t)(0 * 512 + c) * FLEN, FLB, tid);
  }
  uint2 hxr[4][Cf::NTW];
#define HY_PREFETCH(UP)                                                                                      \
  _Pragma("unroll") for (int mb = 0; mb < 4; ++mb) _Pragma("unroll") for (int nt = 0; nt < Cf::NTW; ++nt) {   \
    const int colg = (wave * Cf::NTW + nt) * 16 + fr;                                                         \
    const int i = colg / Cf::NB, b = colg % Cf::NB;                                                           \
    const int t0 = 64 * i + 16 * mb + 4 * fq;                                                                 \
    const int e0 = b * Cf::LSEQ + t0;                                                                         \
    hxr[mb][nt] = *(const uint2*)((UP) + e0);                                                                 \
  }
#define HY_HALO(UP)                                                                                          \
  _Pragma("unroll") for (int mb = 0; mb < 4; ++mb) _Pragma("unroll") for (int nt = 0; nt < Cf::NTW; ++nt) {   \
    const int colg = (wave * Cf::NTW + nt) * 16 + fr;                                                         \
    const int i = colg / Cf::NB, b = colg % Cf::NB;                                                           \
    const int t0 = 64 * i + 16 * mb + 4 * fq;                                                                 \
    const int e0 = b * Cf::LSEQ + t0;                                                                         \
    const u32 lo_ = ((t0 & (Cf::LINE - 1)) > 0) ? (u32)(UP)[e0 - 1] : 0u;                                     \
    const u32 hi_ = (((t0 + 3) & (Cf::LINE - 1)) < Cf::LINE - 1) ? (u32)(UP)[e0 + 4] : 0u;                    \
    hxh[mb][nt] = lo_ | (hi_ << 16);                                                                          \
  }
  const u16* u1 = UT + (size_t)(512 + c) * MM + Cf::MB;
  HY_PREFETCH(u1)
  __syncthreads();
  f32x4 acc[4][Cf::NTW];
#pragma unroll
  for (int mb = 0; mb < 4; ++mb)
#pragma unroll
    for (int nt = 0; nt < Cf::NTW; ++nt) acc[mb][nt] = f32x4{0.f, 0.f, 0.f, 0.f};
  hyena_conv<GRP>(ZS, FLB, acc, wave, fr, fq);
  {
    const float scale = rsqrtf(SUMSQ[((j * 2 + GRP) * 2 + 0) * 512 + c] + 1e-6f);
    const float bias = p.hy_bias[(j * 2 + 0) * 512 + c];
    const float g0 = p.hy_conv[(j * 3 + 0) * 1536 + 512 + c], g1 = p.hy_conv[(j * 3 + 1) * 1536 + 512 + c],
                g2 = p.hy_conv[(j * 3 + 2) * 1536 + 512 + c];
    u32 hxh[4][Cf::NTW];
    HY_HALO(u1)
#pragma unroll
    for (int mb = 0; mb < 4; ++mb)
#pragma unroll
      for (int nt = 0; nt < Cf::NTW; ++nt) {
        const int colg = (wave * Cf::NTW + nt) * 16 + fr;
        const int i = colg / Cf::NB, b = colg % Cf::NB;
        const int e0 = b * Cf::LSEQ + 64 * i + 16 * mb + 4 * fq;
        const uint2 raw = hxr[mb][nt];
        const uint2 zr = *(const uint2*)(ZS + e0);
        const float xm = bflo(hxh[mb][nt]), xp = bfhi(hxh[mb][nt]);
        const float x0 = bflo(raw.x), x1 = bfhi(raw.x), x2 = bflo(raw.y), x3 = bfhi(raw.y);
        acc[mb][nt][0] = (x0 * g1 + xm * g0 + x1 * g2) * (scale * acc[mb][nt][0] + bias * bflo(zr.x));
        acc[mb][nt][1] = (x1 * g1 + x0 * g0 + x2 * g2) * (scale * acc[mb][nt][1] + bias * bfhi(zr.x));
        acc[mb][nt][2] = (x2 * g1 + x1 * g0 + x3 * g2) * (scale * acc[mb][nt][2] + bias * bflo(zr.y));
        acc[mb][nt][3] = (x3 * g1 + x2 * g0 + xp * g2) * (scale * acc[mb][nt][3] + bias * bfhi(zr.y));
        asm volatile("" : "+v"(acc[mb][nt]) : : "memory");
      }
  }
  __syncthreads();
#pragma unroll
  for (int mb = 0; mb < 4; ++mb)
#pragma unroll
    for (int nt = 0; nt < Cf::NTW; ++nt) {
      const int colg = (wave * Cf::NTW + nt) * 16 + fr;
      const int i = colg / Cf::NB, b = colg % Cf::NB;
      const int e0 = b * Cf::LSEQ + 64 * i + 16 * mb + 4 * fq;
      uint2 pk;
      pk.x = pack2(acc[mb][nt][0], acc[mb][nt][1]);
      pk.y = pack2(acc[mb][nt][2], acc[mb][nt][3]);
      *(uint2*)(ZS + e0) = pk;
      acc[mb][nt] = f32x4{0.f, 0.f, 0.f, 0.f};
    }
  hyena_load_filter<FLEN>(filt0 + (size_t)(1 * 512 + c) * FLEN, FLB, tid);
  const u16* u2 = UT + (size_t)(1024 + c) * MM + Cf::MB;
  HY_PREFETCH(u2)
  __syncthreads();
  hyena_conv<GRP>(ZS, FLB, acc, wave, fr, fq);
  {
    const float scale = rsqrtf(SUMSQ[((j * 2 + GRP) * 2 + 1) * 512 + c] + 1e-6f);
    const float bias = p.hy_bias[(j * 2 + 1) * 512 + c];
    const float g0 = p.hy_conv[(j * 3 + 0) * 1536 + 1024 + c], g1 = p.hy_conv[(j * 3 + 1) * 1536 + 1024 + c],
                g2 = p.hy_conv[(j * 3 + 2) * 1536 + 1024 + c];
    u16* yo = YO + (size_t)c * MM + Cf::MB;
    u32 hxh[4][Cf::NTW];
    HY_HALO(u2)
#pragma unroll
    for (int mb = 0; mb < 4; ++mb)
#pragma unroll
      for (int nt = 0; nt < Cf::NTW; ++nt) {
        const int colg = (wave * Cf::NTW + nt) * 16 + fr;
        const int i = colg / Cf::NB, b = colg % Cf::NB;
        const int e0 = b * Cf::LSEQ + 64 * i + 16 * mb + 4 * fq;
        const uint2 raw = hxr[mb][nt];
        const uint2 zr = *(const uint2*)(ZS + e0);
        const float xm = bflo(hxh[mb][nt]), xp = bfhi(hxh[mb][nt]);
        const float x0 = bflo(raw.x), x1 = bfhi(raw.x), x2 = bflo(raw.y), x3 = bfhi(raw.y);
        const float y0 = (x0 * g1 + xm * g0 + x1 * g2) * (scale * acc[mb][nt][0] + bias * bflo(zr.x));
        const float y1 = (x1 * g1 + x0 * g0 + x2 * g2) * (scale * acc[mb][nt][1] + bias * bfhi(zr.x));
        const float y2 = (x2 * g1 + x1 * g0 + x3 * g2) * (scale * acc[mb][nt][2] + bias * bflo(zr.y));
        const float y3 = (x3 * g1 + x2 * g0 + xp * g2) * (scale * acc[mb][nt][3] + bias * bfhi(zr.y));
        uint2 pk;
        pk.x = pack2(y0, y1);
        pk.y = pack2(y2, y3);
        *(uint2*)(yo + e0) = pk;
        asm volatile("" ::: "memory");
      }
  }
#undef HY_PREFETCH
#undef HY_HALO
  __syncthreads();
}

__device__ __forceinline__ void phase_cdscan(const P& p, int j, const u16* prw, u16* obuf, float* bonus, float* out_rwkv, u16* UT,
                                             const u16* FILT, const float* SUMSQ, int* ctr, char* smem) {
  int* sitem = (int*)(smem + SMEM_BYTES - 16);
  for (;;) {
    if (otid() == 0) *sitem = atomicAdd(ctr, 1);
    __syncthreads();
    const int it = *sitem;
    __syncthreads();
    if (it >= 1280 + 1024) break;
    if (it < 1280) {
#ifndef NO_RW
      for (int rep = 0; rep < REP_RW; ++rep) rwkv_item(p, j, it, prw, obuf, bonus, out_rwkv, smem);
#endif
    } else if (it < 1280 + 512) {
#ifndef NO_HY0
      for (int rep = 1; rep < REP_HY; ++rep) hyena_item<0>(p, j, it - 1280, UT, UT + (size_t)1536 * MTOK, FILT, SUMSQ, smem);
      hyena_item<0>(p, j, it - 1280, UT, UT, FILT, SUMSQ, smem);
#endif
    } else {
#ifndef NO_HY1
      for (int rep = 1; rep < REP_HY; ++rep) hyena_item<1>(p, j, it - 1792, UT, UT + (size_t)1536 * MTOK, FILT, SUMSQ, smem);
      hyena_item<1>(p, j, it - 1792, UT, UT, FILT, SUMSQ, smem);
#endif
    }
  }
}

__device__ __forceinline__ void phase_cdfinal(const P& p, int j, const u16* __restrict__ prw, const u16* __restrict__ obuf,
                                              const float* __restrict__ bonus, const u16* __restrict__ UT, u16* __restrict__ mix,
                                              char* smem) {
  const int tid = otid(), lane = tid & 63;
  {
    const int gw = blockIdx.x * 8 + (tid >> 6);
    const int c8 = lane * 8, hd = lane >> 3;
    float gg[8], gb[8], muv[8], mug[8];
#pragma unroll
    for (int q = 0; q < 8; ++q) {
      gg[q] = p.rw_gn_g[j * 512 + c8 + q];
      gb[q] = p.rw_gn_b[j * 512 + c8 + q];
      muv[q] = p.rw_mu[(j * 4 + 2) * 512 + c8 + q];
      mug[q] = p.rw_mu[(j * 4 + 3) * 512 + c8 + q];
    }
    for (int m = gw; m < MTOK; m += gridDim.x * 8) {
      const int line = m < MCTX ? 256 : 64;
      const int pos = m & (line - 1);
      const float mL = pos > 0 ? 0.5f : 0.f, mR = pos < line - 1 ? 0.5f : 0.f;
      const u16* pr = prw + (size_t)m * 2560;
      const u16* pl = pos > 0 ? pr - 2560 : pr;
      const u16* pq = pos < line - 1 ? pr + 2560 : pr;
      const uint4 o0 = *(const uint4*)(obuf + ((size_t)m * 2 + 0) * 512 + c8);
      const uint4 o1 = *(const uint4*)(obuf + ((size_t)m * 2 + 1) * 512 + c8);
      const uint4 v0 = *(const uint4*)(pr + 1024 + c8), vl = *(const uint4*)(pl + 1024 + c8), vr = *(const uint4*)(pq + 1024 + c8);
      const uint4 g0 = *(const uint4*)(pr + 1536 + c8), gl = *(const uint4*)(pl + 1536 + c8), gr = *(const uint4*)(pq + 1536 + c8);
      const float bon = bonus[((size_t)m * 2 + 0) * 8 + hd] + bonus[((size_t)m * 2 + 1) * 8 + hd];
      const u32* o0p = (const u32*)&o0; const u32* o1p = (const u32*)&o1;
      const u32* v0p = (const u32*)&v0; const u32* vlp = (const u32*)&vl; const u32* vrp = (const u32*)&vr;
      const u32* g0p = (const u32*)&g0; const u32* glp = (const u32*)&gl; const u32* grp = (const u32*)&gr;
      float o[8];
      float s1 = 0.f;
#pragma unroll
      for (int q = 0; q < 8; ++q) {
        const int w = q >> 1;
        o[q] = (q & 1) ? (bfhi(o0p[w]) + bfhi(o1p[w])) : (bflo(o0p[w]) + bflo(o1p[w]));
        s1 += o[q];
      }
      const float mean = sum8(s1) * (1.f / 64.f);
      float s2 = 0.f;
#pragma unroll
      for (int q = 0; q < 8; ++q) { o[q] -= mean; s2 += o[q] * o[q]; }
      const float rstd = rsqrtf(sum8(s2) * (1.f / 64.f) + 64e-5f);
      float y[8];
#pragma unroll
      for (int q = 0; q < 8; ++q) {
        const int w = q >> 1;
        const bool hi = q & 1;
        const float x0 = hi ? bfhi(v0p[w]) : bflo(v0p[w]), xl = hi ? bfhi(vlp[w]) : bflo(vlp[w]), xr = hi ? bfhi(vrp[w]) : bflo(vrp[w]);
        const float vm = x0 + (mL * xl + mR * xr - x0) * muv[q];
        const float y0 = hi ? bfhi(g0p[w]) : bflo(g0p[w]), yl = hi ? bfhi(glp[w]) : bflo(glp[w]), yr = hi ? bfhi(grp[w]) : bflo(grp[w]);
        const float gm = y0 + (mL * yl + mR * yr - y0) * mug[q];
        const float on = o[q] * rstd * gg[q] + gb[q];
        y[q] = (on + bon * vm) * sigmoidf_(gm);
      }
      uint4 pk;
      pk.x = pack2(y[0], y[1]); pk.y = pack2(y[2], y[3]); pk.z = pack2(y[4], y[5]); pk.w = pack2(y[6], y[7]);
      *(uint4*)(mix + (size_t)m * 1024 + 512 + c8) = pk;
    }
  }
  {
    u16* tl = (u16*)smem;
    for (int t = blockIdx.x; t < 640 * 8; t += gridDim.x) {
      const int mt = t >> 3, ct = t & 7;
      for (int e = tid; e < 4096; e += NTHR) {
        int cc = e >> 6, mm = e & 63;
        tl[cc * 66 + mm] = UT[(size_t)(ct * 64 + cc) * MTOK + mt * 64 + mm];
      }
      __syncthreads();
      for (int e = tid; e < 4096; e += NTHR) {
        int mm = e >> 6, cc = e & 63;
        mix[(size_t)(mt * 64 + mm) * 1024 + ct * 64 + cc] = tl[cc * 66 + mm];
      }
      __syncthreads();
    }
  }
}

#ifndef PHMASK
#define PHMASK 0xffffffffu
#endif
#define PHS(b) ((PHMASK >> (b)) & 1u)
#define XB_XCNT(j) (256 + 64 * (j))
#define XB_XSUB(j) (1280 + 64 * (j))
#define XB_XGEN(j) (2304 + 64 * (j))
#define XB_TOP 3328
#define XB_TOPGEN 3392
#define XCD_BAR_WORDS 3456
__device__ __forceinline__ unsigned xb_ld(unsigned* p) { return __hip_atomic_load(p, __ATOMIC_RELAXED, __HIP_MEMORY_SCOPE_AGENT); }
__device__ __forceinline__ unsigned xb_add(unsigned* p, unsigned v) { return __hip_atomic_fetch_add(p, v, __ATOMIC_RELAXED, __HIP_MEMORY_SCOPE_AGENT); }
__device__ __forceinline__ unsigned xb_xcc_id() { return (unsigned)__builtin_amdgcn_s_getreg((3 << 11) | 20) & 0xFu; }
__device__ __forceinline__ void xcd_barrier(unsigned* bar, volatile unsigned* st) {
  asm volatile("s_waitcnt vmcnt(0)" ::: "memory");
  __syncthreads();
  if (otid() == 0) {
    __builtin_amdgcn_s_waitcnt(0);
    const unsigned x = xb_xcc_id();
    unsigned nloc = st[0], nx = st[1];
    if (nloc == 0u) {
      const unsigned G = gridDim.x;
      unsigned sum, cnt, mine;
      for (;;) {
        sum = 0u; cnt = 0u; mine = 0u;
#pragma unroll
        for (unsigned jx = 0; jx < 16; ++jx) {
          const unsigned c = xb_ld(&bar[XB_XCNT(jx)]);
          sum += c; cnt += (c > 0u) ? 1u : 0u; mine = (jx == x) ? c : mine;
        }
        if (sum == G) break;
        __builtin_amdgcn_s_sleep(1);
      }
      nloc = mine > 0u ? mine : 1u; nx = cnt > 0u ? cnt : 1u;
      st[0] = nloc; st[1] = nx;
    }
    const unsigned old = xb_add(&bar[XB_XSUB(x)], 1u);
    const unsigned gen = old / nloc;
    if (old + 1u == (gen + 1u) * nloc) {
      __builtin_amdgcn_fence(__ATOMIC_RELEASE, "agent");
      asm volatile("s_waitcnt vmcnt(0)" ::: "memory");
      const unsigned og = xb_add(&bar[XB_TOP], 1u);
      const unsigned tg = og / nx;
      if (og + 1u == (tg + 1u) * nx) xb_add(&bar[XB_TOPGEN], 1u);
      else while (xb_ld(&bar[XB_TOPGEN]) == tg) __builtin_amdgcn_s_sleep(1);
      __builtin_amdgcn_fence(__ATOMIC_ACQUIRE, "agent");
      xb_add(&bar[XB_XGEN(x)], 1u);
      asm volatile("s_waitcnt vmcnt(0)" ::: "memory");
    } else {
      while (xb_ld(&bar[XB_XGEN(x)]) == gen) __builtin_amdgcn_s_sleep(1);
      __builtin_amdgcn_fence(__ATOMIC_ACQUIRE, "agent");
      asm volatile("s_waitcnt vmcnt(0)" ::: "memory");
    }
  }
  __syncthreads();
}
__global__ void __launch_bounds__(NTHR) fwd_megakernel(P p, int ph_begin, int ph_end) {
  extern __shared__ __attribute__((aligned(16))) char smem[];
  cg::grid_group grid = cg::this_grid();
  char* ws = p.ws;
  float* mods = (float*)(ws + OFF_MODS);
  float* bonus = (float*)(ws + OFF_BONUS);
  float* HID2 = (float*)(ws + OFF_HID2);
  float* SUMSQ = (float*)(ws + OFF_SUMSQ);
  int* CTR = (int*)(ws + OFF_CTR);
  u16* WIN = (u16*)(ws + OFF_WIN);
  u16* WOUT = (u16*)(ws + OFF_WOUT);
  u16* W1T = (u16*)(ws + OFF_W1T);
  u16* W2T = (u16*)(ws + OFF_W2T);
  u16* FILT = (u16*)(ws + OFF_FILT);
  u16* H = (u16*)(ws + OFF_H);
  char* arena = ws + OFF_ARENA;
  float* X = p.out;
  float* out_lru = p.out + (size_t)MTOK * 1024;
  float* out_rwkv = out_lru + 32 * 2 * 2 * 512;
  float* smf = (float*)smem;

  volatile unsigned* xst = (volatile unsigned*)(smem + 131072);
  unsigned* xbar = (unsigned*)(p.ws + OFF_BAR);
  if (otid() == 0) { xst[0] = 0u; xst[1] = 0u; (void)xb_add(&xbar[XB_XCNT(xb_xcc_id())], 1u); }
  __syncthreads();
  for (int ph = ph_begin; ph < ph_end; ++ph) {
    if (TSEL && blockIdx.x == 0 && otid() == 0) ((unsigned long long*)(p.ws + OFF_CTR + 1024))[ph] = wall_clock64();
    if (ph == 0) {
      if (blockIdx.x == 0 && otid() < 16) CTR[otid()] = 0;
      for (int i = blockIdx.x * NTHR + otid(); i < 2 * 2 * 2 * 512; i += gridDim.x * NTHR) SUMSQ[i] = 0.f;
      for (int rep = 0; rep < REP_O; ++rep) {
      if (PHS(0)) phase_mods(p, mods, smf);
      __syncthreads();
      if (PHS(1)) phase_hid2(p, HID2, smf);
      if (PHS(2)) { conv_mix_weights(p, 0, ws, smf); }
      __syncthreads(); }
    } else if (ph == 1) {
      for (int rep = 0; rep < REP_O; ++rep) phase_xinit(p, X, mods, H);

    } else {
      const int l = (ph - 2) >> 3, s = (ph - 2) & 7;
      const int j = l >> 1;
      const bool cd = l & 1;
      const float* modl = mods + (size_t)l * 9 * 6144;
      if (s == 0) {
        if (!cd) {
          for (int rep = 0; rep < REP_G; ++rep) gemm_phase<0>(H, 1024, WIN, 1024, 2560, (u16*)arena, 2560, 0, nullptr, nullptr, nullptr, smem);

        } else {
          for (int rep = 0; rep < REP_G; ++rep) gemm_phase<1>(H, 1024, WIN, 1024, 4096, (u16*)arena, 2560, 0, (u16*)(arena + ARENA_B), nullptr, nullptr, smem);
        }

      } else if (s == 1) {
        if (!cd) {
          phase_lru_gates(p, j, (const u16*)arena, (u32*)(arena + ARENA_B), smem);
          xcd_barrier(xbar, xst);
          phase_lru_scan(p, j, (u32*)(arena + ARENA_B), out_lru, CTR + l, smem);
          phase_filtgen(p, j, HID2, FILT, SUMSQ, smf);
        }
        else if (PHS(8)) phase_cdscan(p, j, (const u16*)arena, H, bonus, out_rwkv, (u16*)(arena + ARENA_B), FILT, SUMSQ, CTR + l, smem);
      } else if (s == 2) {
        if (!cd) { for (int rep = 0; rep < REP_O; ++rep) phase_abmix(p, j, (const u16*)arena, (const float*)(arena + ARENA_B), H); }
        else for (int rep = 0; rep < REP_O; ++rep) phase_cdfinal(p, j, (const u16*)arena, H, bonus, (const u16*)(arena + ARENA_B),
                           (u16*)(arena + ARENA_B) + (size_t)512 * MTOK, smem);
      } else if (s == 3) {
        const u16* mixp = cd ? (const u16*)(arena + ARENA_B) + (size_t)512 * MTOK : H;
        if (!cd) for (int rep = 1; rep < REP_E2; ++rep) gemm_phase<2>(mixp, 1024, WOUT, 1024, 1024, nullptr, 0, 1, nullptr, (float*)arena, modl + 2048, smem);
        if (PHS(11)) gemm_phase<2>(mixp, 1024, WOUT, 1024, 1024, nullptr, 0, cd ? 1 : 0, nullptr, X, modl + 2048, smem);
        conv_mlp_weights(p, l, ws, smf, false);
      } else if (s == 4) {
        for (int rep = 1; rep < REP_LN; ++rep) phase_ln(X, p.ln1_g + l * 1024, p.ln1_b + l * 1024, modl, 3072, 4096, H, 1, 0, 0);
        if (PHS(12)) phase_ln(X, p.ln1_g + l * 1024, p.ln1_b + l * 1024, modl, 3072, 4096, H, 1, 0);
      } else if (s == 5) {
        for (int rep = 0; rep < REP_G; ++rep) gemm_phase<0>(H, 1024, W1T, 1024, 4096, (u16*)arena, 4096, 1, nullptr, nullptr, nullptr, smem);

      } else if (s == 6) {
        for (int rep = 0; rep < REP_M2; ++rep) gemm_phase<0>((const u16*)arena, 4096, W2T, 4096, 1024, H, 1024, 0, nullptr, nullptr, nullptr, smem);
        if (PHS(11)) gemm_phase<2>((const u16*)arena, 4096, W2T, 4096, 1024, nullptr, 0, 0, nullptr, X, modl + 5120, smem);
        if (l < 3) conv_mix_weights(p, l + 1, ws, smf, false);
      } else {
        const float* modn = mods + (size_t)(l + 1) * 9 * 6144;
        for (int rep = 1; rep < REP_LN; ++rep) phase_ln(X, p.ln2_g + l * 1024, p.ln2_b + l * 1024, l < 3 ? modn : modl, 0, 1024, H, 1, ((l + 1) & 1), 0);
        if (PHS(12)) phase_ln(X, p.ln2_g + l * 1024, p.ln2_b + l * 1024, l < 3 ? modn : modl, 0, 1024, H, l < 3 ? 1 : 0, ((l + 1) & 1));
      }
    }
    if (ph + 1 < ph_end) {
      if (ph_end < 0) grid.sync();
      xcd_barrier(xbar, xst);
    }
  }
  if (TSEL && blockIdx.x == 0 && otid() == 0) {
    unsigned long long* TS = (unsigned long long*)(p.ws + OFF_CTR + 1024);
    const unsigned long long tend = wall_clock64();
    TS[34] = tend;
    unsigned long long spin = 0;
    for (int ph = 0; ph < 34; ++ph) {
      const unsigned long long dd = TS[ph + 1] - TS[ph];
      const int sc = ph < 2 ? -1 : ((ph - 2) & 7);
      bool sel = false;
      if (TSEL == 1) sel = true;
      else if (TSEL == 2) sel = (sc == 0 || sc == 3 || sc == 5 || sc == 6);
      else if (TSEL == 3) sel = (sc == 1);
      else if (TSEL == 4) sel = (sc == 2 || sc == 4 || sc == 7);
      else if (TSEL == 5) sel = (sc == -1);
      else if (TSEL == 6) sel = (sc == 4 || sc == 7);
      else if (TSEL == 7) sel = (sc == 2);
      else if (TSEL == 8) sel = (sc == 1 && (((ph - 2) >> 3) & 1) == 0);
      else if (TSEL == 9) sel = (sc == 1 && (((ph - 2) >> 3) & 1) == 1);
      if (sel) spin += dd;
    }
    while (wall_clock64() - tend < spin) { __builtin_amdgcn_s_sleep(8); }
  }
}

extern "C" void kernel_launch(void* const* d_in, const int* in_sizes, int n_in, void* d_out, int out_size, void* d_ws,
                              size_t ws_size, hipStream_t stream) {
  static int grid_blocks = 0;
  if (!grid_blocks) {
    int dev = 0, cus = 0, per_cu = 0;
    hipGetDevice(&dev);
    hipDeviceGetAttribute(&cus, hipDeviceAttributeMultiprocessorCount, dev);
    hipFuncSetAttribute((const void*)fwd_megakernel, hipFuncAttributeMaxDynamicSharedMemorySize, SMEM_BYTES);
    hipOccupancyMaxActiveBlocksPerMultiprocessor(&per_cu, fwd_megakernel, NTHR, SMEM_BYTES);
    if (per_cu < 1) per_cu = 1;
    grid_blocks = cus * per_cu;
  }
  if (ws_size < WS_NEED) fprintf(stderr, "workspace too small: %zu < %llu\n", ws_size, (unsigned long long)WS_NEED);
  P p{};
  const float** pp = (const float**)&p;
  for (int i = 0; i < 46; ++i) pp[i] = (const float*)d_in[i];
  p.out = (float*)d_out;
  p.ws = (char*)d_ws;
  int ph0 = 0, ph1 = 34;
  void* args[] = {&p, &ph0, &ph1};
  hipMemsetAsync((char*)d_ws + OFF_BAR, 0, 16384, stream);
  hipError_t e = hipLaunchCooperativeKernel((void*)fwd_megakernel, dim3(grid_blocks), dim3(NTHR), args, SMEM_BYTES, stream);
  if (e != hipSuccess) fprintf(stderr, "cooperative launch failed: %s (grid %d)\n", hipGetErrorString(e), grid_blocks);
}
```

```cpp
#include <hip/hip_runtime.h>
#include <hip/hip_bf16.h>
#include <hip/hip_cooperative_groups.h>
#include <cstdio>
namespace cg = cooperative_groups;

typedef unsigned short u16;
typedef unsigned int u32;
using bf16x8 = __attribute__((ext_vector_type(8))) short;
using f32x4 = __attribute__((ext_vector_type(4))) float;

#define REP_G 1
#define TSEL 0
#define REP_E2 1
#define REP_FG 1
#define REP_LN 1
#define REP_HY 1
#define REP_SYNC 1
#define REP_O 1
#define REP_M2 0
#define REP_RW 1
#define REP_LRU 1
#define NTHR 512
#define MTOK 40960
#define MCTX 8192
#define ALPHA 1.6817928305074292f
#define SMEM_BYTES 131136

struct P {
  const float *x_prompt, *x_sample, *state_lru, *state_rwkv, *c, *c_ctx, *w_mod, *b_mod, *ln1_g, *ln1_b, *ln2_g, *ln2_b,
      *mlp_w1, *mlp_w2, *w_out, *ab_w_in, *sc_conv, *lru_conv, *lru_conv_b, *lru_wa, *lru_ba, *lru_wi, *lru_bi, *lru_lambda,
      *cd_w_in, *hy_conv, *hy_w1, *hy_b1, *hy_w2, *hy_b2, *hy_w3, *hy_freq, *hy_bias, *rw_mu, *rw_mu_x, *rw_w0, *rw_w1, *rw_w2,
      *rw_a0, *rw_a1, *rw_a2, *rw_kk, *rw_ka, *rw_rk, *rw_gn_g, *rw_gn_b;
  float* out;
  char* ws;
};

#define MiB (1024ull * 1024ull)
#define OFF_MODS (0ull)
#define OFF_BONUS (1ull * MiB)
#define OFF_HID2 (4ull * MiB)
#define OFF_SUMSQ (7ull * MiB)
#define OFF_CTR (7ull * MiB + 65536ull)
#define OFF_BAR (7ull * MiB + 131072ull)
#define OFF_WIN (8ull * MiB)
#define OFF_WOUT (16ull * MiB)
#define OFF_W1T (18ull * MiB)
#define OFF_W2T (26ull * MiB)
#define OFF_FILT (34ull * MiB)
#define OFF_H (52ull * MiB)
#define OFF_ARENA (132ull * MiB)
#define ARENA_B (200ull * MiB)
#define WS_NEED (492ull * MiB)

__device__ __forceinline__ int otid() {
  int t = threadIdx.x;
  asm volatile("" : "+v"(t));
  return t;
}
__device__ __forceinline__ u16 f2bf(float f) {
  u32 u = __float_as_uint(f);
  u += 0x7fffu + ((u >> 16) & 1u);
  return (u16)(u >> 16);
}
__device__ __forceinline__ float bf2f(u16 h) { return __uint_as_float(((u32)h) << 16); }
__device__ __forceinline__ float bflo(u32 u) { return __uint_as_float(u << 16); }
__device__ __forceinline__ float bfhi(u32 u) { return __uint_as_float(u & 0xffff0000u); }
__device__ __forceinline__ u32 pack2(float a, float b) { return (u32)f2bf(a) | ((u32)f2bf(b) << 16); }
__device__ __forceinline__ float sigmoidf_(float x) { return __builtin_amdgcn_rcpf(1.f + __expf(-x)); }
__device__ __forceinline__ float softplusf_(float x) { return fmaxf(x, 0.f) + __logf(1.f + __expf(-fabsf(x))); }
__device__ __forceinline__ float tanhf_(float x) { return 1.f - 2.f * __builtin_amdgcn_rcpf(1.f + __expf(2.f * x)); }
template <int CTRL>
__device__ __forceinline__ float dpp_mov(float v) {
  return __int_as_float(__builtin_amdgcn_update_dpp(0, __float_as_int(v), CTRL, 0xf, 0xf, true));
}
__device__ __forceinline__ float wsum(float v) {
  v += dpp_mov<0xB1>(v);
  v += dpp_mov<0x4E>(v);
  v += dpp_mov<0x141>(v);
  v += dpp_mov<0x140>(v);
  const int iv = __float_as_int(v);
  return (__int_as_float(__builtin_amdgcn_readlane(iv, 0)) + __int_as_float(__builtin_amdgcn_readlane(iv, 16))) +
         (__int_as_float(__builtin_amdgcn_readlane(iv, 32)) + __int_as_float(__builtin_amdgcn_readlane(iv, 48)));
}
__device__ __forceinline__ int mods_row(int m) { return m < MCTX ? 0 : 1 + ((m - MCTX) >> 12); }
__device__ __forceinline__ int perm_row(int m) {
  if (m < MCTX) return m;
  int t = m - MCTX;
  int b = t >> 12, s = t & 4095;
  return MCTX + (b << 12) + ((s & 63) << 6) + (s >> 6);
}

__device__ __forceinline__ void phase_mods(const P& p, float* mods, float* sm) {
  float* sc = sm;
  float* red = sm + 9 * 1024;
  const int tid = otid();
  for (int i = tid; i < 9 * 1024; i += NTHR) {
    int r = i >> 10, k = i & 1023;
    float v = (r == 0) ? p.c_ctx[k] : p.c[(r - 1) * 1024 + k];
    sc[i] = v / (1.f + __expf(-v));
  }
  __syncthreads();
  const int nl = tid & 63, ks = tid >> 6;
  for (int it = blockIdx.x; it < 4 * 96; it += gridDim.x) {
    int l = it / 96, ng = it % 96;
    int n = ng * 64 + nl;
    const float* w = p.w_mod + (size_t)l * 1024 * 6144 + n;
    float a0 = 0, a1 = 0, a2 = 0, a3 = 0, a4 = 0, a5 = 0, a6 = 0, a7 = 0, a8 = 0;
#pragma unroll 4
    for (int k = ks * 128; k < ks * 128 + 128; ++k) {
      float wv = w[(size_t)k * 6144];
      a0 += sc[k] * wv; a1 += sc[1024 + k] * wv; a2 += sc[2048 + k] * wv; a3 += sc[3072 + k] * wv;
      a4 += sc[4096 + k] * wv; a5 += sc[5120 + k] * wv; a6 += sc[6144 + k] * wv; a7 += sc[7168 + k] * wv;
      a8 += sc[8192 + k] * wv;
    }
    red[(ks * 9 + 0) * 64 + nl] = a0; red[(ks * 9 + 1) * 64 + nl] = a1; red[(ks * 9 + 2) * 64 + nl] = a2;
    red[(ks * 9 + 3) * 64 + nl] = a3; red[(ks * 9 + 4) * 64 + nl] = a4; red[(ks * 9 + 5) * 64 + nl] = a5;
    red[(ks * 9 + 6) * 64 + nl] = a6; red[(ks * 9 + 7) * 64 + nl] = a7; red[(ks * 9 + 8) * 64 + nl] = a8;
    __syncthreads();
    for (int o = tid; o < 9 * 64; o += NTHR) {
      int r = o >> 6, cc = o & 63;
      float s = 0;
#pragma unroll
      for (int q = 0; q < 8; ++q) s += red[(q * 9 + r) * 64 + cc];
      int nn = ng * 64 + cc;
      mods[(size_t)(l * 9 + r) * 6144 + nn] = s + p.b_mod[l * 6144 + nn];
    }
    __syncthreads();
  }
}

__device__ __forceinline__ void phase_hid2(const P& p, float* HID2, float* sm) {
  float* ft = sm;
  float* h1s = sm + 8 * 36;
  const int tid = otid();
  for (int it = blockIdx.x; it < 2 * 544; it += gridDim.x) {
    int j = it / 544, rg = it % 544;
    int row0 = rg * 8;
    if (tid < 8 * 33) {
      int r = tid / 33, f = tid % 33;
      int row = row0 + r;
      int L = row < 4096 ? 4096 : 256;
      int lag = row < 4096 ? row : row - 4096;
      float val;
      if (f == 0) val = (float)lag / (float)(L - 1);
      else {
        int bi = (f - 1) & 15;
        float band = 1e-4f + (float)bi * ((15.f - 1e-4f) / 15.f);
        float ang = (6.283185307179586f / (float)L) * (float)lag * band;
        val = (f <= 16) ? cosf(ang) : -sinf(ang);
      }
      ft[r * 36 + f] = val;
    }
    __syncthreads();
    int rl = tid >> 6, u = tid & 63;
    float fr = p.hy_freq[j * 64 + u];
    float h1 = p.hy_b1[j * 64 + u];
    for (int f = 0; f < 33; ++f) h1 += ft[rl * 36 + f] * p.hy_w1[(j * 33 + f) * 64 + u];
    h1 = sinf(fr * h1);
    h1s[rl * 64 + u] = h1;
    __syncthreads();
    float h2 = p.hy_b2[j * 64 + u];
    for (int v = 0; v < 64; ++v) h2 += h1s[rl * 64 + v] * p.hy_w2[(j * 64 + v) * 64 + u];
    h2 = sinf(fr * h2);
    HID2[((size_t)j * 4352 + row0 + rl) * 64 + u] = h2;
    __syncthreads();
  }
}

__device__ __forceinline__ void phase_filtgen(const P& p, int j, const float* HID2, u16* FILT, float* SUMSQ, float* sm) {
  float* hs = sm;
  const int tid = otid();
  for (int it = blockIdx.x; it < 272; it += gridDim.x) {
    int lc, lt, ct;
    if (it < 256) { lc = 0; lt = it >> 2; ct = it & 3; }
    else { lc = 1; lt = (it - 256) >> 2; ct = it & 3; }
    const int L = lc ? 256 : 4096;
    const int lag0 = lt * 64;
    const int rowbase = lc ? 4096 : 0;
    for (int e = tid; e < 4096; e += NTHR) hs[e] = HID2[((size_t)j * 4352 + rowbase + lag0) * 64 + e];
    __syncthreads();
    const int col = ct * 512 + tid;
    const int order = col >> 10, dir = (col >> 9) & 1, ch = col & 511;
    float w3c[64];
#pragma unroll
    for (int u = 0; u < 64; ++u) w3c[u] = p.hy_w3[((size_t)j * 64 + u) * 2048 + col];
    const float delta = 3.0701134573253947f + (float)ch * (12.280453829301577f / 511.f);
    u16* fdst = FILT + (lc ? (size_t)2 * 512 * 8192 : 0) + (size_t)(order * 512 + ch) * (2 * L);
    float ss = 0.f;
    for (int ll = 0; ll < 64; ++ll) {
      float raw = 0.f;
#pragma unroll
      for (int u = 0; u < 64; ++u) raw += hs[ll * 64 + u] * w3c[u];
      int lag = lag0 + ll;
      float tn = (float)lag / (float)(L - 1);
      float val = raw * __expf(-tn * delta);
      if (dir == 0) { ss += val * val; fdst[L - lag] = f2bf(val); }
      else if (lag > 0) { ss += val * val; fdst[L + lag] = f2bf(val); }
    }
    atomicAdd(&SUMSQ[((j * 2 + lc) * 2 + order) * 512 + ch], ss);
    __syncthreads();
  }
}

__device__ __forceinline__ void conv_wt(const float* __restrict__ src, int ld, int K, int N, u16* __restrict__ dst, int ldd,
                                        const float* __restrict__ scale, float* sm, bool g_conv_upper = false) {
  const int tid = otid();
  const int KT = K >> 6;
  const int nt_total = KT * (N >> 6);
  const int half = gridDim.x >> 1;
  const int t0 = g_conv_upper ? (int)blockIdx.x - half : (int)blockIdx.x;
  const int tstep = g_conv_upper ? half : (int)gridDim.x;
  if (t0 < 0) return;
  for (int t = t0; t < nt_total; t += tstep) {
    int kt = t % KT, nt = t / KT;
    for (int e = tid; e < 4096; e += NTHR) {
      int kk = e >> 6, nn = e & 63;
      float v = src[(size_t)(kt * 64 + kk) * ld + nt * 64 + nn];
      if (scale) v *= scale[kt * 64 + kk];
      sm[kk * 65 + nn] = v;
    }
    __syncthreads();
    for (int e = tid; e < 4096; e += NTHR) {
      int nn = e >> 6, kk = e & 63;
      dst[(size_t)(nt * 64 + nn) * ldd + kt * 64 + kk] = f2bf(sm[kk * 65 + nn]);
    }
    __syncthreads();
  }
}

__device__ __forceinline__ void conv_mix_weights(const P& p, int l, char* ws, float* sm, bool up = false) {
  u16* WIN = (u16*)(ws + OFF_WIN);
  u16* WOUT = (u16*)(ws + OFF_WOUT);
  const int j = l >> 1;
  if ((l & 1) == 0) {
    conv_wt(p.ab_w_in + (size_t)j * 1024 * 2560, 2560, 1024, 2560, WIN, 1024, nullptr, sm, up);
  } else {
    conv_wt(p.cd_w_in + (size_t)j * 1024 * 3584, 3584, 1024, 3584, WIN, 1024, nullptr, sm, up);
    for (int d = 0; d < 2; ++d) {
      const float* w1 = p.rw_w1 + (size_t)(j * 2 + d) * 1024 * 64;
      const float* a1 = p.rw_a1 + (size_t)(j * 2 + d) * 1024 * 64;
      u16* base = WIN + (size_t)(3584 + d * 256) * 1024;
      conv_wt(w1, 64, 1024, 64, base, 1024, nullptr, sm, up);
      conv_wt(w1, 64, 1024, 64, base + 64 * 1024, 1024, p.rw_mu_x + (size_t)(j * 2 + 0) * 1024, sm, up);
      conv_wt(a1, 64, 1024, 64, base + 128 * 1024, 1024, nullptr, sm, up);
      conv_wt(a1, 64, 1024, 64, base + 192 * 1024, 1024, p.rw_mu_x + (size_t)(j * 2 + 1) * 1024, sm, up);
    }
  }
  conv_wt(p.w_out + (size_t)l * 1024 * 1024, 1024, 1024, 1024, WOUT, 1024, nullptr, sm, up);
}
__device__ __forceinline__ void conv_mlp_weights(const P& p, int l, char* ws, float* sm, bool up = false) {
  conv_wt(p.mlp_w1 + (size_t)l * 1024 * 4096, 4096, 1024, 4096, (u16*)(ws + OFF_W1T), 1024, nullptr, sm, up);
  conv_wt(p.mlp_w2 + (size_t)l * 4096 * 1024, 1024, 4096, 1024, (u16*)(ws + OFF_W2T), 4096, nullptr, sm, up);
}

#define LSTR 64
#define GSTAGE (512 * LSTR)
template <int EPI, int MI>
__device__ __forceinline__ void gemm_part(const u16* __restrict__ A, int lda, const u16* __restrict__ Bt, int K, int N,
                                          u16* __restrict__ C, int ldc, int flag, u16* __restrict__ UT, float* __restrict__ X,
                                          const float* __restrict__ gate, char* smem, int n_items, int tbase) {
  constexpr bool SWAP = (EPI != 1);
  u16* Ls = (u16*)smem;
  const int tid = otid(), wid = tid >> 6, lane = tid & 63, wr = wid >> 1, wc = wid & 1, fr = lane & 15, fq = lane >> 4;
  const int NT = N >> 8, ntiles = n_items, nk = K >> 6;
  const int crow = tid >> 3, ccol = (tid & 7) * 8;
  const int wsw = ((tid & 7) ^ ((crow >> 1) & 7)) * 8;
  const int rsw0 = ((fq) ^ ((fr >> 1) & 7)) * 8, rsw1 = ((4 + fq) ^ ((fr >> 1) & 7)) * 8;
  uint4 ra0, ra1, ra2, ra3, rb0, rb1, rb2, rb3;
  const size_t a64 = (size_t)64 * lda, b64 = (size_t)64 * K;
  const u16* Ap = A;
  const u16* Bp = Bt;
#define GLOAD_A(KS)                                                                          \
  {                                                                                          \
    const int ko_ = min((KS), nk - 1) << 6;                                                  \
    ra0 = *(const uint4*)(Ap + ko_); ra1 = *(const uint4*)(Ap + a64 + ko_);                  \
    if (MI == 4) { ra2 = *(const uint4*)(Ap + 2 * a64 + ko_); ra3 = *(const uint4*)(Ap + 3 * a64 + ko_); } \
  }
#define GLOAD_B(KS)                                                                          \
  {                                                                                          \
    const int ko_ = min((KS), nk - 1) << 6;                                                  \
    rb0 = *(const uint4*)(Bp + ko_); rb1 = *(const uint4*)(Bp + b64 + ko_);                  \
    rb2 = *(const uint4*)(Bp + 2 * b64 + ko_); rb3 = *(const uint4*)(Bp + 3 * b64 + ko_);    \
  }
#define LWRITE_A(STG)                                                                                       \
  {                                                                                                         \
    *(uint4*)(wA + (STG) * GSTAGE) = ra0; *(uint4*)(wA + (STG) * GSTAGE + 64 * LSTR) = ra1;                 \
    if (MI == 4) { *(uint4*)(wA + (STG) * GSTAGE + 128 * LSTR) = ra2; *(uint4*)(wA + (STG) * GSTAGE + 192 * LSTR) = ra3; } \
  }
#define LWRITE_B(STG)                                                                                       \
  {                                                                                                         \
    *(uint4*)(wB + (STG) * GSTAGE) = rb0; *(uint4*)(wB + (STG) * GSTAGE + 64 * LSTR) = rb1;                 \
    *(uint4*)(wB + (STG) * GSTAGE + 128 * LSTR) = rb2; *(uint4*)(wB + (STG) * GSTAGE + 192 * LSTR) = rb3;   \
  }
#define GLOAD(KS) GLOAD_A(KS) GLOAD_B(KS)
#define LWRITE(STG) LWRITE_A(STG) LWRITE_B(STG)
#define TILE_REMAP(T) (((T) < nfull) ? (((T) & ~255) + (((T) & 7) << 5) + (((T) & 255) >> 3)) : (T))
#define ITEM_TILE(T) ((MI == 4) ? TILE_REMAP((EPI == 2 && K == 4096) ? (n_items - 1 - (T)) : (T)) : (tbase + ((T) >> 1)))
#define ITEM_MOFF(T) ((MI == 4) ? 0 : (((T) & 1) << 7))
#define GTILE_PTRS(T)                                                   \
  {                                                                     \
    const int tr_ = ITEM_TILE(T);                                       \
    const int mt_ = tr_ / NT, nt_ = tr_ - mt_ * NT;                     \
    Ap = A + (size_t)((mt_ << 8) + ITEM_MOFF(T) + crow) * lda + ccol;   \
    Bp = Bt + (size_t)((nt_ << 8) + crow) * K + ccol;                   \
  }
  u16* wA = Ls + crow * LSTR + wsw;
  u16* wB = Ls + (256 + crow) * LSTR + wsw;
  const u16* rA = Ls + (wr * 16 * MI + fr) * LSTR;
  const u16* rB = Ls + (256 + wc * 128 + fr) * LSTR;
  const int nfull = (MI == 4 && gridDim.x == 256) ? (ntiles & ~255) : 0;
  int tile = blockIdx.x;
  if (tile < ntiles) {
    GTILE_PTRS(tile)
    GLOAD(0)
  }
  while (tile < ntiles) {
    const int trm = ITEM_TILE(tile);
    const int mt = trm / NT, nt = trm - mt * NT;
    const int m0 = (mt << 8) + ITEM_MOFF(tile), n0 = nt << 8;
    f32x4 acc[MI][8];
#pragma unroll
    for (int i = 0; i < MI; ++i)
#pragma unroll
      for (int k = 0; k < 8; ++k) acc[i][k] = f32x4{0.f, 0.f, 0.f, 0.f};
    LWRITE(0)
    __builtin_amdgcn_sched_barrier(0);
    GLOAD(1)
    __builtin_amdgcn_sched_barrier(0);
    asm volatile("s_waitcnt lgkmcnt(0)\n\ts_barrier" ::: "memory");
#define GEMM_MMA_H(STG, AF, RS, H)                                                                                  \
  {                                                                                                                 \
    bf16x8 b[2];                                                                                                    \
    _Pragma("unroll") for (int i = 0; i < 2; ++i) b[i] = *(const bf16x8*)(rB + (STG) * GSTAGE + ((H) * 2 + i) * 16 * LSTR + (RS)); \
    _Pragma("unroll") for (int mi = 0; mi < MI; ++mi) _Pragma("unroll") for (int ni = 0; ni < 2; ++ni) {            \
      if (SWAP) acc[mi][(H) * 2 + ni] = __builtin_amdgcn_mfma_f32_16x16x32_bf16(b[ni], AF[mi], acc[mi][(H) * 2 + ni], 0, 0, 0); \
      else acc[mi][(H) * 2 + ni] = __builtin_amdgcn_mfma_f32_16x16x32_bf16(AF[mi], b[ni], acc[mi][(H) * 2 + ni], 0, 0, 0);      \
    }                                                                                                               \
  }
#define GEMM_LOAD_A0(STG) \
  _Pragma("unroll") for (int i = 0; i < MI / 2; ++i) a0[i] = *(const bf16x8*)(rA + (STG) * GSTAGE + i * 16 * LSTR + rsw0);
#define GEMM_LOAD_A0B(STG) \
  _Pragma("unroll") for (int i = MI / 2; i < MI; ++i) a0[i] = *(const bf16x8*)(rA + (STG) * GSTAGE + i * 16 * LSTR + rsw0);
#define GSTEP(STG, KS)                                                      \
  {                                                                         \
      \
    GEMM_LOAD_A0B(STG)                                                      \
    __builtin_amdgcn_sched_barrier(0);                                      \
    LWRITE_A((STG) ^ 1)                                                     \
    __builtin_amdgcn_sched_barrier(0);                                      \
    GLOAD_A((KS) + 2)                                                       \
    __builtin_amdgcn_sched_barrier(0);                                      \
    GEMM_MMA_H(STG, a0, rsw0, 0)                                            \
    GEMM_MMA_H(STG, a0, rsw0, 1)                                            \
    GEMM_MMA_H(STG, a0, rsw0, 2)                                            \
    GEMM_MMA_H(STG, a0, rsw0, 3)                                            \
    LWRITE_B((STG) ^ 1)                                                     \
    __builtin_amdgcn_sched_barrier(0);                                      \
    GLOAD_B((KS) + 2)                                                       \
    __builtin_amdgcn_sched_barrier(0);                                      \
    _Pragma("unroll") for (int i = 0; i < MI; ++i) a1[i] = *(const bf16x8*)(rA + (STG) * GSTAGE + i * 16 * LSTR + rsw1); \
    GEMM_MMA_H(STG, a1, rsw1, 0)                                            \
    GEMM_MMA_H(STG, a1, rsw1, 1)                                            \
    GEMM_MMA_H(STG, a1, rsw1, 2)                                            \
    _Pragma("unroll") for (int i = 0; i < 2; ++i) b3[i] = *(const bf16x8*)(rB + (STG) * GSTAGE + (6 + i) * 16 * LSTR + rsw1); \
    __builtin_amdgcn_sched_barrier(0);                                      \
    asm volatile("s_waitcnt lgkmcnt(0)\n\ts_barrier" ::: "memory");         \
    GEMM_LOAD_A0((STG) ^ 1)                                                 \
    __builtin_amdgcn_sched_barrier(0);                                      \
    GEMM_MMA_HP(STG, a1, b3, 3)                                             \
  }
#define GEMM_MMA_HP(STG, AF, BF, H)                                                                                 \
  {                                                                                                                 \
    _Pragma("unroll") for (int mi = 0; mi < MI; ++mi) _Pragma("unroll") for (int ni = 0; ni < 2; ++ni) {            \
      if (SWAP) acc[mi][(H) * 2 + ni] = __builtin_amdgcn_mfma_f32_16x16x32_bf16(BF[ni], AF[mi], acc[mi][(H) * 2 + ni], 0, 0, 0); \
      else acc[mi][(H) * 2 + ni] = __builtin_amdgcn_mfma_f32_16x16x32_bf16(AF[mi], BF[ni], acc[mi][(H) * 2 + ni], 0, 0, 0);      \
    }                                                                                                               \
  }
    bf16x8 a0[MI], a1[MI], b3[2];
    GEMM_LOAD_A0(0)
    for (int kt = 0; kt < nk; kt += 2) {
      GSTEP(0, kt)
      GSTEP(1, kt + 1)
    }
#undef GSTEP
#undef GEMM_MMA_H
#undef GEMM_MMA_HP
#undef GEMM_LOAD_A0
#undef GEMM_LOAD_A0B
    const int tile_next = tile + gridDim.x;
    if (tile_next < ntiles) {
      GTILE_PTRS(tile_next)
      GLOAD(0)
    }
    __builtin_amdgcn_sched_barrier(0);
#pragma unroll
    for (int mi = 0; mi < MI; ++mi) {
#pragma unroll
      for (int ni = 0; ni < 8; ++ni) {
        if (EPI == 0) {
          const int m = m0 + wr * 16 * MI + mi * 16 + fr;
          const int n4 = n0 + wc * 128 + ni * 16 + fq * 4;
          float v0 = acc[mi][ni][0], v1 = acc[mi][ni][1], v2 = acc[mi][ni][2], v3 = acc[mi][ni][3];
          if (flag) {
            v0 = fmaxf(v0, 0.f); v0 *= v0; v1 = fmaxf(v1, 0.f); v1 *= v1;
            v2 = fmaxf(v2, 0.f); v2 *= v2; v3 = fmaxf(v3, 0.f); v3 *= v3;
          }
          uint2 pk;
          pk.x = pack2(v0, v1);
          pk.y = pack2(v2, v3);
          *(uint2*)(C + (size_t)m * ldc + n4) = pk;
        } else if (EPI == 1) {
          const int mb = m0 + wr * 16 * MI + mi * 16 + fq * 4;
          const int n = n0 + wc * 128 + ni * 16 + fr;
          if (n0 < 1536) {
            uint2 pk;
            pk.x = pack2(acc[mi][ni][0], acc[mi][ni][1]);
            pk.y = pack2(acc[mi][ni][2], acc[mi][ni][3]);
            *(uint2*)(UT + (size_t)n * MTOK + mb) = pk;
          } else {
#pragma unroll
            for (int r = 0; r < 4; ++r) C[(size_t)(mb + r) * 2560 + (n - 1536)] = f2bf(acc[mi][ni][r]);
          }
        } else {
          const int m = m0 + wr * 16 * MI + mi * 16 + fr;
          const int n4 = n0 + wc * 128 + ni * 16 + fq * 4;
          const int rm = flag ? perm_row(m) : m;
          float4* xp = (float4*)(X + (size_t)rm * 1024 + n4);
          const float4 g4 = *(const float4*)(gate + (size_t)mods_row(m) * 6144 + n4);
          float4 xv = *xp;
          xv.x = ALPHA * xv.x + g4.x * acc[mi][ni][0];
          xv.y = ALPHA * xv.y + g4.y * acc[mi][ni][1];
          xv.z = ALPHA * xv.z + g4.z * acc[mi][ni][2];
          xv.w = ALPHA * xv.w + g4.w * acc[mi][ni][3];
          *xp = xv;
        }
      }
    }
    tile = tile_next;
  }
#undef GLOAD
#undef LWRITE
#undef GLOAD_A
#undef GLOAD_B
#undef LWRITE_A
#undef LWRITE_B
#undef GTILE_PTRS
#undef ITEM_TILE
#undef ITEM_MOFF
#undef TILE_REMAP
}

template <int EPI>
__device__ __forceinline__ void gemm_phase(const u16* __restrict__ A, int lda, const u16* __restrict__ Bt, int K, int N,
                                           u16* __restrict__ C, int ldc, int flag, u16* __restrict__ UT, float* __restrict__ X,
                                           const float* __restrict__ gate, char* smem) {
  const int ntiles = 160 * (N >> 8);
  const int rem = (gridDim.x == 256) ? (ntiles & 255) : 0;
  if (rem > 0 && rem <= 128) {
    gemm_part<EPI, 4>(A, lda, Bt, K, N, C, ldc, flag, UT, X, gate, smem, ntiles - rem, 0);
    gemm_part<EPI, 2>(A, lda, Bt, K, N, C, ldc, flag, UT, X, gate, smem, 2 * rem, ntiles - rem);
  } else {
    gemm_part<EPI, 4>(A, lda, Bt, K, N, C, ldc, flag, UT, X, gate, smem, ntiles, 0);
  }
}

__device__ __forceinline__ void phase_xinit(const P& p, float* X, const float* mods0, u16* H) {
  const int lane = otid() & 63;
  const int gw = blockIdx.x * 8 + (otid() >> 6);
  for (int m = gw; m < MTOK; m += gridDim.x * 8) {
    const float* src = m < MCTX ? p.x_prompt + (size_t)m * 1024 : p.x_sample + (size_t)(m - MCTX) * 1024;
    const float* md = mods0 + (size_t)mods_row(m) * 6144;
#pragma unroll
    for (int i = 0; i < 4; ++i) {
      int col = lane * 4 + i * 256;
      float4 v = *(const float4*)(src + col);
      *(float4*)(X + (size_t)m * 1024 + col) = v;
      float4 sh = *(const float4*)(md + col);
      float4 sc = *(const float4*)(md + 1024 + col);
      uint2 pk;
      pk.x = pack2(v.x * (1.f + sc.x) + sh.x, v.y * (1.f + sc.y) + sh.y);
      pk.y = pack2(v.z * (1.f + sc.z) + sh.z, v.w * (1.f + sc.w) + sh.w);
      *(uint2*)(H + (size_t)m * 1024 + col) = pk;
    }
  }
}

__device__ __forceinline__ void phase_ln(float* X, const float* g, const float* b, const float* modl, int sh_off, int sc_off,
                                         u16* H, int write_h, int permflag, int write_x = 1) {
  const int lane = otid() & 63;
  const int gw = blockIdx.x * 8 + (otid() >> 6);
  const int stride = gridDim.x * 8;
  for (int mb = gw; mb < MTOK; mb += 2 * stride) {
    float4 v[2][4];
#pragma unroll
    for (int r = 0; r < 2; ++r) {
      const int m = min(mb + r * stride, MTOK - 1);
#pragma unroll
      for (int i = 0; i < 4; ++i) v[r][i] = *(const float4*)(X + (size_t)m * 1024 + lane * 4 + i * 256);
    }
#pragma unroll
    for (int r = 0; r < 2; ++r) {
      const int m = mb + r * stride;
      if (m >= MTOK) break;
      float s = 0.f;
#pragma unroll
      for (int i = 0; i < 4; ++i) s += v[r][i].x + v[r][i].y + v[r][i].z + v[r][i].w;
      const float mean = wsum(s) * (1.f / 1024.f);
      float q = 0.f;
#pragma unroll
      for (int i = 0; i < 4; ++i) {
        v[r][i].x -= mean; v[r][i].y -= mean; v[r][i].z -= mean; v[r][i].w -= mean;
        q += v[r][i].x * v[r][i].x + v[r][i].y * v[r][i].y + v[r][i].z * v[r][i].z + v[r][i].w * v[r][i].w;
      }
      const float rstd = rsqrtf(wsum(q) * (1.f / 1024.f) + 1e-5f);
      const float* md = modl + (size_t)mods_row(m) * 6144;
      const int dst = permflag ? perm_row(m) : m;
#pragma unroll
      for (int i = 0; i < 4; ++i) {
        int col = lane * 4 + i * 256;
        float4 gg = *(const float4*)(g + col);
        float4 bb = *(const float4*)(b + col);
        float4 o;
        o.x = v[r][i].x * rstd * gg.x + bb.x; o.y = v[r][i].y * rstd * gg.y + bb.y;
        o.z = v[r][i].z * rstd * gg.z + bb.z; o.w = v[r][i].w * rstd * gg.w + bb.w;
        if (write_x) *(float4*)(X + (size_t)m * 1024 + col) = o;
        if (write_h) {
          float4 sh = *(const float4*)(md + sh_off + col);
          float4 sc = *(const float4*)(md + sc_off + col);
          uint2 pk;
          pk.x = pack2(o.x * (1.f + sc.x) + sh.x, o.y * (1.f + sc.y) + sh.y);
          pk.y = pack2(o.z * (1.f + sc.z) + sh.z, o.w * (1.f + sc.w) + sh.w);
          *(uint2*)(H + (size_t)dst * 1024 + col) = pk;
        }
      }
    }
  }
}

__device__ __forceinline__ void phase_lru_gates(const P& p, int j, const u16* __restrict__ proj, u32* __restrict__ PK, char* smem) {
  float* XCf = (float*)smem;
  float* cw = XCf + 4096;
  float* cb = cw + 256;
  float* bba = cb + 64;
  float* bbi = bba + 128;
  float* spl = bbi + 128;
  u16* XR = (u16*)(spl + 128);
  u16* XCb = XR + 68 * 64;
  u16* WT = XCb + 64 * 72;
  const int tid = otid();
  const int wave = tid >> 6, lane = tid & 63, fr = lane & 15, fq = lane >> 4;
  const int ptok = tid >> 3, c8 = (tid & 7) * 8;
  const int hd = blockIdx.x & 7;
  const int cstep = gridDim.x >> 3;
  for (int e = tid; e < 4 * 4096; e += NTHR) {
    const int mat = e >> 12, i = (e >> 6) & 63, jj = e & 63;
    const int d = mat >> 1;
    const float* src = (mat & 1) ? p.lru_wi : p.lru_wa;
    WT[(mat * 64 + jj) * 72 + i] = f2bf(src[((size_t)((j * 2 + d) * 8 + hd)) * 4096 + i * 64 + jj]);
  }
  if (tid < 256) cw[tid] = p.lru_conv[(j * 4 + (tid >> 6)) * 512 + hd * 64 + (tid & 63)];
  if (tid < 64) cb[tid] = p.lru_conv_b[j * 512 + hd * 64 + tid];
  if (tid < 128) {
    const int d = tid >> 6, ch = tid & 63;
    bba[tid] = p.lru_ba[(j * 2 + d) * 512 + hd * 64 + ch];
    bbi[tid] = p.lru_bi[(j * 2 + d) * 512 + hd * 64 + ch];
    spl[tid] = softplusf_(-p.lru_lambda[(j * 2 + d) * 512 + hd * 64 + ch]);
  }
  uint4 pmain, phalo;
#define LRUA_PREFETCH(CK)                                                                                   \
  {                                                                                                         \
    const int m0_ = (CK) * 64;                                                                              \
    const u16* base_ = proj + (size_t)m0_ * 2560 + 2048 + hd * 64 + c8;                                      \
    pmain = *(const uint4*)(base_ + (size_t)ptok * 2560);                                                    \
    phalo = make_uint4(0, 0, 0, 0);                                                                          \
    if (tid < 24 && m0_ < MCTX) {                                                                            \
      const int hr_ = tid >> 3;                                                                              \
      const int so_ = hr_ == 0 ? -2 : (hr_ == 1 ? -1 : 64);                                                  \
      const int sg_ = (m0_ & 255) + so_;                                                                     \
      if (sg_ >= 0 && sg_ < 256) phalo = *(const uint4*)(base_ + (long)so_ * 2560);                          \
    }                                                                                                        \
  }
  int ck = blockIdx.x >> 3;
  if (ck < 640) LRUA_PREFETCH(ck)
  __syncthreads();
  for (; ck < 640; ck += cstep) {
    const int m0 = ck * 64;
    *(uint4*)(XR + (ptok + 2) * 64 + c8) = pmain;
    if (tid < 24) {
      const int hr = tid >> 3;
      *(uint4*)(XR + (hr == 2 ? 66 : hr) * 64 + c8) = phalo;
    }
    if (ck + cstep < 640) LRUA_PREFETCH(ck + cstep)
    __syncthreads();
    {
      float xc[8];
#pragma unroll
      for (int q = 0; q < 8; ++q) xc[q] = cb[c8 + q];
#pragma unroll
      for (int k = 0; k < 4; ++k) {
        const uint4 rv = *(const uint4*)(XR + (ptok + k) * 64 + c8);
        const u32 w[4] = {rv.x, rv.y, rv.z, rv.w};
#pragma unroll
        for (int q = 0; q < 8; ++q) {
          const float xv = (q & 1) ? bfhi(w[q >> 1]) : bflo(w[q >> 1]);
          xc[q] += xv * cw[k * 64 + c8 + q];
        }
      }
      *(float4*)(XCf + ptok * 64 + c8) = make_float4(xc[0], xc[1], xc[2], xc[3]);
      *(float4*)(XCf + ptok * 64 + c8 + 4) = make_float4(xc[4], xc[5], xc[6], xc[7]);
      uint4 pk;
      pk.x = pack2(xc[0], xc[1]); pk.y = pack2(xc[2], xc[3]); pk.z = pack2(xc[4], xc[5]); pk.w = pack2(xc[6], xc[7]);
      *(uint4*)(XCb + ptok * 72 + c8) = pk;
    }
    __syncthreads();
    {
      const int tb = wave & 3, d = wave >> 2;
      const int tok = 16 * tb + fr;
      const u16* WA = WT + (size_t)(d * 2 + 0) * 64 * 72;
      const u16* WI = WT + (size_t)(d * 2 + 1) * 64 * 72;
      const bf16x8 xb0 = *(const bf16x8*)(XCb + (16 * tb + fr) * 72 + fq * 8);
      const bf16x8 xb1 = *(const bf16x8*)(XCb + (16 * tb + fr) * 72 + 32 + fq * 8);
#pragma unroll
      for (int cblk = 0; cblk < 4; ++cblk) {
        f32x4 accr = {0.f, 0.f, 0.f, 0.f}, acci = {0.f, 0.f, 0.f, 0.f};
        accr = __builtin_amdgcn_mfma_f32_16x16x32_bf16(*(const bf16x8*)(WA + (16 * cblk + fr) * 72 + fq * 8), xb0, accr, 0, 0, 0);
        accr = __builtin_amdgcn_mfma_f32_16x16x32_bf16(*(const bf16x8*)(WA + (16 * cblk + fr) * 72 + 32 + fq * 8), xb1, accr, 0, 0, 0);
        acci = __builtin_amdgcn_mfma_f32_16x16x32_bf16(*(const bf16x8*)(WI + (16 * cblk + fr) * 72 + fq * 8), xb0, acci, 0, 0, 0);
        acci = __builtin_amdgcn_mfma_f32_16x16x32_bf16(*(const bf16x8*)(WI + (16 * cblk + fr) * 72 + 32 + fq * 8), xb1, acci, 0, 0, 0);
        const int ch4 = 16 * cblk + 4 * fq;
        const float4 x4 = *(const float4*)(XCf + tok * 64 + ch4);
        const float xv[4] = {x4.x, x4.y, x4.z, x4.w};
        u32 pk[4];
#pragma unroll
        for (int r = 0; r < 4; ++r) {
          const int ch = ch4 + r;
          const float rg = sigmoidf_(accr[r] + bba[d * 64 + ch]);
          const float ig = sigmoidf_(acci[r] + bbi[d * 64 + ch]);
          const float la = -8.f * rg * spl[d * 64 + ch];
          const float u = __builtin_amdgcn_sqrtf(fmaxf(1.f - __expf(2.f * la), 0.f)) * ig * xv[r];
          pk[r] = (u32)f2bf(la) | ((u32)f2bf(u) << 16);
        }
        *(uint4*)(PK + ((size_t)(m0 + tok) * 2 + d) * 512 + hd * 64 + ch4) = make_uint4(pk[0], pk[1], pk[2], pk[3]);
      }
    }
  }
#undef LRUA_PREFETCH
  __syncthreads();
}

__device__ __forceinline__ void phase_lru_scan(const P& p, int j, u32* PK, float* out_lru, int* ctr, char* smem) {
  float* SEGA = (float*)smem;
  float* SEGU = SEGA + 512;
  float* HC = SEGU + 512;
  int* sitem = (int*)(HC + 64);
  const int tid = otid();
  const int ch = tid & 63, seg = tid >> 6;
  for (;;) {
    if (tid == 0) *sitem = atomicAdd(ctr, 1);
    __syncthreads();
    const int it = *sitem;
    __syncthreads();
    if (it >= 640) break;
    const int lat = it < 128;
    const int it2 = lat ? it : it - 128;
    const int b = it2 >> 4, hd = (it2 >> 1) & 7, d = it2 & 1;
    const int mbase = lat ? MCTX + b * 4096 : b * 256;
    const int Lseq = lat ? 4096 : 256;
    const int seglen = lat ? 64 : 32;
    const int nsc = Lseq / (8 * seglen);
    if (tid < 64) HC[tid] = lat ? p.state_lru[((size_t)(b * 2 + j) * 2 + d) * 512 + hd * 64 + tid] : 0.f;
    __syncthreads();
    float hlast = 0.f;
    for (int sc = 0; sc < nsc; ++sc) {
      const int p0 = (sc * 8 + seg) * seglen;
      u32 vals[64];
#pragma unroll
      for (int i = 0; i < 64; ++i) {
        const int pp = p0 + min(i, seglen - 1);
        const int sidx = d ? (Lseq - 1 - pp) : pp;
        vals[i] = PK[((size_t)(mbase + sidx) * 2 + d) * 512 + hd * 64 + ch];
      }
      float A = 1.f, U = 0.f;
#pragma unroll
      for (int i = 0; i < 64; ++i) {
        if (i < seglen) {
          const float a = __expf(bflo(vals[i]));
          U = a * U + bfhi(vals[i]);
          A *= a;
        }
      }
      SEGA[seg * 64 + ch] = A;
      SEGU[seg * 64 + ch] = U;
      __syncthreads();
      float h = HC[ch];
      for (int s2 = 0; s2 < seg; ++s2) h = SEGA[s2 * 64 + ch] * h + SEGU[s2 * 64 + ch];
#pragma unroll
      for (int i = 0; i < 64; ++i) {
        if (i < seglen) {
          const int pp = p0 + i;
          const int sidx = d ? (Lseq - 1 - pp) : pp;
          h = __expf(bflo(vals[i])) * h + bfhi(vals[i]);
          ((float*)PK)[((size_t)(mbase + sidx) * 2 + d) * 512 + hd * 64 + ch] = h;
        }
      }
      hlast = h;
      __syncthreads();
      if (seg == 7) HC[ch] = hlast;
      __syncthreads();
    }
    if (!lat && tid < 64) out_lru[((size_t)(b * 2 + j) * 2 + d) * 512 + hd * 64 + tid] = HC[tid];
    __syncthreads();
  }
}

__device__ __forceinline__ void phase_abmix(const P& p, int j, const u16* __restrict__ proj, const float* __restrict__ hfb,
                                            u16* __restrict__ mix) {
  const int c8h = ((blockIdx.x * NTHR + otid()) & 63) * 8;
  float cw0[8], cw1[8], cw2[8];
#pragma unroll
  for (int q = 0; q < 8; ++q) {
    cw0[q] = p.sc_conv[(j * 3 + 0) * 512 + c8h + q];
    cw1[q] = p.sc_conv[(j * 3 + 1) * 512 + c8h + q];
    cw2[q] = p.sc_conv[(j * 3 + 2) * 512 + c8h + q];
  }
  for (int e = blockIdx.x * NTHR + otid(); e < MTOK * 64; e += gridDim.x * NTHR) {
    const int m = e >> 6, c8 = c8h;
    const int line = m < MCTX ? 256 : 64;
    const int pos = m & (line - 1);
    const bool mL = pos > 0, mR = pos < line - 1;
    const u16* pr = proj + (size_t)m * 2560;
    uint4 sb = *(const uint4*)(pr + c8);
    uint4 sc0 = *(const uint4*)(pr + 512 + c8), sv0 = *(const uint4*)(pr + 1024 + c8);
    uint4 gg = *(const uint4*)(pr + 1536 + c8);
    uint4 z = make_uint4(0, 0, 0, 0);
    uint4 scl = mL ? *(const uint4*)(pr - 2560 + 512 + c8) : z, svl = mL ? *(const uint4*)(pr - 2560 + 1024 + c8) : z;
    uint4 scr = mR ? *(const uint4*)(pr + 2560 + 512 + c8) : z, svr = mR ? *(const uint4*)(pr + 2560 + 1024 + c8) : z;
    const u32* sbp = (const u32*)&sb; const u32* scp = (const u32*)&sc0; const u32* svp = (const u32*)&sv0;
    const u32* ggp = (const u32*)&gg; const u32* sclp = (const u32*)&scl; const u32* svlp = (const u32*)&svl;
    const u32* scrp = (const u32*)&scr; const u32* svrp = (const u32*)&svr;
    const float* hf = hfb + (size_t)m * 1024 + c8;
    float ya[8], yb[8];
#pragma unroll
    for (int q = 0; q < 8; ++q) {
      const int ch = c8 + q;
      const int w = q >> 1;
      const bool hi = q & 1;
      float s_b = hi ? bfhi(sbp[w]) : bflo(sbp[w]);
      float c1 = (hi ? bfhi(scp[w]) : bflo(scp[w])) * (hi ? bfhi(svp[w]) : bflo(svp[w]));
      float c0 = (hi ? bfhi(sclp[w]) : bflo(sclp[w])) * (hi ? bfhi(svlp[w]) : bflo(svlp[w]));
      float c2 = (hi ? bfhi(scrp[w]) : bflo(scrp[w])) * (hi ? bfhi(svrp[w]) : bflo(svrp[w]));
      ya[q] = s_b * (c0 * cw0[q] + c1 * cw1[q] + c2 * cw2[q]);
      float g = hi ? bfhi(ggp[w]) : bflo(ggp[w]);
      float ge = 0.5f * g * (1.f + tanhf_(0.7978845608028654f * (g + 0.044715f * g * g * g)));
      yb[q] = ge * (hf[q] + hf[512 + q]);
    }
    uint4 oa, ob;
    oa.x = pack2(ya[0], ya[1]); oa.y = pack2(ya[2], ya[3]); oa.z = pack2(ya[4], ya[5]); oa.w = pack2(ya[6], ya[7]);
    ob.x = pack2(yb[0], yb[1]); ob.y = pack2(yb[2], yb[3]); ob.z = pack2(yb[4], yb[5]); ob.w = pack2(yb[6], yb[7]);
    *(uint4*)(mix + (size_t)m * 1024 + c8) = oa;
    *(uint4*)(mix + (size_t)m * 1024 + 512 + c8) = ob;
  }
}

__device__ __forceinline__ float sum8(float v) {
  v += dpp_mov<0xB1>(v);
  v += dpp_mov<0x4E>(v);
  v += dpp_mov<0x141>(v);
  return v;
}
#define RSTR 72
__device__ __forceinline__ void rwkv_item(const P& p, int j, int it, const u16* __restrict__ prw, u16* __restrict__ obuf,
                                          float* __restrict__ bonus, float* out_rwkv, char* smem) {
  float* BUF = (float*)smem;
  float* OBB = BUF + 12288;
  float* SSB = OBB + 2048;
  float* mur = SSB + 32;
  float* muk = mur + 64;
  float* muv = muk + 64;
  float* kkp = muv + 64;
  float* kap = kkp + 64;
  float* rkp = kap + 64;
  float* w0p = rkp + 64;
  float* a0p = w0p + 64;
  u16* TWb = (u16*)(a0p + 64);
  u16* LAb = TWb + 16 * RSTR;
  u16* W2T = LAb + 16 * RSTR;
  u16* A2T = W2T + 64 * RSTR;
  const int tid = otid();
  const int lat = it < 256;
  const int it2 = lat ? it : it - 256;
  const int b = it2 >> 5, hd = (it2 >> 2) & 7, d = (it2 >> 1) & 1, half = it2 & 1;
  const int mbase = lat ? MCTX + b * 4096 : b * 256;
  const int Lseq = lat ? 4096 : 256;
  const int line = lat ? 64 : 256;
  const int nchunk = Lseq >> 4;
  for (int e = tid; e < 4096; e += NTHR) {
    int u = e >> 6, ch = e & 63;
    W2T[ch * RSTR + u] = f2bf(p.rw_w2[((size_t)(j * 2 + d) * 64 + u) * 512 + hd * 64 + ch]);
    A2T[ch * RSTR + u] = f2bf(p.rw_a2[((size_t)(j * 2 + d) * 64 + u) * 512 + hd * 64 + ch]);
  }
  if (tid < 64) {
    int cidx = hd * 64 + tid;
    mur[tid] = p.rw_mu[(j * 4 + 0) * 512 + cidx];
    muk[tid] = p.rw_mu[(j * 4 + 1) * 512 + cidx];
    muv[tid] = p.rw_mu[(j * 4 + 2) * 512 + cidx];
    kkp[tid] = p.rw_kk[j * 512 + cidx];
    kap[tid] = p.rw_ka[j * 512 + cidx];
    rkp[tid] = p.rw_rk[(j * 8 + hd) * 64 + tid];
    w0p[tid] = p.rw_w0[(j * 2 + d) * 512 + cidx];
    a0p[tid] = p.rw_a0[(j * 2 + d) * 512 + cidx];
  }
  const bool isprep = tid >= 256;
  const int pt = tid & 255;
  const int sq = pt & 7, srow = half * 32 + (pt >> 3);
  float S0[8];
  {
    const float* s0p = p.state_rwkv + ((((size_t)(b * 2 + j) * 2 + d) * 8 + hd) * 64 + srow) * 64 + sq * 8;
#pragma unroll
    for (int e = 0; e < 8; ++e) S0[e] = (lat && !isprep) ? s0p[e] : 0.f;
  }
  const int ptok = pt >> 4, c4 = (pt & 15) * 4;
  const int lane = tid & 63, fr = lane & 15, fq = lane >> 4, pw = (tid >> 6) & 3;
  uint2 pf[17];
#define RW_PREFETCH(S0_)                                                                   \
  {                                                                                        \
    const int s_ = (S0_) + ptok;                                                           \
    const int pos_ = s_ & (line - 1);                                                      \
    const u16* pr_ = prw + (size_t)(mbase + s_) * 2560;                                    \
    const u16* pl_ = pos_ > 0 ? pr_ - 2560 : pr_;                                          \
    const u16* pq_ = pos_ < line - 1 ? pr_ + 2560 : pr_;                                   \
    const int cr_ = hd * 64 + c4, cl_ = 2048 + d * 256 + c4;                               \
    pf[0] = *(const uint2*)(pr_ + cr_); pf[1] = *(const uint2*)(pl_ + cr_); pf[2] = *(const uint2*)(pq_ + cr_);                      \
    pf[3] = *(const uint2*)(pr_ + cr_ + 512); pf[4] = *(const uint2*)(pl_ + cr_ + 512); pf[5] = *(const uint2*)(pq_ + cr_ + 512);    \
    pf[6] = *(const uint2*)(pr_ + cr_ + 1024); pf[7] = *(const uint2*)(pl_ + cr_ + 1024); pf[8] = *(const uint2*)(pq_ + cr_ + 1024); \
    pf[9] = *(const uint2*)(pr_ + cl_);                                                                                             \
    pf[10] = *(const uint2*)(pr_ + cl_ + 64); pf[11] = *(const uint2*)(pl_ + cl_ + 64); pf[12] = *(const uint2*)(pq_ + cl_ + 64);    \
    pf[13] = *(const uint2*)(pr_ + cl_ + 128);                                                                                      \
    pf[14] = *(const uint2*)(pr_ + cl_ + 192); pf[15] = *(const uint2*)(pl_ + cl_ + 192); pf[16] = *(const uint2*)(pq_ + cl_ + 192); \
  }
#define RW_CHUNK_S0(I) ((d ? nchunk - 1 - (I) : (I)) << 4)
#pragma unroll
  for (int q = 0; q < 17; ++q) pf[q] = make_uint2(0, 0);
  if (isprep) RW_PREFETCH(RW_CHUNK_S0(0))
  __syncthreads();
  float kv4[4] = {0.f, 0.f, 0.f, 0.f}, a4[4] = {0.f, 0.f, 0.f, 0.f};
#define RW_DECL(X) float4 k0##X, k1##X, w0##X, w1##X, b0##X, b1##X, d0##X, d1##X, r0##X, r1##X; float vv##X;
#define RW_LOAD(X, TT)                                                                     \
  {                                                                                        \
    const int tk_ = d ? 15 - (TT) : (TT);                                                  \
    const int o8_ = tk_ * 64 + sq * 8;                                                     \
    k0##X = *(const float4*)(sb + 3072 + o8_); k1##X = *(const float4*)(sb + 3072 + o8_ + 4);   \
    w0##X = *(const float4*)(sb + 4096 + o8_); w1##X = *(const float4*)(sb + 4096 + o8_ + 4);   \
    b0##X = *(const float4*)(sb + 5120 + o8_); b1##X = *(const float4*)(sb + 5120 + o8_ + 4);   \
    d0##X = *(const float4*)(sb + 1024 + o8_); d1##X = *(const float4*)(sb + 1024 + o8_ + 4);   \
    r0##X = *(const float4*)(sb + o8_); r1##X = *(const float4*)(sb + o8_ + 4);                 \
    vv##X = sb[2048 + tk_ * 64 + srow];                                                          \
  }
#define RW_STEP(X, TT)                                                                                                      \
  {                                                                                                                         \
    const int tk_ = d ? 15 - (TT) : (TT);                                                                                   \
    float sa0 = (S0[0] * k0##X.x + S0[1] * k0##X.y) + (S0[2] * k0##X.z + S0[3] * k0##X.w) + (S0[4] * k1##X.x + S0[5] * k1##X.y) + \
                (S0[6] * k1##X.z + S0[7] * k1##X.w);                                                                        \
    sa0 = sum8(sa0);                                                                                                        \
    S0[0] = S0[0] * w0##X.x - sa0 * b0##X.x + vv##X * d0##X.x; S0[1] = S0[1] * w0##X.y - sa0 * b0##X.y + vv##X * d0##X.y;   \
    S0[2] = S0[2] * w0##X.z - sa0 * b0##X.z + vv##X * d0##X.z; S0[3] = S0[3] * w0##X.w - sa0 * b0##X.w + vv##X * d0##X.w;   \
    S0[4] = S0[4] * w1##X.x - sa0 * b1##X.x + vv##X * d1##X.x; S0[5] = S0[5] * w1##X.y - sa0 * b1##X.y + vv##X * d1##X.y;   \
    S0[6] = S0[6] * w1##X.z - sa0 * b1##X.z + vv##X * d1##X.z; S0[7] = S0[7] * w1##X.w - sa0 * b1##X.w + vv##X * d1##X.w;   \
    float o0 = (S0[0] * r0##X.x + S0[1] * r0##X.y) + (S0[2] * r0##X.z + S0[3] * r0##X.w) + (S0[4] * r1##X.x + S0[5] * r1##X.y) + \
               (S0[6] * r1##X.z + S0[7] * r1##X.w);                                                                         \
    o0 = sum8(o0);                                                                                                          \
    if (sq == 0) ob[tk_ * 64 + srow] = o0;                                                                                  \
  }
#define RW_RUN(T0, T1)                                          \
  {                                                             \
    RW_LOAD(A, T0)                                              \
    _Pragma("unroll") for (int tt = (T0); tt < (T1); tt += 2) { \
      RW_LOAD(B, min(tt + 1, 15))                               \
      __builtin_amdgcn_sched_barrier(0);                        \
      RW_STEP(A, tt)                                            \
      RW_LOAD(A, min(tt + 2, 15))                               \
      __builtin_amdgcn_sched_barrier(0);                        \
      if (tt + 1 < (T1)) RW_STEP(B, tt + 1)                     \
    }                                                           \
  }
  RW_DECL(A) RW_DECL(B)
  for (int i = 0; i <= nchunk + 1; ++i) {
    const bool doprep = isprep && (i < nchunk);
    const bool doscan = (!isprep) && (i >= 1) && (i <= nchunk);
    float* pbuf = BUF + (i & 1) * 6144;
    const float* sb = BUF + ((i - 1) & 1) * 6144;
    float* ob = OBB + ((i - 1) & 1) * 1024;
    const int s0 = RW_CHUNK_S0(i);
    if (isprep) {
      if (i >= 2) {
        const int c2 = half * 32 + (pt & 15) * 2;
        const float2 o2 = *(const float2*)(OBB + (i & 1) * 1024 + ptok * 64 + c2);
        *(u32*)(obuf + ((size_t)(mbase + RW_CHUNK_S0(i - 2) + ptok) * 2 + d) * 512 + hd * 64 + c2) = pack2(o2.x, o2.y);
      }
      if (doprep) {
        const int pos = (s0 + ptok) & (line - 1);
        const float mL = pos > 0 ? 0.5f : 0.f, mR = pos < line - 1 ? 0.5f : 0.f;
        float rm[4], km[4], vm[4], tw[4], la[4];
#pragma unroll
        for (int q = 0; q < 4; ++q) {
          const int ch = c4 + q;
#define PFV(ix) ((q & 1) ? bfhi((q >> 1) ? pf[ix].y : pf[ix].x) : bflo((q >> 1) ? pf[ix].y : pf[ix].x))
          float x0 = PFV(0), xl = PFV(1), xr = PFV(2);
          rm[q] = x0 + (mL * xl + mR * xr - x0) * mur[ch];
          x0 = PFV(3); xl = PFV(4); xr = PFV(5);
          km[q] = x0 + (mL * xl + mR * xr - x0) * muk[ch];
          x0 = PFV(6); xl = PFV(7); xr = PFV(8);
          vm[q] = x0 + (mL * xl + mR * xr - x0) * muv[ch];
          tw[q] = tanhf_(PFV(9) + mL * PFV(11) + mR * PFV(12) - PFV(10));
          la[q] = PFV(13) + mL * PFV(15) + mR * PFV(16) - PFV(14);
#undef PFV
        }
        *(float4*)(pbuf + ptok * 64 + c4) = make_float4(rm[0], rm[1], rm[2], rm[3]);
        *(float4*)(pbuf + 1024 + ptok * 64 + c4) = make_float4(km[0], km[1], km[2], km[3]);
        *(float4*)(pbuf + 2048 + ptok * 64 + c4) = make_float4(vm[0], vm[1], vm[2], vm[3]);
        uint2 t2, l2;
        t2.x = pack2(tw[0], tw[1]); t2.y = pack2(tw[2], tw[3]);
        l2.x = pack2(la[0], la[1]); l2.y = pack2(la[2], la[3]);
        *(uint2*)(TWb + ptok * RSTR + c4) = t2;
        *(uint2*)(LAb + ptok * RSTR + c4) = l2;
        if (pt < 32) SSB[pt] = 0.f;
        if (i + 1 < nchunk) RW_PREFETCH(RW_CHUNK_S0(i + 1))
      }
    } else if (doscan) {
      RW_RUN(0, 6)
    }
    __syncthreads();
    const int tok2 = fr, ch2 = 16 * pw + 4 * fq;
    if (isprep) {
      if (doprep) {
        f32x4 accw = {0.f, 0.f, 0.f, 0.f}, acca = {0.f, 0.f, 0.f, 0.f};
#pragma unroll
        for (int ks = 0; ks < 2; ++ks) {
          bf16x8 wa = *(const bf16x8*)(W2T + (16 * pw + fr) * RSTR + ks * 32 + fq * 8);
          bf16x8 tb8 = *(const bf16x8*)(TWb + fr * RSTR + ks * 32 + fq * 8);
          accw = __builtin_amdgcn_mfma_f32_16x16x32_bf16(wa, tb8, accw, 0, 0, 0);
          bf16x8 aa = *(const bf16x8*)(A2T + (16 * pw + fr) * RSTR + ks * 32 + fq * 8);
          bf16x8 lb8 = *(const bf16x8*)(LAb + fr * RSTR + ks * 32 + fq * 8);
          acca = __builtin_amdgcn_mfma_f32_16x16x32_bf16(aa, lb8, acca, 0, 0, 0);
        }
        const float4 km4 = *(const float4*)(pbuf + 1024 + tok2 * 64 + ch2);
        const float4 rm4 = *(const float4*)(pbuf + tok2 * 64 + ch2);
        const float kmv[4] = {km4.x, km4.y, km4.z, km4.w};
        const float rmv[4] = {rm4.x, rm4.y, rm4.z, rm4.w};
        float ss = 0.f, bon = 0.f;
        float dec[4], kd[4];
#pragma unroll
        for (int r = 0; r < 4; ++r) {
          const int ch = ch2 + r;
          float wraw = -softplusf_(-(w0p[ch] + accw[r])) - 0.5f;
          dec[r] = __expf(-__expf(wraw));
          float a = sigmoidf_(a0p[ch] + acca[r]);
          float kv = kmv[r] * kkp[ch];
          ss += kv * kv;
          kd[r] = kmv[r] * (1.f + (a - 1.f) * kap[ch]);
          bon += rmv[r] * kd[r] * rkp[ch];
          a4[r] = a;
          kv4[r] = kv;
        }
        *(float4*)(pbuf + 4096 + tok2 * 64 + ch2) = make_float4(dec[0], dec[1], dec[2], dec[3]);
        *(float4*)(pbuf + 1024 + tok2 * 64 + ch2) = make_float4(kd[0], kd[1], kd[2], kd[3]);
        ss += __shfl_xor(ss, 16); ss += __shfl_xor(ss, 32);
        bon += __shfl_xor(bon, 16); bon += __shfl_xor(bon, 32);
        if (fq == 0) { atomicAdd(&SSB[tok2], ss); atomicAdd(&SSB[16 + tok2], bon); }
      }
    } else if (doscan) {
      RW_RUN(6, 11)
    }
    __syncthreads();
    if (isprep) {
      if (doprep) {
        const float inv = rsqrtf(SSB[tok2] + 1e-12f);
        float kk[4];
#pragma unroll
        for (int r = 0; r < 4; ++r) kk[r] = kv4[r] * inv;
        *(float4*)(pbuf + 3072 + tok2 * 64 + ch2) = make_float4(kk[0], kk[1], kk[2], kk[3]);
        *(float4*)(pbuf + 5120 + tok2 * 64 + ch2) = make_float4(kk[0] * a4[0], kk[1] * a4[1], kk[2] * a4[2], kk[3] * a4[3]);
        if (half == 0 && pw == 0 && fq == 0) bonus[((size_t)(mbase + s0 + tok2) * 2 + d) * 8 + hd] = SSB[16 + tok2];
      }
    } else if (doscan) {
      RW_RUN(11, 16)
    }
    __syncthreads();
  }
#undef RW_PREFETCH
#undef RW_CHUNK_S0
#undef RW_DECL
#undef RW_LOAD
#undef RW_STEP
#undef RW_RUN
  if (!lat && !isprep) {
    float* dst = out_rwkv + ((((size_t)(b * 2 + j) * 2 + d) * 8 + hd) * 64 + srow) * 64 + sq * 8;
#pragma unroll
    for (int e = 0; e < 8; ++e) dst[e] = S0[e];
  }
  __syncthreads();
}

template <int GRP>
struct HyCfg {
  static constexpr int NB = GRP == 0 ? 8 : 32;
  static constexpr int NBLK = GRP == 0 ? 64 : 4;
  static constexpr int LSEQ = GRP == 0 ? 4096 : 256;
  static constexpr int NTW = GRP == 0 ? 4 : 1;
  static constexpr int MB = GRP == 0 ? MCTX : 0;
  static constexpr int LINE = GRP == 0 ? 64 : 256;
};

template <int GRP>
__device__ __forceinline__ void hyena_conv(const u16* ZS, const u16* FLB, f32x4 (&acc)[4][HyCfg<GRP>::NTW], int wave, int fr,
                                           int fq) {
  typedef HyCfg<GRP> Cf;
  constexpr int FLEN = 2 * Cf::LSEQ;
  const int colw0 = wave * Cf::NTW * 16;
  const int i_lo = colw0 / Cf::NB, i_hi = (colw0 + Cf::NTW * 16 - 1) / Cf::NB;
  const int o0 = Cf::LSEQ + 8 * fq - fr;
  const u16* fbase = (fr & 1) ? (FLB + FLEN + o0 - 1) : (FLB + o0);
#pragma unroll 1
  for (int d = -(Cf::NBLK - 1); d <= Cf::NBLK - 1; ++d) {
    if (i_hi - d < 0 || i_lo - d > Cf::NBLK - 1) continue;
    const u16* fd = fbase - 64 * d;
    bf16x8 f[6];
#pragma unroll
    for (int v = 0; v < 6; ++v) {
      const int off = (v < 4) ? (-16 * v) : (v == 4 ? 32 : 16);
      const u32* fp = (const u32*)(fd + off);
      uint4 t = make_uint4(fp[0], fp[1], fp[2], fp[3]);
      f[v] = *(bf16x8*)&t;
    }
#pragma unroll
    for (int nt = 0; nt < Cf::NTW; ++nt) {
      const int colg0 = colw0 + nt * 16;
      const int t_lo = colg0 / Cf::NB, t_hi = (colg0 + 15) / Cf::NB;
      if (t_hi - d < 0 || t_lo - d > Cf::NBLK - 1) continue;
      const int colg = colg0 + fr;
      const int i = colg / Cf::NB, b = colg % Cf::NB;
      const int k = i - d;
      const bool valid = (k >= 0) && (k < Cf::NBLK);
      uint4 t0 = make_uint4(0, 0, 0, 0), t1 = make_uint4(0, 0, 0, 0);
      if (valid) {
        t0 = *(const uint4*)(ZS + b * Cf::LSEQ + 64 * k + 8 * fq);
        t1 = *(const uint4*)(ZS + b * Cf::LSEQ + 64 * k + 32 + 8 * fq);
      }
      const bf16x8 b0 = *(bf16x8*)&t0, b1 = *(bf16x8*)&t1;
      acc[0][nt] = __builtin_amdgcn_mfma_f32_16x16x32_bf16(f[0], b0, acc[0][nt], 0, 0, 0);
      acc[1][nt] = __builtin_amdgcn_mfma_f32_16x16x32_bf16(f[1], b0, acc[1][nt], 0, 0, 0);
      acc[2][nt] = __builtin_amdgcn_mfma_f32_16x16x32_bf16(f[2], b0, acc[2][nt], 0, 0, 0);
      acc[3][nt] = __builtin_amdgcn_mfma_f32_16x16x32_bf16(f[3], b0, acc[3][nt], 0, 0, 0);
      acc[0][nt] = __builtin_amdgcn_mfma_f32_16x16x32_bf16(f[4], b1, acc[0][nt], 0, 0, 0);
      acc[1][nt] = __builtin_amdgcn_mfma_f32_16x16x32_bf16(f[5], b1, acc[1][nt], 0, 0, 0);
      acc[2][nt] = __builtin_amdgcn_mfma_f32_16x16x32_bf16(f[0], b1, acc[2][nt], 0, 0, 0);
      acc[3][nt] = __builtin_amdgcn_mfma_f32_16x16x32_bf16(f[1], b1, acc[3][nt], 0, 0, 0);
      if (nt & 1) asm volatile("" ::: "memory");
    }
  }
}

template <int FLEN>
__device__ __forceinline__ void hyena_load_filter(const u16* __restrict__ f, u16* FLB, int tid) {
  for (int e8 = tid; e8 < FLEN / 8; e8 += NTHR) {
    const uint4 v = *(const uint4*)(f + e8 * 8);
    const u32 nx = (e8 * 8 + 8 < FLEN) ? (u32)f[e8 * 8 + 8] : 0u;
    *(uint4*)(FLB + e8 * 8) = v;
    uint4 sft;
    sft.x = (v.x >> 16) | (v.y << 16);
    sft.y = (v.y >> 16) | (v.z << 16);
    sft.z = (v.z >> 16) | (v.w << 16);
    sft.w = (v.w >> 16) | (nx << 16);
    *(uint4*)(FLB + FLEN + e8 * 8) = sft;
  }
}

template <int GRP>
__device__ __forceinline__ void hyena_item(const P& p, int j, int c, u16* UT, u16* YO, const u16* FILT,
                                           const float* SUMSQ, char* smem) {
  typedef HyCfg<GRP> Cf;
  u16* ZS = (u16*)smem;
  u16* FLB = (u16*)(smem + 65536);
  constexpr int FLEN = 2 * Cf::LSEQ;
  const u16* filt0 = FILT + (GRP == 0 ? (size_t)0 : (size_t)2 * 512 * 8192);
  const int tid = otid(), wave = tid >> 6, lane = tid & 63, fr = lane & 15, fq = lane >> 4;
  const size_t MM = MTOK;
  {
    const float h0 = p.hy_conv[(j * 3 + 0) * 1536 + c], h1 = p.hy_conv[(j * 3 + 1) * 1536 + c], h2 = p.hy_conv[(j * 3 + 2) * 1536 + c];
    const u16* ur = UT + (size_t)c * MM + Cf::MB;
#pragma unroll 2
    for (int e8 = tid; e8 < Cf::NB * Cf::LSEQ / 8; e8 += NTHR) {
      const int e0 = e8 * 8;
      const int pos = e0 & (Cf::LINE - 1);
      const uint4 v = *(const uint4*)(ur + e0);
      const float xm = pos > 0 ? bf2f(ur[e0 - 1]) : 0.f;
      const float xp = pos + 8 < Cf::LINE ? bf2f(ur[e0 + 8]) : 0.f;
      const float x0 = bflo(v.x), x1 = bfhi(v.x), x2 = bflo(v.y), x3 = bfhi(v.y), x4 = bflo(v.z), x5 = bfhi(v.z), x6 = bflo(v.w),
                  x7 = bfhi(v.w);
      uint4 o;
      o.x = pack2(x0 * h1 + xm * h0 + x1 * h2, x1 * h1 + x0 * h0 + x2 * h2);
      o.y = pack2(x2 * h1 + x1 * h0 + x3 * h2, x3 * h1 + x2 * h0 + x4 * h2);
      o.z = pack2(x4 * h1 + x3 * h0 + x5 * h2, x5 * h1 + x4 * h0 + x6 * h2);
      o.w = pack2(x6 * h1 + x5 * h0 + x7 * h2, x7 * h1 + x6 * h0 + xp * h2);
      *(uint4*)(ZS + e0) = o;
    }
    hyena_load_filter<FLEN>(filt0 + (size_t)(0 * 512 + c) * FLEN, FLB, tid);
  }
  uint2 hxr[4][Cf::NTW];
#define HY_PREFETCH(UP)                                                                                      \
  _Pragma("unroll") for (int mb = 0; mb < 4; ++mb) _Pragma("unroll") for (int nt = 0; nt < Cf::NTW; ++nt) {   \
    const int colg = (wave * Cf::NTW + nt) * 16 + fr;                                                         \
    const int i = colg / Cf::NB, b = colg % Cf::NB;                                                           \
    const int t0 = 64 * i + 16 * mb + 4 * fq;                                                                 \
    const int e0 = b * Cf::LSEQ + t0;                                                                         \
    hxr[mb][nt] = *(const uint2*)((UP) + e0);                                                                 \
  }
#define HY_HALO(UP)                                                                                          \
  _Pragma("unroll") for (int mb = 0; mb < 4; ++mb) _Pragma("unroll") for (int nt = 0; nt < Cf::NTW; ++nt) {   \
    const int colg = (wave * Cf::NTW + nt) * 16 + fr;                                                         \
    const int i = colg / Cf::NB, b = colg % Cf::NB;                                                           \
    const int t0 = 64 * i + 16 * mb + 4 * fq;                                                                 \
    const int e0 = b * Cf::LSEQ + t0;                                                                         \
    const u32 lo_ = ((t0 & (Cf::LINE - 1)) > 0) ? (u32)(UP)[e0 - 1] : 0u;                                     \
    const u32 hi_ = (((t0 + 3) & (Cf::LINE - 1)) < Cf::LINE - 1) ? (u32)(UP)[e0 + 4] : 0u;                    \
    hxh[mb][nt] = lo_ | (hi_ << 16);                                                                          \
  }
  const u16* u1 = UT + (size_t)(512 + c) * MM + Cf::MB;
  HY_PREFETCH(u1)
  __syncthreads();
  f32x4 acc[4][Cf::NTW];
#pragma unroll
  for (int mb = 0; mb < 4; ++mb)
#pragma unroll
    for (int nt = 0; nt < Cf::NTW; ++nt) acc[mb][nt] = f32x4{0.f, 0.f, 0.f, 0.f};
  hyena_conv<GRP>(ZS, FLB, acc, wave, fr, fq);
  {
    const float scale = rsqrtf(SUMSQ[((j * 2 + GRP) * 2 + 0) * 512 + c] + 1e-6f);
    const float bias = p.hy_bias[(j * 2 + 0) * 512 + c];
    const float g0 = p.hy_conv[(j * 3 + 0) * 1536 + 512 + c], g1 = p.hy_conv[(j * 3 + 1) * 1536 + 512 + c],
                g2 = p.hy_conv[(j * 3 + 2) * 1536 + 512 + c];
    u32 hxh[4][Cf::NTW];
    HY_HALO(u1)
#pragma unroll
    for (int mb = 0; mb < 4; ++mb)
#pragma unroll
      for (int nt = 0; nt < Cf::NTW; ++nt) {
        const int colg = (wave * Cf::NTW + nt) * 16 + fr;
        const int i = colg / Cf::NB, b = colg % Cf::NB;
        const int e0 = b * Cf::LSEQ + 64 * i + 16 * mb + 4 * fq;
        const uint2 raw = hxr[mb][nt];
        const uint2 zr = *(const uint2*)(ZS + e0);
        const float xm = bflo(hxh[mb][nt]), xp = bfhi(hxh[mb][nt]);
        const float x0 = bflo(raw.x), x1 = bfhi(raw.x), x2 = bflo(raw.y), x3 = bfhi(raw.y);
        acc[mb][nt][0] = (x0 * g1 + xm * g0 + x1 * g2) * (scale * acc[mb][nt][0] + bias * bflo(zr.x));
        acc[mb][nt][1] = (x1 * g1 + x0 * g0 + x2 * g2) * (scale * acc[mb][nt][1] + bias * bfhi(zr.x));
        acc[mb][nt][2] = (x2 * g1 + x1 * g0 + x3 * g2) * (scale * acc[mb][nt][2] + bias * bflo(zr.y));
        acc[mb][nt][3] = (x3 * g1 + x2 * g0 + xp * g2) * (scale * acc[mb][nt][3] + bias * bfhi(zr.y));
        asm volatile("" : "+v"(acc[mb][nt]) : : "memory");
      }
  }
  __syncthreads();
#pragma unroll
  for (int mb = 0; mb < 4; ++mb)
#pragma unroll
    for (int nt = 0; nt < Cf::NTW; ++nt) {
      const int colg = (wave * Cf::NTW + nt) * 16 + fr;
      const int i = colg / Cf::NB, b = colg % Cf::NB;
      const int e0 = b * Cf::LSEQ + 64 * i + 16 * mb + 4 * fq;
      uint2 pk;
      pk.x = pack2(acc[mb][nt][0], acc[mb][nt][1]);
      pk.y = pack2(acc[mb][nt][2], acc[mb][nt][3]);
      *(uint2*)(ZS + e0) = pk;
      acc[mb][nt] = f32x4{0.f, 0.f, 0.f, 0.f};
    }
  hyena_load_filter<FLEN>(filt0 + (size_t)(1 * 512 + c) * FLEN, FLB, tid);
  const u16* u2 = UT + (size_t)(1024 + c) * MM + Cf::MB;
  HY_PREFETCH(u2)
  __syncthreads();
  hyena_conv<GRP>(ZS, FLB, acc, wave, fr, fq);
  {
    const float scale = rsqrtf(SUMSQ[((j * 2 + GRP) * 2 + 1) * 512 + c] + 1e-6f);
    const float bias = p.hy_bias[(j * 2 + 1) * 512 + c];
    const float g0 = p.hy_conv[(j * 3 + 0) * 1536 + 1024 + c], g1 = p.hy_conv[(j * 3 + 1) * 1536 + 1024 + c],
                g2 = p.hy_conv[(j * 3 + 2) * 1536 + 1024 + c];
    u16* yo = YO + (size_t)c * MM + Cf::MB;
    u32 hxh[4][Cf::NTW];
    HY_HALO(u2)
#pragma unroll
    for (int mb = 0; mb < 4; ++mb)
#pragma unroll
      for (int nt = 0; nt < Cf::NTW; ++nt) {
        const int colg = (wave * Cf::NTW + nt) * 16 + fr;
        const int i = colg / Cf::NB, b = colg % Cf::NB;
        const int e0 = b * Cf::LSEQ + 64 * i + 16 * mb + 4 * fq;
        const uint2 raw = hxr[mb][nt];
        const uint2 zr = *(const uint2*)(ZS + e0);
        const float xm = bflo(hxh[mb][nt]), xp = bfhi(hxh[mb][nt]);
        const float x0 = bflo(raw.x), x1 = bfhi(raw.x), x2 = bflo(raw.y), x3 = bfhi(raw.y);
        const float y0 = (x0 * g1 + xm * g0 + x1 * g2) * (scale * acc[mb][nt][0] + bias * bflo(zr.x));
        const float y1 = (x1 * g1 + x0 * g0 + x2 * g2) * (scale * acc[mb][nt][1] + bias * bfhi(zr.x));
        const float y2 = (x2 * g1 + x1 * g0 + x3 * g2) * (scale * acc[mb][nt][2] + bias * bflo(zr.y));
        const float y3 = (x3 * g1 + x2 * g0 + xp * g2) * (scale * acc[mb][nt][3] + bias * bfhi(zr.y));
        uint2 pk;
        pk.x = pack2(y0, y1);
        pk.y = pack2(y2, y3);
        *(uint2*)(yo + e0) = pk;
        asm volatile("" ::: "memory");
      }
  }
#undef HY_PREFETCH
#undef HY_HALO
  __syncthreads();
}

__device__ __forceinline__ void phase_cdscan(const P& p, int j, const u16* prw, u16* obuf, float* bonus, float* out_rwkv, u16* UT,
                                             const u16* FILT, const float* SUMSQ, int* ctr, char* smem) {
  int* sitem = (int*)(smem + SMEM_BYTES - 16);
  for (;;) {
    if (otid() == 0) *sitem = atomicAdd(ctr, 1);
    __syncthreads();
    const int it = *sitem;
    __syncthreads();
    if (it >= 1280 + 1024) break;
    if (it < 1280) {
#ifndef NO_RW
      for (int rep = 0; rep < REP_RW; ++rep) rwkv_item(p, j, it, prw, obuf, bonus, out_rwkv, smem);
#endif
    } else if (it < 1280 + 512) {
#ifndef NO_HY0
      for (int rep = 1; rep < REP_HY; ++rep) hyena_item<0>(p, j, it - 1280, UT, UT + (size_t)1536 * MTOK, FILT, SUMSQ, smem);
      hyena_item<0>(p, j, it - 1280, UT, UT, FILT, SUMSQ, smem);
#endif
    } else {
#ifndef NO_HY1
      for (int rep = 1; rep < REP_HY; ++rep) hyena_item<1>(p, j, it - 1792, UT, UT + (size_t)1536 * MTOK, FILT, SUMSQ, smem);
      hyena_item<1>(p, j, it - 1792, UT, UT, FILT, SUMSQ, smem);
#endif
    }
  }
}

__device__ __forceinline__ void phase_cdfinal(const P& p, int j, const u16* __restrict__ prw, const u16* __restrict__ obuf,
                                              const float* __restrict__ bonus, const u16* __restrict__ UT, u16* __restrict__ mix,
                                              char* smem) {
  const int tid = otid(), lane = tid & 63;
  {
    const int gw = blockIdx.x * 8 + (tid >> 6);
    const int c8 = lane * 8, hd = lane >> 3;
    float gg[8], gb[8], muv[8], mug[8];
#pragma unroll
    for (int q = 0; q < 8; ++q) {
      gg[q] = p.rw_gn_g[j * 512 + c8 + q];
      gb[q] = p.rw_gn_b[j * 512 + c8 + q];
      muv[q] = p.rw_mu[(j * 4 + 2) * 512 + c8 + q];
      mug[q] = p.rw_mu[(j * 4 + 3) * 512 + c8 + q];
    }
    for (int m = gw; m < MTOK; m += gridDim.x * 8) {
      const int line = m < MCTX ? 256 : 64;
      const int pos = m & (line - 1);
      const float mL = pos > 0 ? 0.5f : 0.f, mR = pos < line - 1 ? 0.5f : 0.f;
      const u16* pr = prw + (size_t)m * 2560;
      const u16* pl = pos > 0 ? pr - 2560 : pr;
      const u16* pq = pos < line - 1 ? pr + 2560 : pr;
      const uint4 o0 = *(const uint4*)(obuf + ((size_t)m * 2 + 0) * 512 + c8);
      const uint4 o1 = *(const uint4*)(obuf + ((size_t)m * 2 + 1) * 512 + c8);
      const uint4 v0 = *(const uint4*)(pr + 1024 + c8), vl = *(const uint4*)(pl + 1024 + c8), vr = *(const uint4*)(pq + 1024 + c8);
      const uint4 g0 = *(const uint4*)(pr + 1536 + c8), gl = *(const uint4*)(pl + 1536 + c8), gr = *(const uint4*)(pq + 1536 + c8);
      const float bon = bonus[((size_t)m * 2 + 0) * 8 + hd] + bonus[((size_t)m * 2 + 1) * 8 + hd];
      const u32* o0p = (const u32*)&o0; const u32* o1p = (const u32*)&o1;
      const u32* v0p = (const u32*)&v0; const u32* vlp = (const u32*)&vl; const u32* vrp = (const u32*)&vr;
      const u32* g0p = (const u32*)&g0; const u32* glp = (const u32*)&gl; const u32* grp = (const u32*)&gr;
      float o[8];
      float s1 = 0.f;
#pragma unroll
      for (int q = 0; q < 8; ++q) {
        const int w = q >> 1;
        o[q] = (q & 1) ? (bfhi(o0p[w]) + bfhi(o1p[w])) : (bflo(o0p[w]) + bflo(o1p[w]));
        s1 += o[q];
      }
      const float mean = sum8(s1) * (1.f / 64.f);
      float s2 = 0.f;
#pragma unroll
      for (int q = 0; q < 8; ++q) { o[q] -= mean; s2 += o[q] * o[q]; }
      const float rstd = rsqrtf(sum8(s2) * (1.f / 64.f) + 64e-5f);
      float y[8];
#pragma unroll
      for (int q = 0; q < 8; ++q) {
        const int w = q >> 1;
        const bool hi = q & 1;
        const float x0 = hi ? bfhi(v0p[w]) : bflo(v0p[w]), xl = hi ? bfhi(vlp[w]) : bflo(vlp[w]), xr = hi ? bfhi(vrp[w]) : bflo(vrp[w]);
        const float vm = x0 + (mL * xl + mR * xr - x0) * muv[q];
        const float y0 = hi ? bfhi(g0p[w]) : bflo(g0p[w]), yl = hi ? bfhi(glp[w]) : bflo(glp[w]), yr = hi ? bfhi(grp[w]) : bflo(grp[w]);
        const float gm = y0 + (mL * yl + mR * yr - y0) * mug[q];
        const float on = o[q] * rstd * gg[q] + gb[q];
        y[q] = (on + bon * vm) * sigmoidf_(gm);
      }
      uint4 pk;
      pk.x = pack2(y[0], y[1]); pk.y = pack2(y[2], y[3]); pk.z = pack2(y[4], y[5]); pk.w = pack2(y[6], y[7]);
      *(uint4*)(mix + (size_t)m * 1024 + 512 + c8) = pk;
    }
  }
  {
    u16* tl = (u16*)smem;
    for (int t = blockIdx.x; t < 640 * 8; t += gridDim.x) {
      const int mt = t >> 3, ct = t & 7;
      for (int e = tid; e < 4096; e += NTHR) {
        int cc = e >> 6, mm = e & 63;
        tl[cc * 66 + mm] = UT[(size_t)(ct * 64 + cc) * MTOK + mt * 64 + mm];
      }
      __syncthreads();
      for (int e = tid; e < 4096; e += NTHR) {
        int mm = e >> 6, cc = e & 63;
        mix[(size_t)(mt * 64 + mm) * 1024 + ct * 64 + cc] = tl[cc * 66 + mm];
      }
      __syncthreads();
    }
  }
}

#ifndef PHMASK
#define PHMASK 0xffffffffu
#endif
#define PHS(b) ((PHMASK >> (b)) & 1u)
#define XB_XCNT(j) (256 + 64 * (j))
#define XB_XSUB(j) (1280 + 64 * (j))
#define XB_XGEN(j) (2304 + 64 * (j))
#define XB_TOP 3328
#define XB_TOPGEN 3392
#define XCD_BAR_WORDS 3456
__device__ __forceinline__ unsigned xb_ld(unsigned* p) { return __hip_atomic_load(p, __ATOMIC_RELAXED, __HIP_MEMORY_SCOPE_AGENT); }
__device__ __forceinline__ unsigned xb_add(unsigned* p, unsigned v) { return __hip_atomic_fetch_add(p, v, __ATOMIC_RELAXED, __HIP_MEMORY_SCOPE_AGENT); }
__device__ __forceinline__ unsigned xb_xcc_id() { return (unsigned)__builtin_amdgcn_s_getreg((3 << 11) | 20) & 0xFu; }
__device__ __forceinline__ void xcd_barrier(unsigned* bar, volatile unsigned* st) {
  asm volatile("s_waitcnt vmcnt(0)" ::: "memory");
  __syncthreads();
  if (otid() == 0) {
    __builtin_amdgcn_s_waitcnt(0);
    const unsigned x = xb_xcc_id();
    unsigned nloc = st[0], nx = st[1];
    if (nloc == 0u) {
      const unsigned G = gridDim.x;
      unsigned sum, cnt, mine;
      for (;;) {
        sum = 0u; cnt = 0u; mine = 0u;
#pragma unroll
        for (unsigned jx = 0; jx < 16; ++jx) {
          const unsigned c = xb_ld(&bar[XB_XCNT(jx)]);
          sum += c; cnt += (c > 0u) ? 1u : 0u; mine = (jx == x) ? c : mine;
        }
        if (sum == G) break;
        __builtin_amdgcn_s_sleep(1);
      }
      nloc = mine > 0u ? mine : 1u; nx = cnt > 0u ? cnt : 1u;
      st[0] = nloc; st[1] = nx;
    }
    const unsigned old = xb_add(&bar[XB_XSUB(x)], 1u);
    const unsigned gen = old / nloc;
    if (old + 1u == (gen + 1u) * nloc) {
      __builtin_amdgcn_fence(__ATOMIC_RELEASE, "agent");
      asm volatile("s_waitcnt vmcnt(0)" ::: "memory");
      const unsigned og = xb_add(&bar[XB_TOP], 1u);
      const unsigned tg = og / nx;
      if (og + 1u == (tg + 1u) * nx) xb_add(&bar[XB_TOPGEN], 1u);
      else while (xb_ld(&bar[XB_TOPGEN]) == tg) __builtin_amdgcn_s_sleep(1);
      __builtin_amdgcn_fence(__ATOMIC_ACQUIRE, "agent");
      xb_add(&bar[XB_XGEN(x)], 1u);
      asm volatile("s_waitcnt vmcnt(0)" ::: "memory");
    } else {
      while (xb_ld(&bar[XB_XGEN(x)]) == gen) __builtin_amdgcn_s_sleep(1);
      __builtin_amdgcn_fence(__ATOMIC_ACQUIRE, "agent");
      asm volatile("s_waitcnt vmcnt(0)" ::: "memory");
    }
  }
  __syncthreads();
}
__global__ void __launch_bounds__(NTHR) fwd_megakernel(P p, int ph_begin, int ph_end) {
  extern __shared__ __attribute__((aligned(16))) char smem[];
  cg::grid_group grid = cg::this_grid();
  char* ws = p.ws;
  float* mods = (float*)(ws + OFF_MODS);
  float* bonus = (float*)(ws + OFF_BONUS);
  float* HID2 = (float*)(ws + OFF_HID2);
  float* SUMSQ = (float*)(ws + OFF_SUMSQ);
  int* CTR = (int*)(ws + OFF_CTR);
  u16* WIN = (u16*)(ws + OFF_WIN);
  u16* WOUT = (u16*)(ws + OFF_WOUT);
  u16* W1T = (u16*)(ws + OFF_W1T);
  u16* W2T = (u16*)(ws + OFF_W2T);
  u16* FILT = (u16*)(ws + OFF_FILT);
  u16* H = (u16*)(ws + OFF_H);
  char* arena = ws + OFF_ARENA;
  float* X = p.out;
  float* out_lru = p.out + (size_t)MTOK * 1024;
  float* out_rwkv = out_lru + 32 * 2 * 2 * 512;
  float* smf = (float*)smem;

  volatile unsigned* xst = (volatile unsigned*)(smem + 131072);
  unsigned* xbar = (unsigned*)(p.ws + OFF_BAR);
  if (otid() == 0) { xst[0] = 0u; xst[1] = 0u; (void)xb_add(&xbar[XB_XCNT(xb_xcc_id())], 1u); }
  __syncthreads();
  for (int ph = ph_begin; ph < ph_end; ++ph) {
    if (TSEL && blockIdx.x == 0 && otid() == 0) ((unsigned long long*)(p.ws + OFF_CTR + 1024))[ph] = wall_clock64();
    if (ph == 0) {
      if (blockIdx.x == 0 && otid() < 16) CTR[otid()] = 0;
      for (int i = blockIdx.x * NTHR + otid(); i < 2 * 2 * 2 * 512; i += gridDim.x * NTHR) SUMSQ[i] = 0.f;
      for (int rep = 0; rep < REP_O; ++rep) {
      if (PHS(0)) phase_mods(p, mods, smf);
      __syncthreads();
      if (PHS(1)) phase_hid2(p, HID2, smf);
      if (PHS(2)) { conv_mix_weights(p, 0, ws, smf); }
      __syncthreads(); }
    } else if (ph == 1) {
      for (int rep = 0; rep < REP_O; ++rep) phase_xinit(p, X, mods, H);

    } else {
      const int l = (ph - 2) >> 3, s = (ph - 2) & 7;
      const int j = l >> 1;
      const bool cd = l & 1;
      const float* modl = mods + (size_t)l * 9 * 6144;
      if (s == 0) {
        if (!cd) {
          for (int rep = 0; rep < REP_G; ++rep) gemm_phase<0>(H, 1024, WIN, 1024, 2560, (u16*)arena, 2560, 0, nullptr, nullptr, nullptr, smem);

        } else {
          for (int rep = 0; rep < REP_G; ++rep) gemm_phase<1>(H, 1024, WIN, 1024, 4096, (u16*)arena, 2560, 0, (u16*)(arena + ARENA_B), nullptr, nullptr, smem);
        }

      } else if (s == 1) {
        if (!cd) {
          phase_lru_gates(p, j, (const u16*)arena, (u32*)(arena + ARENA_B), smem);
          xcd_barrier(xbar, xst);
          phase_lru_scan(p, j, (u32*)(arena + ARENA_B), out_lru, CTR + l, smem);
          phase_filtgen(p, j, HID2, FILT, SUMSQ, smf);
        }
        else if (PHS(8)) phase_cdscan(p, j, (const u16*)arena, H, bonus, out_rwkv, (u16*)(arena + ARENA_B), FILT, SUMSQ, CTR + l, smem);
      } else if (s == 2) {
        if (!cd) { for (int rep = 0; rep < REP_O; ++rep) phase_abmix(p, j, (const u16*)arena, (const float*)(arena + ARENA_B), H); }
        else for (int rep = 0; rep < REP_O; ++rep) phase_cdfinal(p, j, (const u16*)arena, H, bonus, (const u16*)(arena + ARENA_B),
                           (u16*)(arena + ARENA_B) + (size_t)512 * MTOK, smem);
      } else if (s == 3) {
        const u16* mixp = cd ? (const u16*)(arena + ARENA_B) + (size_t)512 * MTOK : H;
        if (!cd) for (int rep = 1; rep < REP_E2; ++rep) gemm_phase<2>(mixp, 1024, WOUT, 1024, 1024, nullptr, 0, 1, nullptr, (float*)arena, modl + 2048, smem);
        if (PHS(11)) gemm_phase<2>(mixp, 1024, WOUT, 1024, 1024, nullptr, 0, cd ? 1 : 0, nullptr, X, modl + 2048, smem);
        conv_mlp_weights(p, l, ws, smf, false);
      } else if (s == 4) {
        for (int rep = 1; rep < REP_LN; ++rep) phase_ln(X, p.ln1_g + l * 1024, p.ln1_b + l * 1024, modl, 3072, 4096, H, 1, 0, 0);
        if (PHS(12)) phase_ln(X, p.ln1_g + l * 1024, p.ln1_b + l * 1024, modl, 3072, 4096, H, 1, 0);
      } else if (s == 5) {
        for (int rep = 0; rep < REP_G; ++rep) gemm_phase<0>(H, 1024, W1T, 1024, 4096, (u16*)arena, 4096, 1, nullptr, nullptr, nullptr, smem);

      } else if (s == 6) {
        for (int rep = 0; rep < REP_M2; ++rep) gemm_phase<0>((const u16*)arena, 4096, W2T, 4096, 1024, H, 1024, 0, nullptr, nullptr, nullptr, smem);
        if (PHS(11)) gemm_phase<2>((const u16*)arena, 4096, W2T, 4096, 1024, nullptr, 0, 0, nullptr, X, modl + 5120, smem);
        if (l < 3) conv_mix_weights(p, l + 1, ws, smf, false);
      } else {
        const float* modn = mods + (size_t)(l + 1) * 9 * 6144;
        for (int rep = 1; rep < REP_LN; ++rep) phase_ln(X, p.ln2_g + l * 1024, p.ln2_b + l * 1024, l < 3 ? modn : modl, 0, 1024, H, 1, ((l + 1) & 1), 0);
        if (PHS(12)) phase_ln(X, p.ln2_g + l * 1024, p.ln2_b + l * 1024, l < 3 ? modn : modl, 0, 1024, H, l < 3 ? 1 : 0, ((l + 1) & 1));
      }
    }
    if (ph + 1 < ph_end) {
      if (ph_end < 0) grid.sync();
      xcd_barrier(xbar, xst);
    }
  }
  if (TSEL && blockIdx.x == 0 && otid() == 0) {
    unsigned long long* TS = (unsigned long long*)(p.ws + OFF_CTR + 1024);
    const unsigned long long tend = wall_clock64();
    TS[34] = tend;
    unsigned long long spin = 0;
    for (int ph = 0; ph < 34; ++ph) {
      const unsigned long long dd = TS[ph + 1] - TS[ph];
      const int sc = ph < 2 ? -1 : ((ph - 2) & 7);
      bool sel = false;
      if (TSEL == 1) sel = true;
      else if (TSEL == 2) sel = (sc == 0 || sc == 3 || sc == 5 || sc == 6);
      else if (TSEL == 3) sel = (sc == 1);
      else if (TSEL == 4) sel = (sc == 2 || sc == 4 || sc == 7);
      else if (TSEL == 5) sel = (sc == -1);
      else if (TSEL == 6) sel = (sc == 4 || sc == 7);
      else if (TSEL == 7) sel = (sc == 2);
      else if (TSEL == 8) sel = (sc == 1 && (((ph - 2) >> 3) & 1) == 0);
      else if (TSEL == 9) sel = (sc == 1 && (((ph - 2) >> 3) & 1) == 1);
      if (sel) spin += dd;
    }
    while (wall_clock64() - tend < spin) { __builtin_amdgcn_s_sleep(8); }
  }
}

extern "C" void kernel_launch(void* const* d_in, const int* in_sizes, int n_in, void* d_out, int out_size, void* d_ws,
                              size_t ws_size, hipStream_t stream) {
  static int grid_blocks = 0;
  if (!grid_blocks) {
    int dev = 0, cus = 0, per_cu = 0;
    hipGetDevice(&dev);
    hipDeviceGetAttribute(&cus, hipDeviceAttributeMultiprocessorCount, dev);
    hipFuncSetAttribute((const void*)fwd_megakernel, hipFuncAttributeMaxDynamicSharedMemorySize, SMEM_BYTES);
    hipOccupancyMaxActiveBlocksPerMultiprocessor(&per_cu, fwd_megakernel, NTHR, SMEM_BYTES);
    if (per_cu < 1) per_cu = 1;
    grid_blocks = cus * per_cu;
  }
  if (ws_size < WS_NEED) fprintf(stderr, "workspace too small: %zu < %llu\n", ws_size, (unsigned long long)WS_NEED);
  P p{};
  const float** pp = (const float**)&p;
  for (int i = 0; i < 46; ++i) pp[i] = (const float*)d_in[i];
  p.out = (float*)d_out;
  p.ws = (char*)d_ws;
  int ph0 = 0, ph1 = 34;
  void* args[] = {&p, &ph0, &ph1};
  hipMemsetAsync((char*)d_ws + OFF_BAR, 0, 16384, stream);
  hipError_t e = hipLaunchCooperativeKernel((void*)fwd_megakernel, dim3(grid_blocks), dim3(NTHR), args, SMEM_BYTES, stream);
  if (e != hipSuccess) fprintf(stderr, "cooperative launch failed: %s (grid %d)\n", hipGetErrorString(e), grid_blocks);
}
```

```cpp
#include <hip/hip_runtime.h>
#include <hip/hip_bf16.h>
#include <hip/hip_cooperative_groups.h>
#include <cstdio>
namespace cg = cooperative_groups;

typedef unsigned short u16;
typedef unsigned int u32;
using bf16x8 = __attribute__((ext_vector_type(8))) short;
using f32x4 = __attribute__((ext_vector_type(4))) float;

#define REP_G 1
#define TSEL 0
#define REP_E2 1
#define REP_FG 1
#define REP_LN 1
#define REP_HY 1
#define REP_SYNC 1
#define REP_O 1
#define REP_M2 0
#define REP_RW 1
#define REP_LRU 1
#define NTHR 512
#define MTOK 40960
#define MCTX 8192
#define ALPHA 1.6817928305074292f
#define SMEM_BYTES 131136

struct P {
  const float *x_prompt, *x_sample, *state_lru, *state_rwkv, *c, *c_ctx, *w_mod, *b_mod, *ln1_g, *ln1_b, *ln2_g, *ln2_b,
      *mlp_w1, *mlp_w2, *w_out, *ab_w_in, *sc_conv, *lru_conv, *lru_conv_b, *lru_wa, *lru_ba, *lru_wi, *lru_bi, *lru_lambda,
      *cd_w_in, *hy_conv, *hy_w1, *hy_b1, *hy_w2, *hy_b2, *hy_w3, *hy_freq, *hy_bias, *rw_mu, *rw_mu_x, *rw_w0, *rw_w1, *rw_w2,
      *rw_a0, *rw_a1, *rw_a2, *rw_kk, *rw_ka, *rw_rk, *rw_gn_g, *rw_gn_b;
  float* out;
  char* ws;
};

#define MiB (1024ull * 1024ull)
#define OFF_MODS (0ull)
#define OFF_BONUS (1ull * MiB)
#define OFF_HID2 (4ull * MiB)
#define OFF_SUMSQ (7ull * MiB)
#define OFF_CTR (7ull * MiB + 65536ull)
#define OFF_BAR (7ull * MiB + 131072ull)
#define OFF_WIN (8ull * MiB)
#define OFF_WOUT (16ull * MiB)
#define OFF_W1T (18ull * MiB)
#define OFF_W2T (26ull * MiB)
#define OFF_FILT (34ull * MiB)
#define OFF_H (52ull * MiB)
#define OFF_ARENA (132ull * MiB)
#define ARENA_B (200ull * MiB)
#define WS_NEED (492ull * MiB)

__device__ __forceinline__ int otid() {
  int t = threadIdx.x;
  asm volatile("" : "+v"(t));
  return t;
}
__device__ __forceinline__ u16 f2bf(float f) {
  u32 u = __float_as_uint(f);
  u += 0x7fffu + ((u >> 16) & 1u);
  return (u16)(u >> 16);
}
__device__ __forceinline__ float bf2f(u16 h) { return __uint_as_float(((u32)h) << 16); }
__device__ __forceinline__ float bflo(u32 u) { return __uint_as_float(u << 16); }
__device__ __forceinline__ float bfhi(u32 u) { return __uint_as_float(u & 0xffff0000u); }
__device__ __forceinline__ u32 pack2(float a, float b) { return (u32)f2bf(a) | ((u32)f2bf(b) << 16); }
__device__ __forceinline__ float sigmoidf_(float x) { return __builtin_amdgcn_rcpf(1.f + __expf(-x)); }
__device__ __forceinline__ float softplusf_(float x) { return fmaxf(x, 0.f) + __logf(1.f + __expf(-fabsf(x))); }
__device__ __forceinline__ float tanhf_(float x) { return 1.f - 2.f * __builtin_amdgcn_rcpf(1.f + __expf(2.f * x)); }
template <int CTRL>
__device__ __forceinline__ float dpp_mov(float v) {
  return __int_as_float(__builtin_amdgcn_update_dpp(0, __float_as_int(v), CTRL, 0xf, 0xf, true));
}
__device__ __forceinline__ float wsum(float v) {
  v += dpp_mov<0xB1>(v);
  v += dpp_mov<0x4E>(v);
  v += dpp_mov<0x141>(v);
  v += dpp_mov<0x140>(v);
  const int iv = __float_as_int(v);
  return (__int_as_float(__builtin_amdgcn_readlane(iv, 0)) + __int_as_float(__builtin_amdgcn_readlane(iv, 16))) +
         (__int_as_float(__builtin_amdgcn_readlane(iv, 32)) + __int_as_float(__builtin_amdgcn_readlane(iv, 48)));
}
__device__ __forceinline__ int mods_row(int m) { return m < MCTX ? 0 : 1 + ((m - MCTX) >> 12); }
__device__ __forceinline__ int perm_row(int m) {
  if (m < MCTX) return m;
  int t = m - MCTX;
  int b = t >> 12, s = t & 4095;
  return MCTX + (b << 12) + ((s & 63) << 6) + (s >> 6);
}

__device__ __forceinline__ void phase_mods(const P& p, float* mods, float* sm) {
  float* sc = sm;
  float* red = sm + 9 * 1024;
  const int tid = otid();
  for (int i = tid; i < 9 * 1024; i += NTHR) {
    int r = i >> 10, k = i & 1023;
    float v = (r == 0) ? p.c_ctx[k] : p.c[(r - 1) * 1024 + k];
    sc[i] = v / (1.f + __expf(-v));
  }
  __syncthreads();
  const int nl = tid & 63, ks = tid >> 6;
  for (int it = blockIdx.x; it < 4 * 96; it += gridDim.x) {
    int l = it / 96, ng = it % 96;
    int n = ng * 64 + nl;
    const float* w = p.w_mod + (size_t)l * 1024 * 6144 + n;
    float a0 = 0, a1 = 0, a2 = 0, a3 = 0, a4 = 0, a5 = 0, a6 = 0, a7 = 0, a8 = 0;
#pragma unroll 4
    for (int k = ks * 128; k < ks * 128 + 128; ++k) {
      float wv = w[(size_t)k * 6144];
      a0 += sc[k] * wv; a1 += sc[1024 + k] * wv; a2 += sc[2048 + k] * wv; a3 += sc[3072 + k] * wv;
      a4 += sc[4096 + k] * wv; a5 += sc[5120 + k] * wv; a6 += sc[6144 + k] * wv; a7 += sc[7168 + k] * wv;
      a8 += sc[8192 + k] * wv;
    }
    red[(ks * 9 + 0) * 64 + nl] = a0; red[(ks * 9 + 1) * 64 + nl] = a1; red[(ks * 9 + 2) * 64 + nl] = a2;
    red[(ks * 9 + 3) * 64 + nl] = a3; red[(ks * 9 + 4) * 64 + nl] = a4; red[(ks * 9 + 5) * 64 + nl] = a5;
    red[(ks * 9 + 6) * 64 + nl] = a6; red[(ks * 9 + 7) * 64 + nl] = a7; red[(ks * 9 + 8) * 64 + nl] = a8;
    __syncthreads();
    for (int o = tid; o < 9 * 64; o += NTHR) {
      int r = o >> 6, cc = o & 63;
      float s = 0;
#pragma unroll
      for (int q = 0; q < 8; ++q) s += red[(q * 9 + r) * 64 + cc];
      int nn = ng * 64 + cc;
      mods[(size_t)(l * 9 + r) * 6144 + nn] = s + p.b_mod[l * 6144 + nn];
    }
    __syncthreads();
  }
}

__device__ __forceinline__ void phase_hid2(const P& p, float* HID2, float* sm) {
  float* ft = sm;
  float* h1s = sm + 8 * 36;
  const int tid = otid();
  for (int it = blockIdx.x; it < 2 * 544; it += gridDim.x) {
    int j = it / 544, rg = it % 544;
    int row0 = rg * 8;
    if (tid < 8 * 33) {
      int r = tid / 33, f = tid % 33;
      int row = row0 + r;
      int L = row < 4096 ? 4096 : 256;
      int lag = row < 4096 ? row : row - 4096;
      float val;
      if (f == 0) val = (float)lag / (float)(L - 1);
      else {
        int bi = (f - 1) & 15;
        float band = 1e-4f + (float)bi * ((15.f - 1e-4f) / 15.f);
        float ang = (6.283185307179586f / (float)L) * (float)lag * band;
        val = (f <= 16) ? cosf(ang) : -sinf(ang);
      }
      ft[r * 36 + f] = val;
    }
    __syncthreads();
    int rl = tid >> 6, u = tid & 63;
    float fr = p.hy_freq[j * 64 + u];
    float h1 = p.hy_b1[j * 64 + u];
    for (int f = 0; f < 33; ++f) h1 += ft[rl * 36 + f] * p.hy_w1[(j * 33 + f) * 64 + u];
    h1 = sinf(fr * h1);
    h1s[rl * 64 + u] = h1;
    __syncthreads();
    float h2 = p.hy_b2[j * 64 + u];
    for (int v = 0; v < 64; ++v) h2 += h1s[rl * 64 + v] * p.hy_w2[(j * 64 + v) * 64 + u];
    h2 = sinf(fr * h2);
    HID2[((size_t)j * 4352 + row0 + rl) * 64 + u] = h2;
    __syncthreads();
  }
}

__device__ __forceinline__ void phase_filtgen(const P& p, int j, const float* HID2, u16* FILT, float* SUMSQ, float* sm) {
  float* hs = sm;
  const int tid = otid();
  for (int it = blockIdx.x; it < 272; it += gridDim.x) {
    int lc, lt, ct;
    if (it < 256) { lc = 0; lt = it >> 2; ct = it & 3; }
    else { lc = 1; lt = (it - 256) >> 2; ct = it & 3; }
    const int L = lc ? 256 : 4096;
    const int lag0 = lt * 64;
    const int rowbase = lc ? 4096 : 0;
    for (int e = tid; e < 4096; e += NTHR) hs[e] = HID2[((size_t)j * 4352 + rowbase + lag0) * 64 + e];
    __syncthreads();
    const int col = ct * 512 + tid;
    const int order = col >> 10, dir = (col >> 9) & 1, ch = col & 511;
    float w3c[64];
#pragma unroll
    for (int u = 0; u < 64; ++u) w3c[u] = p.hy_w3[((size_t)j * 64 + u) * 2048 + col];
    const float delta = 3.0701134573253947f + (float)ch * (12.280453829301577f / 511.f);
    u16* fdst = FILT + (lc ? (size_t)2 * 512 * 8192 : 0) + (size_t)(order * 512 + ch) * (2 * L);
    float ss = 0.f;
    for (int ll = 0; ll < 64; ++ll) {
      float raw = 0.f;
#pragma unroll
      for (int u = 0; u < 64; ++u) raw += hs[ll * 64 + u] * w3c[u];
      int lag = lag0 + ll;
      float tn = (float)lag / (float)(L - 1);
      float val = raw * __expf(-tn * delta);
      if (dir == 0) { ss += val * val; fdst[L - lag] = f2bf(val); }
      else if (lag > 0) { ss += val * val; fdst[L + lag] = f2bf(val); }
    }
    atomicAdd(&SUMSQ[((j * 2 + lc) * 2 + order) * 512 + ch], ss);
    __syncthreads();
  }
}

__device__ __forceinline__ void conv_wt(const float* __restrict__ src, int ld, int K, int N, u16* __restrict__ dst, int ldd,
                                        const float* __restrict__ scale, float* sm, bool g_conv_upper = false) {
  const int tid = otid();
  const int KT = K >> 6;
  const int nt_total = KT * (N >> 6);
  const int half = gridDim.x >> 1;
  const int t0 = g_conv_upper ? (int)blockIdx.x - half : (int)blockIdx.x;
  const int tstep = g_conv_upper ? half : (int)gridDim.x;
  if (t0 < 0) return;
  for (int t = t0; t < nt_total; t += tstep) {
    int kt = t % KT, nt = t / KT;
    for (int e = tid; e < 4096; e += NTHR) {
      int kk = e >> 6, nn = e & 63;
      float v = src[(size_t)(kt * 64 + kk) * ld + nt * 64 + nn];
      if (scale) v *= scale[kt * 64 + kk];
      sm[kk * 65 + nn] = v;
    }
    __syncthreads();
    for (int e = tid; e < 4096; e += NTHR) {
      int nn = e >> 6, kk = e & 63;
      dst[(size_t)(nt * 64 + nn) * ldd + kt * 64 + kk] = f2bf(sm[kk * 65 + nn]);
    }
    __syncthreads();
  }
}

__device__ __forceinline__ void conv_mix_weights(const P& p, int l, char* ws, float* sm, bool up = false) {
  u16* WIN = (u16*)(ws + OFF_WIN);
  u16* WOUT = (u16*)(ws + OFF_WOUT);
  const int j = l >> 1;
  if ((l & 1) == 0) {
    conv_wt(p.ab_w_in + (size_t)j * 1024 * 2560, 2560, 1024, 2560, WIN, 1024, nullptr, sm, up);
  } else {
    conv_wt(p.cd_w_in + (size_t)j * 1024 * 3584, 3584, 1024, 3584, WIN, 1024, nullptr, sm, up);
    for (int d = 0; d < 2; ++d) {
      const float* w1 = p.rw_w1 + (size_t)(j * 2 + d) * 1024 * 64;
      const float* a1 = p.rw_a1 + (size_t)(j * 2 + d) * 1024 * 64;
      u16* base = WIN + (size_t)(3584 + d * 256) * 1024;
      conv_wt(w1, 64, 1024, 64, base, 1024, nullptr, sm, up);
      conv_wt(w1, 64, 1024, 64, base + 64 * 1024, 1024, p.rw_mu_x + (size_t)(j * 2 + 0) * 1024, sm, up);
      conv_wt(a1, 64, 1024, 64, base + 128 * 1024, 1024, nullptr, sm, up);
      conv_wt(a1, 64, 1024, 64, base + 192 * 1024, 1024, p.rw_mu_x + (size_t)(j * 2 + 1) * 1024, sm, up);
    }
  }
  conv_wt(p.w_out + (size_t)l * 1024 * 1024, 1024, 1024, 1024, WOUT, 1024, nullptr, sm, up);
}
__device__ __forceinline__ void conv_mlp_weights(const P& p, int l, char* ws, float* sm, bool up = false) {
  conv_wt(p.mlp_w1 + (size_t)l * 1024 * 4096, 4096, 1024, 4096, (u16*)(ws + OFF_W1T), 1024, nullptr, sm, up);
  conv_wt(p.mlp_w2 + (size_t)l * 4096 * 1024, 1024, 4096, 1024, (u16*)(ws + OFF_W2T), 4096, nullptr, sm, up);
}

#define LSTR 64
#define GSTAGE (512 * LSTR)
template <int EPI, int MI>
__device__ __forceinline__ void gemm_part(const u16* __restrict__ A, int lda, const u16* __restrict__ Bt, int K, int N,
                                          u16* __restrict__ C, int ldc, int flag, u16* __restrict__ UT, float* __restrict__ X,
                                          const float* __restrict__ gate, char* smem, int n_items, int tbase) {
  constexpr bool SWAP = (EPI != 1);
  u16* Ls = (u16*)smem;
  const int tid = otid(), wid = tid >> 6, lane = tid & 63, wr = wid >> 1, wc = wid & 1, fr = lane & 15, fq = lane >> 4;
  const int NT = N >> 8, ntiles = n_items, nk = K >> 6;
  const int crow = tid >> 3, ccol = (tid & 7) * 8;
  const int wsw = ((tid & 7) ^ ((crow >> 1) & 7)) * 8;
  const int rsw0 = ((fq) ^ ((fr >> 1) & 7)) * 8, rsw1 = ((4 + fq) ^ ((fr >> 1) & 7)) * 8;
  uint4 ra0, ra1, ra2, ra3, rb0, rb1, rb2, rb3;
  const size_t a64 = (size_t)64 * lda, b64 = (size_t)64 * K;
  const u16* Ap = A;
  const u16* Bp = Bt;
#define GLOAD_A(KS)                                                                          \
  {                                                                                          \
    const int ko_ = min((KS), nk - 1) << 6;                                                  \
    ra0 = *(const uint4*)(Ap + ko_); ra1 = *(const uint4*)(Ap + a64 + ko_);                  \
    if (MI == 4) { ra2 = *(const uint4*)(Ap + 2 * a64 + ko_); ra3 = *(const uint4*)(Ap + 3 * a64 + ko_); } \
  }
#define GLOAD_B(KS)                                                                          \
  {                                                                                          \
    const int ko_ = min((KS), nk - 1) << 6;                                                  \
    rb0 = *(const uint4*)(Bp + ko_); rb1 = *(const uint4*)(Bp + b64 + ko_);                  \
    rb2 = *(const uint4*)(Bp + 2 * b64 + ko_); rb3 = *(const uint4*)(Bp + 3 * b64 + ko_);    \
  }
#define LWRITE_A(STG)                                                                                       \
  {                                                                                                         \
    *(uint4*)(wA + (STG) * GSTAGE) = ra0; *(uint4*)(wA + (STG) * GSTAGE + 64 * LSTR) = ra1;                 \
    if (MI == 4) { *(uint4*)(wA + (STG) * GSTAGE + 128 * LSTR) = ra2; *(uint4*)(wA + (STG) * GSTAGE + 192 * LSTR) = ra3; } \
  }
#define LWRITE_B(STG)                                                                                       \
  {                                                                                                         \
    *(uint4*)(wB + (STG) * GSTAGE) = rb0; *(uint4*)(wB + (STG) * GSTAGE + 64 * LSTR) = rb1;                 \
    *(uint4*)(wB + (STG) * GSTAGE + 128 * LSTR) = rb2; *(uint4*)(wB + (STG) * GSTAGE + 192 * LSTR) = rb3;   \
  }
#define GLOAD(KS) GLOAD_A(KS) GLOAD_B(KS)
#define LWRITE(STG) LWRITE_A(STG) LWRITE_B(STG)
#define TILE_REMAP(T) (((T) < nfull) ? (((T) & ~255) + (((T) & 7) << 5) + (((T) & 255) >> 3)) : (T))
#define ITEM_TILE(T) ((MI == 4) ? TILE_REMAP((EPI == 2 && K == 4096) ? (n_items - 1 - (T)) : (T)) : (tbase + ((T) >> 1)))
#define ITEM_MOFF(T) ((MI == 4) ? 0 : (((T) & 1) << 7))
#define GTILE_PTRS(T)                                                   \
  {                                                                     \
    const int tr_ = ITEM_TILE(T);                                       \
    const int mt_ = tr_ / NT, nt_ = tr_ - mt_ * NT;                     \
    Ap = A + (size_t)((mt_ << 8) + ITEM_MOFF(T) + crow) * lda + ccol;   \
    Bp = Bt + (size_t)((nt_ << 8) + crow) * K + ccol;                   \
  }
  u16* wA = Ls + crow * LSTR + wsw;
  u16* wB = Ls + (256 + crow) * LSTR + wsw;
  const u16* rA = Ls + (wr * 16 * MI + fr) * LSTR;
  const u16* rB = Ls + (256 + wc * 128 + fr) * LSTR;
  const int nfull = (MI == 4 && gridDim.x == 256) ? (ntiles & ~255) : 0;
  int tile = blockIdx.x;
  if (tile < ntiles) {
    GTILE_PTRS(tile)
    GLOAD(0)
  }
  while (tile < ntiles) {
    const int trm = ITEM_TILE(tile);
    const int mt = trm / NT, nt = trm - mt * NT;
    const int m0 = (mt << 8) + ITEM_MOFF(tile), n0 = nt << 8;
    f32x4 acc[MI][8];
#pragma unroll
    for (int i = 0; i < MI; ++i)
#pragma unroll
      for (int k = 0; k < 8; ++k) acc[i][k] = f32x4{0.f, 0.f, 0.f, 0.f};
    LWRITE(0)
    __builtin_amdgcn_sched_barrier(0);
    GLOAD(1)
    __builtin_amdgcn_sched_barrier(0);
    asm volatile("s_waitcnt lgkmcnt(0)\n\ts_barrier" ::: "memory");
#define GEMM_MMA_H(STG, AF, RS, H)                                                                                  \
  {                                                                                                                 \
    bf16x8 b[2];                                                                                                    \
    _Pragma("unroll") for (int i = 0; i < 2; ++i) b[i] = *(const bf16x8*)(rB + (STG) * GSTAGE + ((H) * 2 + i) * 16 * LSTR + (RS)); \
    _Pragma("unroll") for (int mi = 0; mi < MI; ++mi) _Pragma("unroll") for (int ni = 0; ni < 2; ++ni) {            \
      if (SWAP) acc[mi][(H) * 2 + ni] = __builtin_amdgcn_mfma_f32_16x16x32_bf16(b[ni], AF[mi], acc[mi][(H) * 2 + ni], 0, 0, 0); \
      else acc[mi][(H) * 2 + ni] = __builtin_amdgcn_mfma_f32_16x16x32_bf16(AF[mi], b[ni], acc[mi][(H) * 2 + ni], 0, 0, 0);      \
    }                                                                                                               \
  }
#define GEMM_LOAD_A0(STG) \
  _Pragma("unroll") for (int i = 0; i < MI / 2; ++i) a0[i] = *(const bf16x8*)(rA + (STG) * GSTAGE + i * 16 * LSTR + rsw0);
#define GEMM_LOAD_A0B(STG) \
  _Pragma("unroll") for (int i = MI / 2; i < MI; ++i) a0[i] = *(const bf16x8*)(rA + (STG) * GSTAGE + i * 16 * LSTR + rsw0);
#define GSTEP(STG, KS)                                                      \
  {                                                                         \
      \
    GEMM_LOAD_A0B(STG)                                                      \
    __builtin_amdgcn_sched_barrier(0);                                      \
    LWRITE_A((STG) ^ 1)                                                     \
    __builtin_amdgcn_sched_barrier(0);                                      \
    GLOAD_A((KS) + 2)                                                       \
    __builtin_amdgcn_sched_barrier(0);                                      \
    GEMM_MMA_H(STG, a0, rsw0, 0)                                            \
    GEMM_MMA_H(STG, a0, rsw0, 1)                                            \
    GEMM_MMA_H(STG, a0, rsw0, 2)                                            \
    GEMM_MMA_H(STG, a0, rsw0, 3)                                            \
    LWRITE_B((STG) ^ 1)                                                     \
    __builtin_amdgcn_sched_barrier(0);                                      \
    GLOAD_B((KS) + 2)                                                       \
    __builtin_amdgcn_sched_barrier(0);                                      \
    _Pragma("unroll") for (int i = 0; i < MI; ++i) a1[i] = *(const bf16x8*)(rA + (STG) * GSTAGE + i * 16 * LSTR + rsw1); \
    GEMM_MMA_H(STG, a1, rsw1, 0)                                            \
    GEMM_MMA_H(STG, a1, rsw1, 1)                                            \
    GEMM_MMA_H(STG, a1, rsw1, 2)                                            \
    _Pragma("unroll") for (int i = 0; i < 2; ++i) b3[i] = *(const bf16x8*)(rB + (STG) * GSTAGE + (6 + i) * 16 * LSTR + rsw1); \
    __builtin_amdgcn_sched_barrier(0);                                      \
    asm volatile("s_waitcnt lgkmcnt(0)\n\ts_barrier" ::: "memory");         \
    GEMM_LOAD_A0((STG) ^ 1)                                                 \
    __builtin_amdgcn_sched_barrier(0);                                      \
    GEMM_MMA_HP(STG, a1, b3, 3)                                             \
  }
#define GEMM_MMA_HP(STG, AF, BF, H)                                                                                 \
  {                                                                                                                 \
    _Pragma("unroll") for (int mi = 0; mi < MI; ++mi) _Pragma("unroll") for (int ni = 0; ni < 2; ++ni) {            \
      if (SWAP) acc[mi][(H) * 2 + ni] = __builtin_amdgcn_mfma_f32_16x16x32_bf16(BF[ni], AF[mi], acc[mi][(H) * 2 + ni], 0, 0, 0); \
      else acc[mi][(H) * 2 + ni] = __builtin_amdgcn_mfma_f32_16x16x32_bf16(AF[mi], BF[ni], acc[mi][(H) * 2 + ni], 0, 0, 0);      \
    }                                                                                                               \
  }
    bf16x8 a0[MI], a1[MI], b3[2];
    GEMM_LOAD_A0(0)
    for (int kt = 0; kt < nk; kt += 2) {
      GSTEP(0, kt)
      GSTEP(1, kt + 1)
    }
#undef GSTEP
#undef GEMM_MMA_H
#undef GEMM_MMA_HP
#undef GEMM_LOAD_A0
#undef GEMM_LOAD_A0B
    const int tile_next = tile + gridDim.x;
    if (tile_next < ntiles) {
      GTILE_PTRS(tile_next)
      GLOAD(0)
    }
    __builtin_amdgcn_sched_barrier(0);
#pragma unroll
    for (int mi = 0; mi < MI; ++mi) {
#pragma unroll
      for (int ni = 0; ni < 8; ++ni) {
        if (EPI == 0) {
          const int m = m0 + wr * 16 * MI + mi * 16 + fr;
          const int n4 = n0 + wc * 128 + ni * 16 + fq * 4;
          float v0 = acc[mi][ni][0], v1 = acc[mi][ni][1], v2 = acc[mi][ni][2], v3 = acc[mi][ni][3];
          if (flag) {
            v0 = fmaxf(v0, 0.f); v0 *= v0; v1 = fmaxf(v1, 0.f); v1 *= v1;
            v2 = fmaxf(v2, 0.f); v2 *= v2; v3 = fmaxf(v3, 0.f); v3 *= v3;
          }
          uint2 pk;
          pk.x = pack2(v0, v1);
          pk.y = pack2(v2, v3);
          *(uint2*)(C + (size_t)m * ldc + n4) = pk;
        } else if (EPI == 1) {
          const int mb = m0 + wr * 16 * MI + mi * 16 + fq * 4;
          const int n = n0 + wc * 128 + ni * 16 + fr;
          if (n0 < 1536) {
            uint2 pk;
            pk.x = pack2(acc[mi][ni][0], acc[mi][ni][1]);
            pk.y = pack2(acc[mi][ni][2], acc[mi][ni][3]);
            *(uint2*)(UT + (size_t)n * MTOK + mb) = pk;
          } else {
#pragma unroll
            for (int r = 0; r < 4; ++r) C[(size_t)(mb + r) * 2560 + (n - 1536)] = f2bf(acc[mi][ni][r]);
          }
        } else {
          const int m = m0 + wr * 16 * MI + mi * 16 + fr;
          const int n4 = n0 + wc * 128 + ni * 16 + fq * 4;
          const int rm = flag ? perm_row(m) : m;
          float4* xp = (float4*)(X + (size_t)rm * 1024 + n4);
          const float4 g4 = *(const float4*)(gate + (size_t)mods_row(m) * 6144 + n4);
          float4 xv = *xp;
          xv.x = ALPHA * xv.x + g4.x * acc[mi][ni][0];
          xv.y = ALPHA * xv.y + g4.y * acc[mi][ni][1];
          xv.z = ALPHA * xv.z + g4.z * acc[mi][ni][2];
          xv.w = ALPHA * xv.w + g4.w * acc[mi][ni][3];
          *xp = xv;
        }
      }
    }
    tile = tile_next;
  }
#undef GLOAD
#undef LWRITE
#undef GLOAD_A
#undef GLOAD_B
#undef LWRITE_A
#undef LWRITE_B
#undef GTILE_PTRS
#undef ITEM_TILE
#undef ITEM_MOFF
#undef TILE_REMAP
}

template <int EPI>
__device__ __forceinline__ void gemm_phase(const u16* __restrict__ A, int lda, const u16* __restrict__ Bt, int K, int N,
                                           u16* __restrict__ C, int ldc, int flag, u16* __restrict__ UT, float* __restrict__ X,
                                           const float* __restrict__ gate, char* smem) {
  const int ntiles = 160 * (N >> 8);
  const int rem = (gridDim.x == 256) ? (ntiles & 255) : 0;
  if (rem > 0 && rem <= 128) {
    gemm_part<EPI, 4>(A, lda, Bt, K, N, C, ldc, flag, UT, X, gate, smem, ntiles - rem, 0);
    gemm_part<EPI, 2>(A, lda, Bt, K, N, C, ldc, flag, UT, X, gate, smem, 2 * rem, ntiles - rem);
  } else {
    gemm_part<EPI, 4>(A, lda, Bt, K, N, C, ldc, flag, UT, X, gate, smem, ntiles, 0);
  }
}

__device__ __forceinline__ void phase_xinit(const P& p, float* X, const float* mods0, u16* H) {
  const int lane = otid() & 63;
  const int gw = blockIdx.x * 8 + (otid() >> 6);
  for (int m = gw; m < MTOK; m += gridDim.x * 8) {
    const float* src = m < MCTX ? p.x_prompt + (size_t)m * 1024 : p.x_sample + (size_t)(m - MCTX) * 1024;
    const float* md = mods0 + (size_t)mods_row(m) * 6144;
#pragma unroll
    for (int i = 0; i < 4; ++i) {
      int col = lane * 4 + i * 256;
      float4 v = *(const float4*)(src + col);
      *(float4*)(X + (size_t)m * 1024 + col) = v;
      float4 sh = *(const float4*)(md + col);
      float4 sc = *(const float4*)(md + 1024 + col);
      uint2 pk;
      pk.x = pack2(v.x * (1.f + sc.x) + sh.x, v.y * (1.f + sc.y) + sh.y);
      pk.y = pack2(v.z * (1.f + sc.z) + sh.z, v.w * (1.f + sc.w) + sh.w);
      *(uint2*)(H + (size_t)m * 1024 + col) = pk;
    }
  }
}

__device__ __forceinline__ void phase_ln(float* X, const float* g, const float* b, const float* modl, int sh_off, int sc_off,
                                         u16* H, int write_h, int permflag, int write_x = 1) {
  const int lane = otid() & 63;
  const int gw = blockIdx.x * 8 + (otid() >> 6);
  const int stride = gridDim.x * 8;
  float4 ggh[4], bbh[4];
#pragma unroll
  for (int i = 0; i < 4; ++i) {
    ggh[i] = *(const float4*)(g + lane * 4 + i * 256);
    bbh[i] = *(const float4*)(b + lane * 4 + i * 256);
  }
  for (int mb = gw; mb < MTOK; mb += 2 * stride) {
    float4 v[2][4];
#pragma unroll
    for (int r = 0; r < 2; ++r) {
      const int m = min(mb + r * stride, MTOK - 1);
#pragma unroll
      for (int i = 0; i < 4; ++i) v[r][i] = *(const float4*)(X + (size_t)m * 1024 + lane * 4 + i * 256);
    }
#pragma unroll
    for (int r = 0; r < 2; ++r) {
      const int m = mb + r * stride;
      if (m >= MTOK) break;
      float s = 0.f;
#pragma unroll
      for (int i = 0; i < 4; ++i) s += v[r][i].x + v[r][i].y + v[r][i].z + v[r][i].w;
      const float mean = wsum(s) * (1.f / 1024.f);
      float q = 0.f;
#pragma unroll
      for (int i = 0; i < 4; ++i) {
        v[r][i].x -= mean; v[r][i].y -= mean; v[r][i].z -= mean; v[r][i].w -= mean;
        q += v[r][i].x * v[r][i].x + v[r][i].y * v[r][i].y + v[r][i].z * v[r][i].z + v[r][i].w * v[r][i].w;
      }
      const float rstd = rsqrtf(wsum(q) * (1.f / 1024.f) + 1e-5f);
      const float* md = modl + (size_t)mods_row(m) * 6144;
      const int dst = permflag ? perm_row(m) : m;
#pragma unroll
      for (int i = 0; i < 4; ++i) {
        int col = lane * 4 + i * 256;
        const float4 gg = ggh[i];
        const float4 bb = bbh[i];
        float4 o;
        o.x = v[r][i].x * rstd * gg.x + bb.x; o.y = v[r][i].y * rstd * gg.y + bb.y;
        o.z = v[r][i].z * rstd * gg.z + bb.z; o.w = v[r][i].w * rstd * gg.w + bb.w;
        if (write_x) *(float4*)(X + (size_t)m * 1024 + col) = o;
        if (write_h) {
          float4 sh = *(const float4*)(md + sh_off + col);
          float4 sc = *(const float4*)(md + sc_off + col);
          uint2 pk;
          pk.x = pack2(o.x * (1.f + sc.x) + sh.x, o.y * (1.f + sc.y) + sh.y);
          pk.y = pack2(o.z * (1.f + sc.z) + sh.z, o.w * (1.f + sc.w) + sh.w);
          *(uint2*)(H + (size_t)dst * 1024 + col) = pk;
        }
      }
    }
  }
}

__device__ __forceinline__ void phase_lru_gates(const P& p, int j, const u16* __restrict__ proj, u32* __restrict__ PK, char* smem) {
  float* XCf = (float*)smem;
  float* cw = XCf + 4096;
  float* cb = cw + 256;
  float* bba = cb + 64;
  float* bbi = bba + 128;
  float* spl = bbi + 128;
  u16* XR = (u16*)(spl + 128);
  u16* XCb = XR + 68 * 64;
  u16* WT = XCb + 64 * 72;
  const int tid = otid();
  const int wave = tid >> 6, lane = tid & 63, fr = lane & 15, fq = lane >> 4;
  const int ptok = tid >> 3, c8 = (tid & 7) * 8;
  const int hd = blockIdx.x & 7;
  const int cstep = gridDim.x >> 3;
  for (int e = tid; e < 4 * 4096; e += NTHR) {
    const int mat = e >> 12, i = (e >> 6) & 63, jj = e & 63;
    const int d = mat >> 1;
    const float* src = (mat & 1) ? p.lru_wi : p.lru_wa;
    WT[(mat * 64 + jj) * 72 + i] = f2bf(src[((size_t)((j * 2 + d) * 8 + hd)) * 4096 + i * 64 + jj]);
  }
  if (tid < 256) cw[tid] = p.lru_conv[(j * 4 + (tid >> 6)) * 512 + hd * 64 + (tid & 63)];
  if (tid < 64) cb[tid] = p.lru_conv_b[j * 512 + hd * 64 + tid];
  if (tid < 128) {
    const int d = tid >> 6, ch = tid & 63;
    bba[tid] = p.lru_ba[(j * 2 + d) * 512 + hd * 64 + ch];
    bbi[tid] = p.lru_bi[(j * 2 + d) * 512 + hd * 64 + ch];
    spl[tid] = softplusf_(-p.lru_lambda[(j * 2 + d) * 512 + hd * 64 + ch]);
  }
  uint4 pmain, phalo;
#define LRUA_PREFETCH(CK)                                                                                   \
  {                                                                                                         \
    const int m0_ = (CK) * 64;                                                                              \
    const u16* base_ = proj + (size_t)m0_ * 2560 + 2048 + hd * 64 + c8;                                      \
    pmain = *(const uint4*)(base_ + (size_t)ptok * 2560);                                                    \
    phalo = make_uint4(0, 0, 0, 0);                                                                          \
    if (tid < 24 && m0_ < MCTX) {                                                                            \
      const int hr_ = tid >> 3;                                                                              \
      const int so_ = hr_ == 0 ? -2 : (hr_ == 1 ? -1 : 64);                                                  \
      const int sg_ = (m0_ & 255) + so_;                                                                     \
      if (sg_ >= 0 && sg_ < 256) phalo = *(const uint4*)(base_ + (long)so_ * 2560);                          \
    }                                                                                                        \
  }
  int ck = blockIdx.x >> 3;
  if (ck < 640) LRUA_PREFETCH(ck)
  __syncthreads();
  for (; ck < 640; ck += cstep) {
    const int m0 = ck * 64;
    *(uint4*)(XR + (ptok + 2) * 64 + c8) = pmain;
    if (tid < 24) {
      const int hr = tid >> 3;
      *(uint4*)(XR + (hr == 2 ? 66 : hr) * 64 + c8) = phalo;
    }
    if (ck + cstep < 640) LRUA_PREFETCH(ck + cstep)
    __syncthreads();
    {
      float xc[8];
#pragma unroll
      for (int q = 0; q < 8; ++q) xc[q] = cb[c8 + q];
#pragma unroll
      for (int k = 0; k < 4; ++k) {
        const uint4 rv = *(const uint4*)(XR + (ptok + k) * 64 + c8);
        const u32 w[4] = {rv.x, rv.y, rv.z, rv.w};
#pragma unroll
        for (int q = 0; q < 8; ++q) {
          const float xv = (q & 1) ? bfhi(w[q >> 1]) : bflo(w[q >> 1]);
          xc[q] += xv * cw[k * 64 + c8 + q];
        }
      }
      *(float4*)(XCf + ptok * 64 + c8) = make_float4(xc[0], xc[1], xc[2], xc[3]);
      *(float4*)(XCf + ptok * 64 + c8 + 4) = make_float4(xc[4], xc[5], xc[6], xc[7]);
      uint4 pk;
      pk.x = pack2(xc[0], xc[1]); pk.y = pack2(xc[2], xc[3]); pk.z = pack2(xc[4], xc[5]); pk.w = pack2(xc[6], xc[7]);
      *(uint4*)(XCb + ptok * 72 + c8) = pk;
    }
    __syncthreads();
    {
      const int tb = wave & 3, d = wave >> 2;
      const int tok = 16 * tb + fr;
      const u16* WA = WT + (size_t)(d * 2 + 0) * 64 * 72;
      const u16* WI = WT + (size_t)(d * 2 + 1) * 64 * 72;
      const bf16x8 xb0 = *(const bf16x8*)(XCb + (16 * tb + fr) * 72 + fq * 8);
      const bf16x8 xb1 = *(const bf16x8*)(XCb + (16 * tb + fr) * 72 + 32 + fq * 8);
#pragma unroll
      for (int cblk = 0; cblk < 4; ++cblk) {
        f32x4 accr = {0.f, 0.f, 0.f, 0.f}, acci = {0.f, 0.f, 0.f, 0.f};
        accr = __builtin_amdgcn_mfma_f32_16x16x32_bf16(*(const bf16x8*)(WA + (16 * cblk + fr) * 72 + fq * 8), xb0, accr, 0, 0, 0);
        accr = __builtin_amdgcn_mfma_f32_16x16x32_bf16(*(const bf16x8*)(WA + (16 * cblk + fr) * 72 + 32 + fq * 8), xb1, accr, 0, 0, 0);
        acci = __builtin_amdgcn_mfma_f32_16x16x32_bf16(*(const bf16x8*)(WI + (16 * cblk + fr) * 72 + fq * 8), xb0, acci, 0, 0, 0);
        acci = __builtin_amdgcn_mfma_f32_16x16x32_bf16(*(const bf16x8*)(WI + (16 * cblk + fr) * 72 + 32 + fq * 8), xb1, acci, 0, 0, 0);
        const int ch4 = 16 * cblk + 4 * fq;
        const float4 x4 = *(const float4*)(XCf + tok * 64 + ch4);
        const float xv[4] = {x4.x, x4.y, x4.z, x4.w};
        u32 pk[4];
#pragma unroll
        for (int r = 0; r < 4; ++r) {
          const int ch = ch4 + r;
          const float rg = sigmoidf_(accr[r] + bba[d * 64 + ch]);
          const float ig = sigmoidf_(acci[r] + bbi[d * 64 + ch]);
          const float la = -8.f * rg * spl[d * 64 + ch];
          const float u = __builtin_amdgcn_sqrtf(fmaxf(1.f - __expf(2.f * la), 0.f)) * ig * xv[r];
          pk[r] = (u32)f2bf(la) | ((u32)f2bf(u) << 16);
        }
        *(uint4*)(PK + ((size_t)(m0 + tok) * 2 + d) * 512 + hd * 64 + ch4) = make_uint4(pk[0], pk[1], pk[2], pk[3]);
      }
    }
  }
#undef LRUA_PREFETCH
  __syncthreads();
}

__device__ __forceinline__ void phase_lru_scan(const P& p, int j, u32* PK, float* out_lru, int* ctr, char* smem) {
  float* SEGA = (float*)smem;
  float* SEGU = SEGA + 512;
  float* HC = SEGU + 512;
  int* sitem = (int*)(HC + 64);
  const int tid = otid();
  const int ch = tid & 63, seg = tid >> 6;
  for (;;) {
    if (tid == 0) *sitem = atomicAdd(ctr, 1);
    __syncthreads();
    const int it = *sitem;
    __syncthreads();
    if (it >= 640) break;
    const int lat = it < 128;
    const int it2 = lat ? it : it - 128;
    const int b = it2 >> 4, hd = (it2 >> 1) & 7, d = it2 & 1;
    const int mbase = lat ? MCTX + b * 4096 : b * 256;
    const int Lseq = lat ? 4096 : 256;
    const int seglen = lat ? 64 : 32;
    const int nsc = Lseq / (8 * seglen);
    if (tid < 64) HC[tid] = lat ? p.state_lru[((size_t)(b * 2 + j) * 2 + d) * 512 + hd * 64 + tid] : 0.f;
    __syncthreads();
    float hlast = 0.f;
    for (int sc = 0; sc < nsc; ++sc) {
      const int p0 = (sc * 8 + seg) * seglen;
      u32 vals[64];
#pragma unroll
      for (int i = 0; i < 64; ++i) {
        const int pp = p0 + min(i, seglen - 1);
        const int sidx = d ? (Lseq - 1 - pp) : pp;
        vals[i] = PK[((size_t)(mbase + sidx) * 2 + d) * 512 + hd * 64 + ch];
      }
      float A = 1.f, U = 0.f;
#pragma unroll
      for (int i = 0; i < 64; ++i) {
        if (i < seglen) {
          const float a = __expf(bflo(vals[i]));
          U = a * U + bfhi(vals[i]);
          A *= a;
        }
      }
      SEGA[seg * 64 + ch] = A;
      SEGU[seg * 64 + ch] = U;
      __syncthreads();
      float h = HC[ch];
      for (int s2 = 0; s2 < seg; ++s2) h = SEGA[s2 * 64 + ch] * h + SEGU[s2 * 64 + ch];
#pragma unroll
      for (int i = 0; i < 64; ++i) {
        if (i < seglen) {
          const int pp = p0 + i;
          const int sidx = d ? (Lseq - 1 - pp) : pp;
          h = __expf(bflo(vals[i])) * h + bfhi(vals[i]);
          ((float*)PK)[((size_t)(mbase + sidx) * 2 + d) * 512 + hd * 64 + ch] = h;
        }
      }
      hlast = h;
      __syncthreads();
      if (seg == 7) HC[ch] = hlast;
      __syncthreads();
    }
    if (!lat && tid < 64) out_lru[((size_t)(b * 2 + j) * 2 + d) * 512 + hd * 64 + tid] = HC[tid];
    __syncthreads();
  }
}

__device__ __forceinline__ void phase_abmix(const P& p, int j, const u16* __restrict__ proj, const float* __restrict__ hfb,
                                            u16* __restrict__ mix) {
  const int c8h = ((blockIdx.x * NTHR + otid()) & 63) * 8;
  float cw0[8], cw1[8], cw2[8];
#pragma unroll
  for (int q = 0; q < 8; ++q) {
    cw0[q] = p.sc_conv[(j * 3 + 0) * 512 + c8h + q];
    cw1[q] = p.sc_conv[(j * 3 + 1) * 512 + c8h + q];
    cw2[q] = p.sc_conv[(j * 3 + 2) * 512 + c8h + q];
  }
  for (int e = blockIdx.x * NTHR + otid(); e < MTOK * 64; e += gridDim.x * NTHR) {
    const int m = e >> 6, c8 = c8h;
    const int line = m < MCTX ? 256 : 64;
    const int pos = m & (line - 1);
    const bool mL = pos > 0, mR = pos < line - 1;
    const u16* pr = proj + (size_t)m * 2560;
    uint4 sb = *(const uint4*)(pr + c8);
    uint4 sc0 = *(const uint4*)(pr + 512 + c8), sv0 = *(const uint4*)(pr + 1024 + c8);
    uint4 gg = *(const uint4*)(pr + 1536 + c8);
    uint4 z = make_uint4(0, 0, 0, 0);
    uint4 scl = mL ? *(const uint4*)(pr - 2560 + 512 + c8) : z, svl = mL ? *(const uint4*)(pr - 2560 + 1024 + c8) : z;
    uint4 scr = mR ? *(const uint4*)(pr + 2560 + 512 + c8) : z, svr = mR ? *(const uint4*)(pr + 2560 + 1024 + c8) : z;
    const u32* sbp = (const u32*)&sb; const u32* scp = (const u32*)&sc0; const u32* svp = (const u32*)&sv0;
    const u32* ggp = (const u32*)&gg; const u32* sclp = (const u32*)&scl; const u32* svlp = (const u32*)&svl;
    const u32* scrp = (const u32*)&scr; const u32* svrp = (const u32*)&svr;
    const float* hf = hfb + (size_t)m * 1024 + c8;
    float ya[8], yb[8];
#pragma unroll
    for (int q = 0; q < 8; ++q) {
      const int ch = c8 + q;
      const int w = q >> 1;
      const bool hi = q & 1;
      float s_b = hi ? bfhi(sbp[w]) : bflo(sbp[w]);
      float c1 = (hi ? bfhi(scp[w]) : bflo(scp[w])) * (hi ? bfhi(svp[w]) : bflo(svp[w]));
      float c0 = (hi ? bfhi(sclp[w]) : bflo(sclp[w])) * (hi ? bfhi(svlp[w]) : bflo(svlp[w]));
      float c2 = (hi ? bfhi(scrp[w]) : bflo(scrp[w])) * (hi ? bfhi(svrp[w]) : bflo(svrp[w]));
      ya[q] = s_b * (c0 * cw0[q] + c1 * cw1[q] + c2 * cw2[q]);
      float g = hi ? bfhi(ggp[w]) : bflo(ggp[w]);
      float ge = 0.5f * g * (1.f + tanhf_(0.7978845608028654f * (g + 0.044715f * g * g * g)));
      yb[q] = ge * (hf[q] + hf[512 + q]);
    }
    uint4 oa, ob;
    oa.x = pack2(ya[0], ya[1]); oa.y = pack2(ya[2], ya[3]); oa.z = pack2(ya[4], ya[5]); oa.w = pack2(ya[6], ya[7]);
    ob.x = pack2(yb[0], yb[1]); ob.y = pack2(yb[2], yb[3]); ob.z = pack2(yb[4], yb[5]); ob.w = pack2(yb[6], yb[7]);
    *(uint4*)(mix + (size_t)m * 1024 + c8) = oa;
    *(uint4*)(mix + (size_t)m * 1024 + 512 + c8) = ob;
  }
}

__device__ __forceinline__ float sum8(float v) {
  v += dpp_mov<0xB1>(v);
  v += dpp_mov<0x4E>(v);
  v += dpp_mov<0x141>(v);
  return v;
}
#define RSTR 72
__device__ __forceinline__ void rwkv_item(const P& p, int j, int it, const u16* __restrict__ prw, u16* __restrict__ obuf,
                                          float* __restrict__ bonus, float* out_rwkv, char* smem) {
  float* BUF = (float*)smem;
  float* OBB = BUF + 12288;
  float* SSB = OBB + 2048;
  float* mur = SSB + 32;
  float* muk = mur + 64;
  float* muv = muk + 64;
  float* kkp = muv + 64;
  float* kap = kkp + 64;
  float* rkp = kap + 64;
  float* w0p = rkp + 64;
  float* a0p = w0p + 64;
  u16* TWb = (u16*)(a0p + 64);
  u16* LAb = TWb + 16 * RSTR;
  u16* W2T = LAb + 16 * RSTR;
  u16* A2T = W2T + 64 * RSTR;
  const int tid = otid();
  const int lat = it < 256;
  const int it2 = lat ? it : it - 256;
  const int b = it2 >> 5, hd = (it2 >> 2) & 7, d = (it2 >> 1) & 1, half = it2 & 1;
  const int mbase = lat ? MCTX + b * 4096 : b * 256;
  const int Lseq = lat ? 4096 : 256;
  const int line = lat ? 64 : 256;
  const int nchunk = Lseq >> 4;
  for (int e = tid; e < 4096; e += NTHR) {
    int u = e >> 6, ch = e & 63;
    W2T[ch * RSTR + u] = f2bf(p.rw_w2[((size_t)(j * 2 + d) * 64 + u) * 512 + hd * 64 + ch]);
    A2T[ch * RSTR + u] = f2bf(p.rw_a2[((size_t)(j * 2 + d) * 64 + u) * 512 + hd * 64 + ch]);
  }
  if (tid < 64) {
    int cidx = hd * 64 + tid;
    mur[tid] = p.rw_mu[(j * 4 + 0) * 512 + cidx];
    muk[tid] = p.rw_mu[(j * 4 + 1) * 512 + cidx];
    muv[tid] = p.rw_mu[(j * 4 + 2) * 512 + cidx];
    kkp[tid] = p.rw_kk[j * 512 + cidx];
    kap[tid] = p.rw_ka[j * 512 + cidx];
    rkp[tid] = p.rw_rk[(j * 8 + hd) * 64 + tid];
    w0p[tid] = p.rw_w0[(j * 2 + d) * 512 + cidx];
    a0p[tid] = p.rw_a0[(j * 2 + d) * 512 + cidx];
  }
  const bool isprep = tid >= 256;
  const int pt = tid & 255;
  const int sq = pt & 7, srow = half * 32 + (pt >> 3);
  float S0[8];
  {
    const float* s0p = p.state_rwkv + ((((size_t)(b * 2 + j) * 2 + d) * 8 + hd) * 64 + srow) * 64 + sq * 8;
#pragma unroll
    for (int e = 0; e < 8; ++e) S0[e] = (lat && !isprep) ? s0p[e] : 0.f;
  }
  const int ptok = pt >> 4, c4 = (pt & 15) * 4;
  const int lane = tid & 63, fr = lane & 15, fq = lane >> 4, pw = (tid >> 6) & 3;
  uint2 pf[17];
#define RW_PREFETCH(S0_)                                                                   \
  {                                                                                        \
    const int s_ = (S0_) + ptok;                                                           \
    const int pos_ = s_ & (line - 1);                                                      \
    const u16* pr_ = prw + (size_t)(mbase + s_) * 2560;                                    \
    const u16* pl_ = pos_ > 0 ? pr_ - 2560 : pr_;                                          \
    const u16* pq_ = pos_ < line - 1 ? pr_ + 2560 : pr_;                                   \
    const int cr_ = hd * 64 + c4, cl_ = 2048 + d * 256 + c4;                               \
    pf[0] = *(const uint2*)(pr_ + cr_); pf[1] = *(const uint2*)(pl_ + cr_); pf[2] = *(const uint2*)(pq_ + cr_);                      \
    pf[3] = *(const uint2*)(pr_ + cr_ + 512); pf[4] = *(const uint2*)(pl_ + cr_ + 512); pf[5] = *(const uint2*)(pq_ + cr_ + 512);    \
    pf[6] = *(const uint2*)(pr_ + cr_ + 1024); pf[7] = *(const uint2*)(pl_ + cr_ + 1024); pf[8] = *(const uint2*)(pq_ + cr_ + 1024); \
    pf[9] = *(const uint2*)(pr_ + cl_);                                                                                             \
    pf[10] = *(const uint2*)(pr_ + cl_ + 64); pf[11] = *(const uint2*)(pl_ + cl_ + 64); pf[12] = *(const uint2*)(pq_ + cl_ + 64);    \
    pf[13] = *(const uint2*)(pr_ + cl_ + 128);                                                                                      \
    pf[14] = *(const uint2*)(pr_ + cl_ + 192); pf[15] = *(const uint2*)(pl_ + cl_ + 192); pf[16] = *(const uint2*)(pq_ + cl_ + 192); \
  }
#define RW_CHUNK_S0(I) ((d ? nchunk - 1 - (I) : (I)) << 4)
#pragma unroll
  for (int q = 0; q < 17; ++q) pf[q] = make_uint2(0, 0);
  if (isprep) RW_PREFETCH(RW_CHUNK_S0(0))
  __syncthreads();
  float kv4[4] = {0.f, 0.f, 0.f, 0.f}, a4[4] = {0.f, 0.f, 0.f, 0.f};
#define RW_DECL(X) float4 k0##X, k1##X, w0##X, w1##X, b0##X, b1##X, d0##X, d1##X, r0##X, r1##X; float vv##X;
#define RW_LOAD(X, TT)                                                                     \
  {                                                                                        \
    const int tk_ = d ? 15 - (TT) : (TT);                                                  \
    const int o8_ = tk_ * 64 + sq * 8;                                                     \
    k0##X = *(const float4*)(sb + 3072 + o8_); k1##X = *(const float4*)(sb + 3072 + o8_ + 4);   \
    w0##X = *(const float4*)(sb + 4096 + o8_); w1##X = *(const float4*)(sb + 4096 + o8_ + 4);   \
    b0##X = *(const float4*)(sb + 5120 + o8_); b1##X = *(const float4*)(sb + 5120 + o8_ + 4);   \
    d0##X = *(const float4*)(sb + 1024 + o8_); d1##X = *(const float4*)(sb + 1024 + o8_ + 4);   \
    r0##X = *(const float4*)(sb + o8_); r1##X = *(const float4*)(sb + o8_ + 4);                 \
    vv##X = sb[2048 + tk_ * 64 + srow];                                                          \
  }
#define RW_STEP(X, TT)                                                                                                      \
  {                                                                                                                         \
    const int tk_ = d ? 15 - (TT) : (TT);                                                                                   \
    float sa0 = (S0[0] * k0##X.x + S0[1] * k0##X.y) + (S0[2] * k0##X.z + S0[3] * k0##X.w) + (S0[4] * k1##X.x + S0[5] * k1##X.y) + \
                (S0[6] * k1##X.z + S0[7] * k1##X.w);                                                                        \
    sa0 = sum8(sa0);                                                                                                        \
    S0[0] = S0[0] * w0##X.x - sa0 * b0##X.x + vv##X * d0##X.x; S0[1] = S0[1] * w0##X.y - sa0 * b0##X.y + vv##X * d0##X.y;   \
    S0[2] = S0[2] * w0##X.z - sa0 * b0##X.z + vv##X * d0##X.z; S0[3] = S0[3] * w0##X.w - sa0 * b0##X.w + vv##X * d0##X.w;   \
    S0[4] = S0[4] * w1##X.x - sa0 * b1##X.x + vv##X * d1##X.x; S0[5] = S0[5] * w1##X.y - sa0 * b1##X.y + vv##X * d1##X.y;   \
    S0[6] = S0[6] * w1##X.z - sa0 * b1##X.z + vv##X * d1##X.z; S0[7] = S0[7] * w1##X.w - sa0 * b1##X.w + vv##X * d1##X.w;   \
    float o0 = (S0[0] * r0##X.x + S0[1] * r0##X.y) + (S0[2] * r0##X.z + S0[3] * r0##X.w) + (S0[4] * r1##X.x + S0[5] * r1##X.y) + \
               (S0[6] * r1##X.z + S0[7] * r1##X.w);                                                                         \
    o0 = sum8(o0);                                                                                                          \
    if (sq == 0) ob[tk_ * 64 + srow] = o0;                                                                                  \
  }
#define RW_RUN(T0, T1)                                          \
  {                                                             \
    RW_LOAD(A, T0)                                              \
    _Pragma("unroll") for (int tt = (T0); tt < (T1); tt += 2) { \
      RW_LOAD(B, min(tt + 1, 15))                               \
      __builtin_amdgcn_sched_barrier(0);                        \
      RW_STEP(A, tt)                                            \
      RW_LOAD(A, min(tt + 2, 15))                               \
      __builtin_amdgcn_sched_barrier(0);                        \
      if (tt + 1 < (T1)) RW_STEP(B, tt + 1)                     \
    }                                                           \
  }
  RW_DECL(A) RW_DECL(B)
  for (int i = 0; i <= nchunk + 1; ++i) {
    const bool doprep = isprep && (i < nchunk);
    const bool doscan = (!isprep) && (i >= 1) && (i <= nchunk);
    float* pbuf = BUF + (i & 1) * 6144;
    const float* sb = BUF + ((i - 1) & 1) * 6144;
    float* ob = OBB + ((i - 1) & 1) * 1024;
    const int s0 = RW_CHUNK_S0(i);
    if (isprep) {
      if (i >= 2) {
        const int c2 = half * 32 + (pt & 15) * 2;
        const float2 o2 = *(const float2*)(OBB + (i & 1) * 1024 + ptok * 64 + c2);
        *(u32*)(obuf + ((size_t)(mbase + RW_CHUNK_S0(i - 2) + ptok) * 2 + d) * 512 + hd * 64 + c2) = pack2(o2.x, o2.y);
      }
      if (doprep) {
        const int pos = (s0 + ptok) & (line - 1);
        const float mL = pos > 0 ? 0.5f : 0.f, mR = pos < line - 1 ? 0.5f : 0.f;
        float rm[4], km[4], vm[4], tw[4], la[4];
#pragma unroll
        for (int q = 0; q < 4; ++q) {
          const int ch = c4 + q;
#define PFV(ix) ((q & 1) ? bfhi((q >> 1) ? pf[ix].y : pf[ix].x) : bflo((q >> 1) ? pf[ix].y : pf[ix].x))
          float x0 = PFV(0), xl = PFV(1), xr = PFV(2);
          rm[q] = x0 + (mL * xl + mR * xr - x0) * mur[ch];
          x0 = PFV(3); xl = PFV(4); xr = PFV(5);
          km[q] = x0 + (mL * xl + mR * xr - x0) * muk[ch];
          x0 = PFV(6); xl = PFV(7); xr = PFV(8);
          vm[q] = x0 + (mL * xl + mR * xr - x0) * muv[ch];
          tw[q] = tanhf_(PFV(9) + mL * PFV(11) + mR * PFV(12) - PFV(10));
          la[q] = PFV(13) + mL * PFV(15) + mR * PFV(16) - PFV(14);
#undef PFV
        }
        *(float4*)(pbuf + ptok * 64 + c4) = make_float4(rm[0], rm[1], rm[2], rm[3]);
        *(float4*)(pbuf + 1024 + ptok * 64 + c4) = make_float4(km[0], km[1], km[2], km[3]);
        *(float4*)(pbuf + 2048 + ptok * 64 + c4) = make_float4(vm[0], vm[1], vm[2], vm[3]);
        uint2 t2, l2;
        t2.x = pack2(tw[0], tw[1]); t2.y = pack2(tw[2], tw[3]);
        l2.x = pack2(la[0], la[1]); l2.y = pack2(la[2], la[3]);
        *(uint2*)(TWb + ptok * RSTR + c4) = t2;
        *(uint2*)(LAb + ptok * RSTR + c4) = l2;
        if (pt < 32) SSB[pt] = 0.f;
        if (i + 1 < nchunk) RW_PREFETCH(RW_CHUNK_S0(i + 1))
      }
    } else if (doscan) {
      RW_RUN(0, 6)
    }
    __syncthreads();
    const int tok2 = fr, ch2 = 16 * pw + 4 * fq;
    if (isprep) {
      if (doprep) {
        f32x4 accw = {0.f, 0.f, 0.f, 0.f}, acca = {0.f, 0.f, 0.f, 0.f};
#pragma unroll
        for (int ks = 0; ks < 2; ++ks) {
          bf16x8 wa = *(const bf16x8*)(W2T + (16 * pw + fr) * RSTR + ks * 32 + fq * 8);
          bf16x8 tb8 = *(const bf16x8*)(TWb + fr * RSTR + ks * 32 + fq * 8);
          accw = __builtin_amdgcn_mfma_f32_16x16x32_bf16(wa, tb8, accw, 0, 0, 0);
          bf16x8 aa = *(const bf16x8*)(A2T + (16 * pw + fr) * RSTR + ks * 32 + fq * 8);
          bf16x8 lb8 = *(const bf16x8*)(LAb + fr * RSTR + ks * 32 + fq * 8);
          acca = __builtin_amdgcn_mfma_f32_16x16x32_bf16(aa, lb8, acca, 0, 0, 0);
        }
        const float4 km4 = *(const float4*)(pbuf + 1024 + tok2 * 64 + ch2);
        const float4 rm4 = *(const float4*)(pbuf + tok2 * 64 + ch2);
        const float kmv[4] = {km4.x, km4.y, km4.z, km4.w};
        const float rmv[4] = {rm4.x, rm4.y, rm4.z, rm4.w};
        float ss = 0.f, bon = 0.f;
        float dec[4], kd[4];
#pragma unroll
        for (int r = 0; r < 4; ++r) {
          const int ch = ch2 + r;
          float wraw = -softplusf_(-(w0p[ch] + accw[r])) - 0.5f;
          dec[r] = __expf(-__expf(wraw));
          float a = sigmoidf_(a0p[ch] + acca[r]);
          float kv = kmv[r] * kkp[ch];
          ss += kv * kv;
          kd[r] = kmv[r] * (1.f + (a - 1.f) * kap[ch]);
          bon += rmv[r] * kd[r] * rkp[ch];
          a4[r] = a;
          kv4[r] = kv;
        }
        *(float4*)(pbuf + 4096 + tok2 * 64 + ch2) = make_float4(dec[0], dec[1], dec[2], dec[3]);
        *(float4*)(pbuf + 1024 + tok2 * 64 + ch2) = make_float4(kd[0], kd[1], kd[2], kd[3]);
        ss += __shfl_xor(ss, 16); ss += __shfl_xor(ss, 32);
        bon += __shfl_xor(bon, 16); bon += __shfl_xor(bon, 32);
        if (fq == 0) { atomicAdd(&SSB[tok2], ss); atomicAdd(&SSB[16 + tok2], bon); }
      }
    } else if (doscan) {
      RW_RUN(6, 11)
    }
    __syncthreads();
    if (isprep) {
      if (doprep) {
        const float inv = rsqrtf(SSB[tok2] + 1e-12f);
        float kk[4];
#pragma unroll
        for (int r = 0; r < 4; ++r) kk[r] = kv4[r] * inv;
        *(float4*)(pbuf + 3072 + tok2 * 64 + ch2) = make_float4(kk[0], kk[1], kk[2], kk[3]);
        *(float4*)(pbuf + 5120 + tok2 * 64 + ch2) = make_float4(kk[0] * a4[0], kk[1] * a4[1], kk[2] * a4[2], kk[3] * a4[3]);
        if (half == 0 && pw == 0 && fq == 0) bonus[((size_t)(mbase + s0 + tok2) * 2 + d) * 8 + hd] = SSB[16 + tok2];
      }
    } else if (doscan) {
      RW_RUN(11, 16)
    }
    __syncthreads();
  }
#undef RW_PREFETCH
#undef RW_CHUNK_S0
#undef RW_DECL
#undef RW_LOAD
#undef RW_STEP
#undef RW_RUN
  if (!lat && !isprep) {
    float* dst = out_rwkv + ((((size_t)(b * 2 + j) * 2 + d) * 8 + hd) * 64 + srow) * 64 + sq * 8;
#pragma unroll
    for (int e = 0; e < 8; ++e) dst[e] = S0[e];
  }
  __syncthreads();
}

template <int GRP>
struct HyCfg {
  static constexpr int NB = GRP == 0 ? 8 : 32;
  static constexpr int NBLK = GRP == 0 ? 64 : 4;
  static constexpr int LSEQ = GRP == 0 ? 4096 : 256;
  static constexpr int NTW = GRP == 0 ? 4 : 1;
  static constexpr int MB = GRP == 0 ? MCTX : 0;
  static constexpr int LINE = GRP == 0 ? 64 : 256;
};

template <int GRP>
__device__ __forceinline__ void hyena_conv(const u16* ZS, const u16* FLB, f32x4 (&acc)[4][HyCfg<GRP>::NTW], int wave, int fr,
                                           int fq) {
  typedef HyCfg<GRP> Cf;
  constexpr int FLEN = 2 * Cf::LSEQ;
  const int colw0 = wave * Cf::NTW * 16;
  const int i_lo = colw0 / Cf::NB, i_hi = (colw0 + Cf::NTW * 16 - 1) / Cf::NB;
  const int o0 = Cf::LSEQ + 8 * fq - fr;
  const u16* fbase = (fr & 1) ? (FLB + FLEN + o0 - 1) : (FLB + o0);
#pragma unroll 1
  for (int d = -(Cf::NBLK - 1); d <= Cf::NBLK - 1; ++d) {
    if (i_hi - d < 0 || i_lo - d > Cf::NBLK - 1) continue;
    const u16* fd = fbase - 64 * d;
    bf16x8 f[6];
#pragma unroll
    for (int v = 0; v < 6; ++v) {
      const int off = (v < 4) ? (-16 * v) : (v == 4 ? 32 : 16);
      const u32* fp = (const u32*)(fd + off);
      uint4 t = make_uint4(fp[0], fp[1], fp[2], fp[3]);
      f[v] = *(bf16x8*)&t;
    }
#pragma unroll
    for (int nt = 0; nt < Cf::NTW; ++nt) {
      const int colg0 = colw0 + nt * 16;
      const int t_lo = colg0 / Cf::NB, t_hi = (colg0 + 15) / Cf::NB;
      if (t_hi - d < 0 || t_lo - d > Cf::NBLK - 1) continue;
      const int colg = colg0 + fr;
      const int i = colg / Cf::NB, b = colg % Cf::NB;
      const int k = i - d;
      const bool valid = (k >= 0) && (k < Cf::NBLK);
      uint4 t0 = make_uint4(0, 0, 0, 0), t1 = make_uint4(0, 0, 0, 0);
      if (valid) {
        t0 = *(const uint4*)(ZS + b * Cf::LSEQ + 64 * k + 8 * fq);
        t1 = *(const uint4*)(ZS + b * Cf::LSEQ + 64 * k + 32 + 8 * fq);
      }
      const bf16x8 b0 = *(bf16x8*)&t0, b1 = *(bf16x8*)&t1;
      acc[0][nt] = __builtin_amdgcn_mfma_f32_16x16x32_bf16(f[0], b0, acc[0][nt], 0, 0, 0);
      acc[1][nt] = __builtin_amdgcn_mfma_f32_16x16x32_bf16(f[1], b0, acc[1][nt], 0, 0, 0);
      acc[2][nt] = __builtin_amdgcn_mfma_f32_16x16x32_bf16(f[2], b0, acc[2][nt], 0, 0, 0);
      acc[3][nt] = __builtin_amdgcn_mfma_f32_16x16x32_bf16(f[3], b0, acc[3][nt], 0, 0, 0);
      acc[0][nt] = __builtin_amdgcn_mfma_f32_16x16x32_bf16(f[4], b1, acc[0][nt], 0, 0, 0);
      acc[1][nt] = __builtin_amdgcn_mfma_f32_16x16x32_bf16(f[5], b1, acc[1][nt], 0, 0, 0);
      acc[2][nt] = __builtin_amdgcn_mfma_f32_16x16x32_bf16(f[0], b1, acc[2][nt], 0, 0, 0);
      acc[3][nt] = __builtin_amdgcn_mfma_f32_16x16x32_bf16(f[1], b1, acc[3][nt], 0, 0, 0);
      if (nt & 1) asm volatile("" ::: "memory");
    }
  }
}

template <int FLEN>
__device__ __forceinline__ void hyena_load_filter(const u16* __restrict__ f, u16* FLB, int tid) {
  for (int e8 = tid; e8 < FLEN / 8; e8 += NTHR) {
    const uint4 v = *(const uint4*)(f + e8 * 8);
    const u32 nx = (e8 * 8 + 8 < FLEN) ? (u32)f[e8 * 8 + 8] : 0u;
    *(uint4*)(FLB + e8 * 8) = v;
    uint4 sft;
    sft.x = (v.x >> 16) | (v.y << 16);
    sft.y = (v.y >> 16) | (v.z << 16);
    sft.z = (v.z >> 16) | (v.w << 16);
    sft.w = (v.w >> 16) | (nx << 16);
    *(uint4*)(FLB + FLEN + e8 * 8) = sft;
  }
}

template <int GRP>
__device__ __forceinline__ void hyena_item(const P& p, int j, int c, u16* UT, u16* YO, const u16* FILT,
                                           const float* SUMSQ, char* smem) {
  typedef HyCfg<GRP> Cf;
  u16* ZS = (u16*)smem;
  u16* FLB = (u16*)(smem + 65536);
  constexpr int FLEN = 2 * Cf::LSEQ;
  const u16* filt0 = FILT + (GRP == 0 ? (size_t)0 : (size_t)2 * 512 * 8192);
  const int tid = otid(), wave = tid >> 6, lane = tid & 63, fr = lane & 15, fq = lane >> 4;
  const size_t MM = MTOK;
  {
    const float h0 = p.hy_conv[(j * 3 + 0) * 1536 + c], h1 = p.hy_conv[(j * 3 + 1) * 1536 + c], h2 = p.hy_conv[(j * 3 + 2) * 1536 + c];
    const u16* ur = UT + (size_t)c * MM + Cf::MB;
#pragma unroll 2
    for (int e8 = tid; e8 < Cf::NB * Cf::LSEQ / 8; e8 += NTHR) {
      const int e0 = e8 * 8;
      const int pos = e0 & (Cf::LINE - 1);
      const uint4 v = *(const uint4*)(ur + e0);
      const float xm = pos > 0 ? bf2f(ur[e0 - 1]) : 0.f;
      const float xp = pos + 8 < Cf::LINE ? bf2f(ur[e0 + 8]) : 0.f;
      const float x0 = bflo(v.x), x1 = bfhi(v.x), x2 = bflo(v.y), x3 = bfhi(v.y), x4 = bflo(v.z), x5 = bfhi(v.z), x6 = bflo(v.w),
                  x7 = bfhi(v.w);
      uint4 o;
      o.x = pack2(x0 * h1 + xm * h0 + x1 * h2, x1 * h1 + x0 * h0 + x2 * h2);
      o.y = pack2(x2 * h1 + x1 * h0 + x3 * h2, x3 * h1 + x2 * h0 + x4 * h2);
      o.z = pack2(x4 * h1 + x3 * h0 + x5 * h2, x5 * h1 + x4 * h0 + x6 * h2);
      o.w = pack2(x6 * h1 + x5 * h0 + x7 * h2, x7 * h1 + x6 * h0 + xp * h2);
      *(uint4*)(ZS + e0) = o;
    }
    hyena_load_filter<FLEN>(filt0 + (size_t)(0 * 512 + c) * FLEN, FLB, tid);
  }
  uint2 hxr[4][Cf::NTW];
#define HY_PREFETCH(UP)                                                                                      \
  _Pragma("unroll") for (int mb = 0; mb < 4; ++mb) _Pragma("unroll") for (int nt = 0; nt < Cf::NTW; ++nt) {   \
    const int colg = (wave * Cf::NTW + nt) * 16 + fr;                                                         \
    const int i = colg / Cf::NB, b = colg % Cf::NB;                                                           \
    const int t0 = 64 * i + 16 * mb + 4 * fq;                                                                 \
    const int e0 = b * Cf::LSEQ + t0;                                                                         \
    hxr[mb][nt] = *(const uint2*)((UP) + e0);                                                                 \
  }
#define HY_HALO(UP)                                                                                          \
  _Pragma("unroll") for (int mb = 0; mb < 4; ++mb) _Pragma("unroll") for (int nt = 0; nt < Cf::NTW; ++nt) {   \
    const int colg = (wave * Cf::NTW + nt) * 16 + fr;                                                         \
    const int i = colg / Cf::NB, b = colg % Cf::NB;                                                           \
    const int t0 = 64 * i + 16 * mb + 4 * fq;                                                                 \
    const int e0 = b * Cf::LSEQ + t0;                                                                         \
    const u32 lo_ = ((t0 & (Cf::LINE - 1)) > 0) ? (u32)(UP)[e0 - 1] : 0u;                                     \
    const u32 hi_ = (((t0 + 3) & (Cf::LINE - 1)) < Cf::LINE - 1) ? (u32)(UP)[e0 + 4] : 0u;                    \
    hxh[mb][nt] = lo_ | (hi_ << 16);                                                                          \
  }
  const u16* u1 = UT + (size_t)(512 + c) * MM + Cf::MB;
  HY_PREFETCH(u1)
  __syncthreads();
  f32x4 acc[4][Cf::NTW];
#pragma unroll
  for (int mb = 0; mb < 4; ++mb)
#pragma unroll
    for (int nt = 0; nt < Cf::NTW; ++nt) acc[mb][nt] = f32x4{0.f, 0.f, 0.f, 0.f};
  hyena_conv<GRP>(ZS, FLB, acc, wave, fr, fq);
  {
    const float scale = rsqrtf(SUMSQ[((j * 2 + GRP) * 2 + 0) * 512 + c] + 1e-6f);
    const float bias = p.hy_bias[(j * 2 + 0) * 512 + c];
    const float g0 = p.hy_conv[(j * 3 + 0) * 1536 + 512 + c], g1 = p.hy_conv[(j * 3 + 1) * 1536 + 512 + c],
                g2 = p.hy_conv[(j * 3 + 2) * 1536 + 512 + c];
    u32 hxh[4][Cf::NTW];
    HY_HALO(u1)
#pragma unroll
    for (int mb = 0; mb < 4; ++mb)
#pragma unroll
      for (int nt = 0; nt < Cf::NTW; ++nt) {
        const int colg = (wave * Cf::NTW + nt) * 16 + fr;
        const int i = colg / Cf::NB, b = colg % Cf::NB;
        const int e0 = b * Cf::LSEQ + 64 * i + 16 * mb + 4 * fq;
        const uint2 raw = hxr[mb][nt];
        const uint2 zr = *(const uint2*)(ZS + e0);
        const float xm = bflo(hxh[mb][nt]), xp = bfhi(hxh[mb][nt]);
        const float x0 = bflo(raw.x), x1 = bfhi(raw.x), x2 = bflo(raw.y), x3 = bfhi(raw.y);
        acc[mb][nt][0] = (x0 * g1 + xm * g0 + x1 * g2) * (scale * acc[mb][nt][0] + bias * bflo(zr.x));
        acc[mb][nt][1] = (x1 * g1 + x0 * g0 + x2 * g2) * (scale * acc[mb][nt][1] + bias * bfhi(zr.x));
        acc[mb][nt][2] = (x2 * g1 + x1 * g0 + x3 * g2) * (scale * acc[mb][nt][2] + bias * bflo(zr.y));
        acc[mb][nt][3] = (x3 * g1 + x2 * g0 + xp * g2) * (scale * acc[mb][nt][3] + bias * bfhi(zr.y));
        asm volatile("" : "+v"(acc[mb][nt]) : : "memory");
      }
  }
  __syncthreads();
#pragma unroll
  for (int mb = 0; mb < 4; ++mb)
#pragma unroll
    for (int nt = 0; nt < Cf::NTW; ++nt) {
      const int colg = (wave * Cf::NTW + nt) * 16 + fr;
      const int i = colg / Cf::NB, b = colg % Cf::NB;
      const int e0 = b * Cf::LSEQ + 64 * i + 16 * mb + 4 * fq;
      uint2 pk;
      pk.x = pack2(acc[mb][nt][0], acc[mb][nt][1]);
      pk.y = pack2(acc[mb][nt][2], acc[mb][nt][3]);
      *(uint2*)(ZS + e0) = pk;
      acc[mb][nt] = f32x4{0.f, 0.f, 0.f, 0.f};
    }
  hyena_load_filter<FLEN>(filt0 + (size_t)(1 * 512 + c) * FLEN, FLB, tid);
  const u16* u2 = UT + (size_t)(1024 + c) * MM + Cf::MB;
  HY_PREFETCH(u2)
  __syncthreads();
  hyena_conv<GRP>(ZS, FLB, acc, wave, fr, fq);
  {
    const float scale = rsqrtf(SUMSQ[((j * 2 + GRP) * 2 + 1) * 512 + c] + 1e-6f);
    const float bias = p.hy_bias[(j * 2 + 1) * 512 + c];
    const float g0 = p.hy_conv[(j * 3 + 0) * 1536 + 1024 + c], g1 = p.hy_conv[(j * 3 + 1) * 1536 + 1024 + c],
                g2 = p.hy_conv[(j * 3 + 2) * 1536 + 1024 + c];
    u16* yo = YO + (size_t)c * MM + Cf::MB;
    u32 hxh[4][Cf::NTW];
    HY_HALO(u2)
#pragma unroll
    for (int mb = 0; mb < 4; ++mb)
#pragma unroll
      for (int nt = 0; nt < Cf::NTW; ++nt) {
        const int colg = (wave * Cf::NTW + nt) * 16 + fr;
        const int i = colg / Cf::NB, b = colg % Cf::NB;
        const int e0 = b * Cf::LSEQ + 64 * i + 16 * mb + 4 * fq;
        const uint2 raw = hxr[mb][nt];
        const uint2 zr = *(const uint2*)(ZS + e0);
        const float xm = bflo(hxh[mb][nt]), xp = bfhi(hxh[mb][nt]);
        const float x0 = bflo(raw.x), x1 = bfhi(raw.x), x2 = bflo(raw.y), x3 = bfhi(raw.y);
        const float y0 = (x0 * g1 + xm * g0 + x1 * g2) * (scale * acc[mb][nt][0] + bias * bflo(zr.x));
        const float y1 = (x1 * g1 + x0 * g0 + x2 * g2) * (scale * acc[mb][nt][1] + bias * bfhi(zr.x));
        const float y2 = (x2 * g1 + x1 * g0 + x3 * g2) * (scale * acc[mb][nt][2] + bias * bflo(zr.y));
        const float y3 = (x3 * g1 + x2 * g0 + xp * g2) * (scale * acc[mb][nt][3] + bias * bfhi(zr.y));
        uint2 pk;
        pk.x = pack2(y0, y1);
        pk.y = pack2(y2, y3);
        *(uint2*)(yo + e0) = pk;
        asm volatile("" ::: "memory");
      }
  }
#undef HY_PREFETCH
#undef HY_HALO
  __syncthreads();
}

__device__ __forceinline__ void phase_cdscan(const P& p, int j, const u16* prw, u16* obuf, float* bonus, float* out_rwkv, u16* UT,
                                             const u16* FILT, const float* SUMSQ, int* ctr, char* smem) {
  int* sitem = (int*)(smem + SMEM_BYTES - 16);
  for (;;) {
    if (otid() == 0) *sitem = atomicAdd(ctr, 1);
    __syncthreads();
    const int it = *sitem;
    __syncthreads();
    if (it >= 1280 + 1024) break;
    if (it < 1280) {
#ifndef NO_RW
      for (int rep = 0; rep < REP_RW; ++rep) rwkv_item(p, j, it, prw, obuf, bonus, out_rwkv, smem);
#endif
    } else if (it < 1280 + 512) {
#ifndef NO_HY0
      for (int rep = 1; rep < REP_HY; ++rep) hyena_item<0>(p, j, it - 1280, UT, UT + (size_t)1536 * MTOK, FILT, SUMSQ, smem);
      hyena_item<0>(p, j, it - 1280, UT, UT, FILT, SUMSQ, smem);
#endif
    } else {
#ifndef NO_HY1
      for (int rep = 1; rep < REP_HY; ++rep) hyena_item<1>(p, j, it - 1792, UT, UT + (size_t)1536 * MTOK, FILT, SUMSQ, smem);
      hyena_item<1>(p, j, it - 1792, UT, UT, FILT, SUMSQ, smem);
#endif
    }
  }
}

__device__ __forceinline__ void phase_cdfinal(const P& p, int j, const u16* __restrict__ prw, const u16* __restrict__ obuf,
                                              const float* __restrict__ bonus, const u16* __restrict__ UT, u16* __restrict__ mix,
                                              char* smem) {
  const int tid = otid(), lane = tid & 63;
  {
    const int gw = blockIdx.x * 8 + (tid >> 6);
    const int c8 = lane * 8, hd = lane >> 3;
    float gg[8], gb[8], muv[8], mug[8];
#pragma unroll
    for (int q = 0; q < 8; ++q) {
      gg[q] = p.rw_gn_g[j * 512 + c8 + q];
      gb[q] = p.rw_gn_b[j * 512 + c8 + q];
      muv[q] = p.rw_mu[(j * 4 + 2) * 512 + c8 + q];
      mug[q] = p.rw_mu[(j * 4 + 3) * 512 + c8 + q];
    }
    for (int m = gw; m < MTOK; m += gridDim.x * 8) {
      const int line = m < MCTX ? 256 : 64;
      const int pos = m & (line - 1);
      const float mL = pos > 0 ? 0.5f : 0.f, mR = pos < line - 1 ? 0.5f : 0.f;
      const u16* pr = prw + (size_t)m * 2560;
      const u16* pl = pos > 0 ? pr - 2560 : pr;
      const u16* pq = pos < line - 1 ? pr + 2560 : pr;
      const uint4 o0 = *(const uint4*)(obuf + ((size_t)m * 2 + 0) * 512 + c8);
      const uint4 o1 = *(const uint4*)(obuf + ((size_t)m * 2 + 1) * 512 + c8);
      const uint4 v0 = *(const uint4*)(pr + 1024 + c8), vl = *(const uint4*)(pl + 1024 + c8), vr = *(const uint4*)(pq + 1024 + c8);
      const uint4 g0 = *(const uint4*)(pr + 1536 + c8), gl = *(const uint4*)(pl + 1536 + c8), gr = *(const uint4*)(pq + 1536 + c8);
      const float bon = bonus[((size_t)m * 2 + 0) * 8 + hd] + bonus[((size_t)m * 2 + 1) * 8 + hd];
      const u32* o0p = (const u32*)&o0; const u32* o1p = (const u32*)&o1;
      const u32* v0p = (const u32*)&v0; const u32* vlp = (const u32*)&vl; const u32* vrp = (const u32*)&vr;
      const u32* g0p = (const u32*)&g0; const u32* glp = (const u32*)&gl; const u32* grp = (const u32*)&gr;
      float o[8];
      float s1 = 0.f;
#pragma unroll
      for (int q = 0; q < 8; ++q) {
        const int w = q >> 1;
        o[q] = (q & 1) ? (bfhi(o0p[w]) + bfhi(o1p[w])) : (bflo(o0p[w]) + bflo(o1p[w]));
        s1 += o[q];
      }
      const float mean = sum8(s1) * (1.f / 64.f);
      float s2 = 0.f;
#pragma unroll
      for (int q = 0; q < 8; ++q) { o[q] -= mean; s2 += o[q] * o[q]; }
      const float rstd = rsqrtf(sum8(s2) * (1.f / 64.f) + 64e-5f);
      float y[8];
#pragma unroll
      for (int q = 0; q < 8; ++q) {
        const int w = q >> 1;
        const bool hi = q & 1;
        const float x0 = hi ? bfhi(v0p[w]) : bflo(v0p[w]), xl = hi ? bfhi(vlp[w]) : bflo(vlp[w]), xr = hi ? bfhi(vrp[w]) : bflo(vrp[w]);
        const float vm = x0 + (mL * xl + mR * xr - x0) * muv[q];
        const float y0 = hi ? bfhi(g0p[w]) : bflo(g0p[w]), yl = hi ? bfhi(glp[w]) : bflo(glp[w]), yr = hi ? bfhi(grp[w]) : bflo(grp[w]);
        const float gm = y0 + (mL * yl + mR * yr - y0) * mug[q];
        const float on = o[q] * rstd * gg[q] + gb[q];
        y[q] = (on + bon * vm) * sigmoidf_(gm);
      }
      uint4 pk;
      pk.x = pack2(y[0], y[1]); pk.y = pack2(y[2], y[3]); pk.z = pack2(y[4], y[5]); pk.w = pack2(y[6], y[7]);
      *(uint4*)(mix + (size_t)m * 1024 + 512 + c8) = pk;
    }
  }
  {
    u16* tl = (u16*)smem;
    for (int t = blockIdx.x; t < 640 * 8; t += gridDim.x) {
      const int mt = t >> 3, ct = t & 7;
      for (int e = tid; e < 4096; e += NTHR) {
        int cc = e >> 6, mm = e & 63;
        tl[cc * 66 + mm] = UT[(size_t)(ct * 64 + cc) * MTOK + mt * 64 + mm];
      }
      __syncthreads();
      for (int e = tid; e < 4096; e += NTHR) {
        int mm = e >> 6, cc = e & 63;
        mix[(size_t)(mt * 64 + mm) * 1024 + ct * 64 + cc] = tl[cc * 66 + mm];
      }
      __syncthreads();
    }
  }
}

#ifndef PHMASK
#define PHMASK 0xffffffffu
#endif
#define PHS(b) ((PHMASK >> (b)) & 1u)
#define XB_XCNT(j) (256 + 64 * (j))
#define XB_XSUB(j) (1280 + 64 * (j))
#define XB_XGEN(j) (2304 + 64 * (j))
#define XB_TOP 3328
#define XB_TOPGEN 3392
#define XCD_BAR_WORDS 3456
__device__ __forceinline__ unsigned xb_ld(unsigned* p) { return __hip_atomic_load(p, __ATOMIC_RELAXED, __HIP_MEMORY_SCOPE_AGENT); }
__device__ __forceinline__ unsigned xb_add(unsigned* p, unsigned v) { return __hip_atomic_fetch_add(p, v, __ATOMIC_RELAXED, __HIP_MEMORY_SCOPE_AGENT); }
__device__ __forceinline__ unsigned xb_xcc_id() { return (unsigned)__builtin_amdgcn_s_getreg((3 << 11) | 20) & 0xFu; }
__device__ __forceinline__ void xcd_barrier(unsigned* bar, volatile unsigned* st) {
  asm volatile("s_waitcnt vmcnt(0)" ::: "memory");
  __syncthreads();
  if (otid() == 0) {
    __builtin_amdgcn_s_waitcnt(0);
    const unsigned x = xb_xcc_id();
    unsigned nloc = st[0], nx = st[1];
    if (nloc == 0u) {
      const unsigned G = gridDim.x;
      unsigned sum, cnt, mine;
      for (;;) {
        sum = 0u; cnt = 0u; mine = 0u;
#pragma unroll
        for (unsigned jx = 0; jx < 16; ++jx) {
          const unsigned c = xb_ld(&bar[XB_XCNT(jx)]);
          sum += c; cnt += (c > 0u) ? 1u : 0u; mine = (jx == x) ? c : mine;
        }
        if (sum == G) break;
        __builtin_amdgcn_s_sleep(1);
      }
      nloc = mine > 0u ? mine : 1u; nx = cnt > 0u ? cnt : 1u;
      st[0] = nloc; st[1] = nx;
    }
    const unsigned old = xb_add(&bar[XB_XSUB(x)], 1u);
    const unsigned gen = old / nloc;
    if (old + 1u == (gen + 1u) * nloc) {
      __builtin_amdgcn_fence(__ATOMIC_RELEASE, "agent");
      asm volatile("s_waitcnt vmcnt(0)" ::: "memory");
      const unsigned og = xb_add(&bar[XB_TOP], 1u);
      const unsigned tg = og / nx;
      if (og + 1u == (tg + 1u) * nx) xb_add(&bar[XB_TOPGEN], 1u);
      else while (xb_ld(&bar[XB_TOPGEN]) == tg) __builtin_amdgcn_s_sleep(1);
      __builtin_amdgcn_fence(__ATOMIC_ACQUIRE, "agent");
      xb_add(&bar[XB_XGEN(x)], 1u);
      asm volatile("s_waitcnt vmcnt(0)" ::: "memory");
    } else {
      while (xb_ld(&bar[XB_XGEN(x)]) == gen) __builtin_amdgcn_s_sleep(1);
      __builtin_amdgcn_fence(__ATOMIC_ACQUIRE, "agent");
      asm volatile("s_waitcnt vmcnt(0)" ::: "memory");
    }
  }
  __syncthreads();
}
__global__ void __launch_bounds__(NTHR) fwd_megakernel(P p, int ph_begin, int ph_end) {
  extern __shared__ __attribute__((aligned(16))) char smem[];
  cg::grid_group grid = cg::this_grid();
  char* ws = p.ws;
  float* mods = (float*)(ws + OFF_MODS);
  float* bonus = (float*)(ws + OFF_BONUS);
  float* HID2 = (float*)(ws + OFF_HID2);
  float* SUMSQ = (float*)(ws + OFF_SUMSQ);
  int* CTR = (int*)(ws + OFF_CTR);
  u16* WIN = (u16*)(ws + OFF_WIN);
  u16* WOUT = (u16*)(ws + OFF_WOUT);
  u16* W1T = (u16*)(ws + OFF_W1T);
  u16* W2T = (u16*)(ws + OFF_W2T);
  u16* FILT = (u16*)(ws + OFF_FILT);
  u16* H = (u16*)(ws + OFF_H);
  char* arena = ws + OFF_ARENA;
  float* X = p.out;
  float* out_lru = p.out + (size_t)MTOK * 1024;
  float* out_rwkv = out_lru + 32 * 2 * 2 * 512;
  float* smf = (float*)smem;

  volatile unsigned* xst = (volatile unsigned*)(smem + 131072);
  unsigned* xbar = (unsigned*)(p.ws + OFF_BAR);
  if (otid() == 0) { xst[0] = 0u; xst[1] = 0u; (void)xb_add(&xbar[XB_XCNT(xb_xcc_id())], 1u); }
  __syncthreads();
  for (int ph = ph_begin; ph < ph_end; ++ph) {
    if (TSEL && blockIdx.x == 0 && otid() == 0) ((unsigned long long*)(p.ws + OFF_CTR + 1024))[ph] = wall_clock64();
    if (ph == 0) {
      if (blockIdx.x == 0 && otid() < 16) CTR[otid()] = 0;
      for (int i = blockIdx.x * NTHR + otid(); i < 2 * 2 * 2 * 512; i += gridDim.x * NTHR) SUMSQ[i] = 0.f;
      for (int rep = 0; rep < REP_O; ++rep) {
      if (PHS(0)) phase_mods(p, mods, smf);
      __syncthreads();
      if (PHS(1)) phase_hid2(p, HID2, smf);
      if (PHS(2)) { conv_mix_weights(p, 0, ws, smf); }
      __syncthreads(); }
    } else if (ph == 1) {
      for (int rep = 0; rep < REP_O; ++rep) phase_xinit(p, X, mods, H);

    } else {
      const int l = (ph - 2) >> 3, s = (ph - 2) & 7;
      const int j = l >> 1;
      const bool cd = l & 1;
      const float* modl = mods + (size_t)l * 9 * 6144;
      if (s == 0) {
        if (!cd) {
          for (int rep = 0; rep < REP_G; ++rep) gemm_phase<0>(H, 1024, WIN, 1024, 2560, (u16*)arena, 2560, 0, nullptr, nullptr, nullptr, smem);

        } else {
          for (int rep = 0; rep < REP_G; ++rep) gemm_phase<1>(H, 1024, WIN, 1024, 4096, (u16*)arena, 2560, 0, (u16*)(arena + ARENA_B), nullptr, nullptr, smem);
        }

      } else if (s == 1) {
        if (!cd) {
          phase_lru_gates(p, j, (const u16*)arena, (u32*)(arena + ARENA_B), smem);
          xcd_barrier(xbar, xst);
          phase_lru_scan(p, j, (u32*)(arena + ARENA_B), out_lru, CTR + l, smem);
          phase_filtgen(p, j, HID2, FILT, SUMSQ, smf);
        }
        else if (PHS(8)) phase_cdscan(p, j, (const u16*)arena, H, bonus, out_rwkv, (u16*)(arena + ARENA_B), FILT, SUMSQ, CTR + l, smem);
      } else if (s == 2) {
        if (!cd) { for (int rep = 0; rep < REP_O; ++rep) phase_abmix(p, j, (const u16*)arena, (const float*)(arena + ARENA_B), H); }
        else for (int rep = 0; rep < REP_O; ++rep) phase_cdfinal(p, j, (const u16*)arena, H, bonus, (const u16*)(arena + ARENA_B),
                           (u16*)(arena + ARENA_B) + (size_t)512 * MTOK, smem);
      } else if (s == 3) {
        const u16* mixp = cd ? (const u16*)(arena + ARENA_B) + (size_t)512 * MTOK : H;
        if (!cd) for (int rep = 1; rep < REP_E2; ++rep) gemm_phase<2>(mixp, 1024, WOUT, 1024, 1024, nullptr, 0, 1, nullptr, (float*)arena, modl + 2048, smem);
        if (PHS(11)) gemm_phase<2>(mixp, 1024, WOUT, 1024, 1024, nullptr, 0, cd ? 1 : 0, nullptr, X, modl + 2048, smem);
        conv_mlp_weights(p, l, ws, smf, false);
      } else if (s == 4) {
        for (int rep = 1; rep < REP_LN; ++rep) phase_ln(X, p.ln1_g + l * 1024, p.ln1_b + l * 1024, modl, 3072, 4096, H, 1, 0, 0);
        if (PHS(12)) phase_ln(X, p.ln1_g + l * 1024, p.ln1_b + l * 1024, modl, 3072, 4096, H, 1, 0);
      } else if (s == 5) {
        for (int rep = 0; rep < REP_G; ++rep) gemm_phase<0>(H, 1024, W1T, 1024, 4096, (u16*)arena, 4096, 1, nullptr, nullptr, nullptr, smem);

      } else if (s == 6) {
        for (int rep = 0; rep < REP_M2; ++rep) gemm_phase<0>((const u16*)arena, 4096, W2T, 4096, 1024, H, 1024, 0, nullptr, nullptr, nullptr, smem);
        if (PHS(11)) gemm_phase<2>((const u16*)arena, 4096, W2T, 4096, 1024, nullptr, 0, 0, nullptr, X, modl + 5120, smem);
        if (l < 3) conv_mix_weights(p, l + 1, ws, smf, false);
      } else {
        const float* modn = mods + (size_t)(l + 1) * 9 * 6144;
        for (int rep = 1; rep < REP_LN; ++rep) phase_ln(X, p.ln2_g + l * 1024, p.ln2_b + l * 1024, l < 3 ? modn : modl, 0, 1024, H, 1, ((l + 1) & 1), 0);
        if (PHS(12)) phase_ln(X, p.ln2_g + l * 1024, p.ln2_b + l * 1024, l < 3 ? modn : modl, 0, 1024, H, l < 3 ? 1 : 0, ((l + 1) & 1));
      }
    }
    if (ph + 1 < ph_end) {
      if (ph_end < 0) grid.sync();
      xcd_barrier(xbar, xst);
    }
  }
  if (TSEL && blockIdx.x == 0 && otid() == 0) {
    unsigned long long* TS = (unsigned long long*)(p.ws + OFF_CTR + 1024);
    const unsigned long long tend = wall_clock64();
    TS[34] = tend;
    unsigned long long spin = 0;
    for (int ph = 0; ph < 34; ++ph) {
      const unsigned long long dd = TS[ph + 1] - TS[ph];
      const int sc = ph < 2 ? -1 : ((ph - 2) & 7);
      bool sel = false;
      if (TSEL == 1) sel = true;
      else if (TSEL == 2) sel = (sc == 0 || sc == 3 || sc == 5 || sc == 6);
      else if (TSEL == 3) sel = (sc == 1);
      else if (TSEL == 4) sel = (sc == 2 || sc == 4 || sc == 7);
      else if (TSEL == 5) sel = (sc == -1);
      else if (TSEL == 6) sel = (sc == 4 || sc == 7);
      else if (TSEL == 7) sel = (sc == 2);
      else if (TSEL == 8) sel = (sc == 1 && (((ph - 2) >> 3) & 1) == 0);
      else if (TSEL == 9) sel = (sc == 1 && (((ph - 2) >> 3) & 1) == 1);
      if (sel) spin += dd;
    }
    while (wall_clock64() - tend < spin) { __builtin_amdgcn_s_sleep(8); }
  }
}

extern "C" void kernel_launch(void* const* d_in, const int* in_sizes, int n_in, void* d_out, int out_size, void* d_ws,
                              size_t ws_size, hipStream_t stream) {
  static int grid_blocks = 0;
  if (!grid_blocks) {
    int dev = 0, cus = 0, per_cu = 0;
    hipGetDevice(&dev);
    hipDeviceGetAttribute(&cus, hipDeviceAttributeMultiprocessorCount, dev);
    hipFuncSetAttribute((const void*)fwd_megakernel, hipFuncAttributeMaxDynamicSharedMemorySize, SMEM_BYTES);
    hipOccupancyMaxActiveBlocksPerMultiprocessor(&per_cu, fwd_megakernel, NTHR, SMEM_BYTES);
    if (per_cu < 1) per_cu = 1;
    grid_blocks = cus * per_cu;
  }
  if (ws_size < WS_NEED) fprintf(stderr, "workspace too small: %zu < %llu\n", ws_size, (unsigned long long)WS_NEED);
  P p{};
  const float** pp = (const float**)&p;
  for (int i = 0; i < 46; ++i) pp[i] = (const float*)d_in[i];
  p.out = (float*)d_out;
  p.ws = (char*)d_ws;
  int ph0 = 0, ph1 = 34;
  void* args[] = {&p, &ph0, &ph1};
  hipMemsetAsync((char*)d_ws + OFF_BAR, 0, 16384, stream);
  hipError_t e = hipLaunchCooperativeKernel((void*)fwd_megakernel, dim3(grid_blocks), dim3(NTHR), args, SMEM_BYTES, stream);
  if (e != hipSuccess) fprintf(stderr, "cooperative launch failed: %s (grid %d)\n", hipGetErrorString(e), grid_blocks);
}
```
